# Optimizing an MI355X kernel written in HIP

```python
import jax, jax.numpy as jnp
from jax import lax
import numpy as np

D_MODEL = 2048
BATCH = 1
SEQ = 8192
DEPTH = 1

D_SSM = 1024
SSM_GROUP = 16
SSM_GROUPS = D_SSM // SSM_GROUP
SSM_STATE = 64
NA_HEADS = 16
NA_HEAD_DIM = 64
D_NA = NA_HEADS * NA_HEAD_DIM
D_MIX = D_SSM + D_NA
D_IN_PROJ = D_SSM + 3 * D_NA
GRID_W = 64
WIN_ROWS_MAX = 8
WIN_COLS = 16
RPB_ROWS = 2 * WIN_ROWS_MAX - 1
RPB_COLS = 2 * WIN_COLS - 1
N_EXPERTS = 16
EXPERT_FF = 2048
EC_CAPACITY_FACTOR = 2
RMS_EPS = 1e-6
DT_MIN = 1e-3
DT_MAX = 1e-1

kernel_name = "hybrid_s5_natten_ecmoe_block"


def rms_norm(x, g):
    xf = x.astype(jnp.float32)
    y = xf * lax.rsqrt(jnp.mean(xf * xf, axis=-1, keepdims=True) + RMS_EPS)
    return (y * g.astype(jnp.float32)).astype(x.dtype)


def s5_direction(u, a_re, a_im, log_dt, b_re, b_im, c_re, c_im, reverse):
    lam = lax.complex(a_re.astype(jnp.float32), a_im.astype(jnp.float32))
    dt = jnp.exp(log_dt.astype(jnp.float32))[:, None]
    a_bar = jnp.exp(lam * dt)
    b = lax.complex(b_re.astype(jnp.float32), b_im.astype(jnp.float32))
    b_bar = ((a_bar - 1.0) / lam)[..., None] * b
    bu = jnp.einsum('blgc,gpc->blgp', u.astype(jnp.complex64), b_bar)
    a = jnp.broadcast_to(a_bar, bu.shape)

    def combine(e1, e2):
        a1, s1 = e1
        a2, s2 = e2
        return a1 * a2, a2 * s1 + s2

    _, states = lax.associative_scan(combine, (a, bu), axis=1, reverse=reverse)
    c = lax.complex(c_re.astype(jnp.float32), c_im.astype(jnp.float32))
    return jnp.real(jnp.einsum('blgp,gcp->blgc', states, c))


def s5_mixer(u, fwd, bwd, d_skip, w_glu, b_glu):
    bsz, seq_len, _ = u.shape
    uf = u.astype(jnp.float32)
    ug = uf.reshape(bsz, seq_len, SSM_GROUPS, SSM_GROUP)
    y = s5_direction(ug, *fwd, reverse=False) + s5_direction(ug, *bwd, reverse=True)
    y = y.reshape(bsz, seq_len, D_SSM) + d_skip.astype(jnp.float32) * uf
    y = jax.nn.gelu(y).astype(u.dtype)
    return y * jax.nn.sigmoid(y @ w_glu + b_glu)


def neighbourhood_attention(q, k, v, rpb):
    bsz, seq_len, _ = q.shape
    rows = seq_len // GRID_W
    wr = min(WIN_ROWS_MAX, rows)

    def to_grid(t):
        return t.reshape(bsz, rows, GRID_W, NA_HEADS, NA_HEAD_DIM)

    qg, kg, vg = to_grid(q), to_grid(k), to_grid(v)
    cols = np.arange(GRID_W)
    col_start = np.clip(cols - WIN_COLS // 2, 0, GRID_W - WIN_COLS)
    col_idx = (col_start[:, None] + np.arange(WIN_COLS)[None, :]).astype(np.int32)
    dx_idx = (col_idx - cols[:, None] + (WIN_COLS - 1)).astype(np.int32)
    scale = NA_HEAD_DIM ** -0.5
    rpb_f = rpb.astype(jnp.float32)

    def one_row(r):
        rs = jnp.clip(r - wr // 2, 0, rows - wr)
        k_rows = lax.dynamic_slice_in_dim(kg, rs, wr, axis=1)
        v_rows = lax.dynamic_slice_in_dim(vg, rs, wr, axis=1)
        k_win = k_rows[:, :, col_idx]
        v_win = v_rows[:, :, col_idx]
        q_r = lax.dynamic_index_in_dim(qg, r, axis=1, keepdims=False)
        s = jnp.einsum('bchd,bicjhd->bhcij', q_r, k_win).astype(jnp.float32) * scale
        dy_idx = rs + jnp.arange(wr, dtype=jnp.int32) - r + (WIN_ROWS_MAX - 1)
        bias = rpb_f[:, dy_idx][:, :, dx_idx]
        s = s + jnp.transpose(bias, (0, 2, 1, 3))[None]
        p = jax.nn.softmax(s.reshape(bsz, NA_HEADS, GRID_W, wr * WIN_COLS), axis=-1)
        p = p.reshape(s.shape).astype(v.dtype)
        return jnp.einsum('bhcij,bicjhd->bchd', p, v_win)

    out = lax.map(one_row, jnp.arange(rows, dtype=jnp.int32))
    return jnp.moveaxis(out, 0, 1).reshape(bsz, seq_len, D_NA)


def expert_choice_moe(h, w_router, w_gate, w_up, w_down):
    bsz, seq_len, _ = h.shape
    cap = EC_CAPACITY_FACTOR * seq_len // N_EXPERTS
    affinity = jax.nn.softmax((h @ w_router).astype(jnp.float32), axis=-1)
    gates, idx = lax.top_k(jnp.swapaxes(affinity, 1, 2), cap)
    b_idx = jnp.arange(bsz, dtype=jnp.int32)[:, None, None]
    xe = h[b_idx, idx]
    g = jnp.einsum('becd,edf->becf', xe, w_gate)
    u = jnp.einsum('becd,edf->becf', xe, w_up)
    ye = jnp.einsum('becf,efd->becd', jax.nn.silu(g) * u, w_down)
    ye = ye * gates[..., None].astype(ye.dtype)
    return jnp.zeros_like(h).at[b_idx, idx].add(ye)


def setup_inputs(seed: int = 0) -> dict:
    key = jax.random.key(seed)
    ks = iter(jax.random.split(key, 40))
    f32 = jnp.float32

    def nrm(shape, std):
        return jax.random.normal(next(ks), shape, f32) * std

    def gain(shape):
        return 1.0 + nrm(shape, 0.01)

    n = jnp.arange(SSM_STATE, dtype=f32)

    def ssm_dir():
        a_re = -0.5 + nrm((DEPTH, SSM_GROUPS, SSM_STATE), 0.01)
        a_im = jnp.pi * n + nrm((DEPTH, SSM_GROUPS, SSM_STATE), 0.01)
        log_dt = jax.random.uniform(next(ks), (DEPTH, SSM_GROUPS), f32,
                                    np.log(DT_MIN), np.log(DT_MAX))
        b_std = (2.0 * SSM_GROUP) ** -0.5
        c_std = (2.0 * SSM_STATE) ** -0.5
        b_re = nrm((DEPTH, SSM_GROUPS, SSM_STATE, SSM_GROUP), b_std)
        b_im = nrm((DEPTH, SSM_GROUPS, SSM_STATE, SSM_GROUP), b_std)
        c_re = nrm((DEPTH, SSM_GROUPS, SSM_GROUP, SSM_STATE), c_std)
        c_im = nrm((DEPTH, SSM_GROUPS, SSM_GROUP, SSM_STATE), c_std)
        return a_re, a_im, log_dt, b_re, b_im, c_re, c_im

    x = nrm((BATCH, SEQ, D_MODEL), 1.0)
    norm_mix_g = gain((DEPTH, D_MODEL))
    w_in = nrm((DEPTH, D_MODEL, D_IN_PROJ), D_MODEL ** -0.5)
    a_re_fwd, a_im_fwd, log_dt_fwd, b_re_fwd, b_im_fwd, c_re_fwd, c_im_fwd = ssm_dir()
    a_re_bwd, a_im_bwd, log_dt_bwd, b_re_bwd, b_im_bwd, c_re_bwd, c_im_bwd = ssm_dir()
    ssm_d = nrm((DEPTH, D_SSM), 1.0)
    w_glu = nrm((DEPTH, D_SSM, D_SSM), D_SSM ** -0.5)
    b_glu = nrm((DEPTH, D_SSM), 0.01)
    na_rpb = nrm((DEPTH, NA_HEADS, RPB_ROWS, RPB_COLS), 0.02)
    g_ssm_out = gain((DEPTH, D_SSM))
    g_na_out = gain((DEPTH, D_NA))
    w_out = nrm((DEPTH, D_MIX, D_MODEL), D_MIX ** -0.5)
    norm_ffn_g = gain((DEPTH, D_MODEL))
    w_router = nrm((DEPTH, D_MODEL, N_EXPERTS), D_MODEL ** -0.5)
    w_gate = nrm((DEPTH, N_EXPERTS, D_MODEL, EXPERT_FF), D_MODEL ** -0.5)
    w_up = nrm((DEPTH, N_EXPERTS, D_MODEL, EXPERT_FF), D_MODEL ** -0.5)
    w_down = nrm((DEPTH, N_EXPERTS, EXPERT_FF, D_MODEL), EXPERT_FF ** -0.5)
    norm_final_g = gain((D_MODEL,))
    return {
        "x": x, "norm_mix_g": norm_mix_g, "w_in": w_in,
        "a_re_fwd": a_re_fwd, "a_im_fwd": a_im_fwd, "log_dt_fwd": log_dt_fwd,
        "b_re_fwd": b_re_fwd, "b_im_fwd": b_im_fwd, "c_re_fwd": c_re_fwd, "c_im_fwd": c_im_fwd,
        "a_re_bwd": a_re_bwd, "a_im_bwd": a_im_bwd, "log_dt_bwd": log_dt_bwd,
        "b_re_bwd": b_re_bwd, "b_im_bwd": b_im_bwd, "c_re_bwd": c_re_bwd, "c_im_bwd": c_im_bwd,
        "ssm_d": ssm_d, "w_glu": w_glu, "b_glu": b_glu, "na_rpb": na_rpb,
        "g_ssm_out": g_ssm_out, "g_na_out": g_na_out, "w_out": w_out,
        "norm_ffn_g": norm_ffn_g, "w_router": w_router, "w_gate": w_gate,
        "w_up": w_up, "w_down": w_down, "norm_final_g": norm_final_g,
    }


def reference(x, norm_mix_g, w_in,
              a_re_fwd, a_im_fwd, log_dt_fwd, b_re_fwd, b_im_fwd, c_re_fwd, c_im_fwd,
              a_re_bwd, a_im_bwd, log_dt_bwd, b_re_bwd, b_im_bwd, c_re_bwd, c_im_bwd,
              ssm_d, w_glu, b_glu, na_rpb, g_ssm_out, g_na_out, w_out,
              norm_ffn_g, w_router, w_gate, w_up, w_down, norm_final_g):
    for layer in range(DEPTH):
        h = rms_norm(x, norm_mix_g[layer])
        proj = h @ w_in[layer]
        u, q, k, v = jnp.split(proj, [D_SSM, D_SSM + D_NA, D_SSM + 2 * D_NA], axis=-1)
        fwd = (a_re_fwd[layer], a_im_fwd[layer], log_dt_fwd[layer], b_re_fwd[layer],
               b_im_fwd[layer], c_re_fwd[layer], c_im_fwd[layer])
        bwd = (a_re_bwd[layer], a_im_bwd[layer], log_dt_bwd[layer], b_re_bwd[layer],
               b_im_bwd[layer], c_re_bwd[layer], c_im_bwd[layer])
        y_ssm = s5_mixer(u, fwd, bwd, ssm_d[layer], w_glu[layer], b_glu[layer])
        y_na = neighbourhood_attention(q, k, v, na_rpb[layer])
        y_mix = jnp.concatenate([rms_norm(y_ssm, g_ssm_out[layer]),
                                 rms_norm(y_na, g_na_out[layer])], axis=-1)
        x = x + y_mix @ w_out[layer]
        h2 = rms_norm(x, norm_ffn_g[layer])
        x = x + expert_choice_moe(h2, w_router[layer], w_gate[layer], w_up[layer], w_down[layer])
    return rms_norm(x, norm_final_g)
```

```cpp
#include <hip/hip_runtime.h>
#include <math.h>
#include <stdint.h>

#define L_   8192
#define D_   2048
#define DIN_ 4096
#define DS_  1024
#define NG_  64
#define NP_  64
#define NE_  16
#define CAP_ 1024
#define FF_  2048

__device__ __forceinline__ float wave_sum(float v) {
#pragma unroll
    for (int o = 32; o >= 1; o >>= 1) v += __shfl_xor(v, o);
    return v;
}

__global__ __launch_bounds__(256) void k_rmsnorm(const float* __restrict__ in, int ld_in, const float* __restrict__ g,
                                                 float* __restrict__ out, int ld_out, int ncols) {
    __shared__ float red[4];
    const int row = blockIdx.x;
    const float* ip = in + (size_t)row * ld_in;
    float* op = out + (size_t)row * ld_out;
    float s = 0.f;
    for (int c = threadIdx.x; c < ncols; c += 256) { float v = ip[c]; s += v * v; }
    s = wave_sum(s);
    if ((threadIdx.x & 63) == 0) red[threadIdx.x >> 6] = s;
    __syncthreads();
    const float tot = red[0] + red[1] + red[2] + red[3];
    const float rstd = 1.0f / sqrtf(tot / (float)ncols + 1e-6f);
    for (int c = threadIdx.x; c < ncols; c += 256) op[c] = ip[c] * rstd * g[c];
}

template <bool GATHER>
__global__ __launch_bounds__(256) void k_gemm_f32(const float* __restrict__ A, int lda, long strideA,
                                                  const int* __restrict__ gidx, int gstride,
                                                  const float* __restrict__ B, int ldb, long strideB,
                                                  float* __restrict__ C, int ldc, long strideC, int K) {
    __shared__ float As[16][68];
    __shared__ float Bs[16][68];
    const int bz = blockIdx.z;
    if (!GATHER) A += (size_t)bz * strideA;
    B += (size_t)bz * strideB;
    C += (size_t)bz * strideC;
    const int m0 = blockIdx.y * 64, n0 = blockIdx.x * 64;
    const int tid = threadIdx.x, tx = tid & 15, ty = tid >> 4;
    const int ar = tid >> 2, ak = (tid & 3) * 4;
    const long arow = GATHER ? (long)gidx[(size_t)bz * gstride + m0 + ar] : (long)(m0 + ar);
    const float* Arow = A + arow * lda + ak;
    const float* Bp = B + (size_t)(tid >> 4) * ldb + n0 + (tid & 15) * 4;
    float acc[4][4];
#pragma unroll
    for (int i = 0; i < 4; ++i)
#pragma unroll
        for (int j = 0; j < 4; ++j) acc[i][j] = 0.f;
    for (int k0 = 0; k0 < K; k0 += 16) {
        const float4 a = *(const float4*)(Arow + k0);
        const float4 b = *(const float4*)(Bp + (size_t)k0 * ldb);
        As[ak + 0][ar] = a.x; As[ak + 1][ar] = a.y; As[ak + 2][ar] = a.z; As[ak + 3][ar] = a.w;
        *(float4*)&Bs[tid >> 4][(tid & 15) * 4] = b;
        __syncthreads();
#pragma unroll
        for (int kk = 0; kk < 16; ++kk) {
            const float4 av = *(const float4*)&As[kk][ty * 4];
            const float4 bv = *(const float4*)&Bs[kk][tx * 4];
            const float aa[4] = {av.x, av.y, av.z, av.w};
            const float bb[4] = {bv.x, bv.y, bv.z, bv.w};
#pragma unroll
            for (int i = 0; i < 4; ++i)
#pragma unroll
                for (int j = 0; j < 4; ++j) acc[i][j] = fmaf(aa[i], bb[j], acc[i][j]);
        }
        __syncthreads();
    }
#pragma unroll
    for (int i = 0; i < 4; ++i) {
        float4 o; o.x = acc[i][0]; o.y = acc[i][1]; o.z = acc[i][2]; o.w = acc[i][3];
        *(float4*)(C + (size_t)(m0 + ty * 4 + i) * ldc + n0 + tx * 4) = o;
    }
}

__global__ void k_ssm_setup(const float* a_re_f, const float* a_im_f, const float* ldt_f, const float* b_re_f, const float* b_im_f,
                            const float* a_re_b, const float* a_im_b, const float* ldt_b, const float* b_re_b, const float* b_im_b,
                            float* __restrict__ abar, float* __restrict__ bbar) {
    const int t = blockIdx.x * blockDim.x + threadIdx.x;
    if (t >= 2 * NG_ * NP_) return;
    const int dir = t / (NG_ * NP_), gp = t % (NG_ * NP_), g = gp / NP_;
    const float* a_re = dir ? a_re_b : a_re_f; const float* a_im = dir ? a_im_b : a_im_f;
    const float* ldt = dir ? ldt_b : ldt_f; const float* b_re = dir ? b_re_b : b_re_f; const float* b_im = dir ? b_im_b : b_im_f;
    const float lr = a_re[gp], li = a_im[gp];
    const float dt = expf(ldt[g]);
    const float x = lr * dt, y = li * dt;
    const float ex = expf(x), cy = cosf(y), sy = sinf(y);
    const float ar = ex * cy, ai = ex * sy;
    const float sh = sinf(0.5f * y);
    const float nr = expm1f(x) * cy - 2.f * sh * sh, ni = ai;
    const float den = lr * lr + li * li;
    const float fr = (nr * lr + ni * li) / den, fi = (ni * lr - nr * li) / den;
    abar[t * 2 + 0] = ar; abar[t * 2 + 1] = ai;
    for (int c = 0; c < 16; ++c) {
        const float br = b_re[gp * 16 + c], bi = b_im[gp * 16 + c];
        bbar[(t * 16 + c) * 2 + 0] = fr * br - fi * bi;
        bbar[(t * 16 + c) * 2 + 1] = fr * bi + fi * br;
    }
}

__global__ __launch_bounds__(64) void k_ssm_scan(const float* __restrict__ proj, const float* __restrict__ abar, const float* __restrict__ bbar,
                                                 const float* __restrict__ c_re_f, const float* __restrict__ c_im_f,
                                                 const float* __restrict__ c_re_b, const float* __restrict__ c_im_b,
                                                 float* __restrict__ ydir) {
    __shared__ float red[16][65];
    const int dir = blockIdx.x / NG_, g = blockIdx.x % NG_, p = threadIdx.x;
    const int t = (dir * NG_ + g) * NP_ + p;
    const float ar = abar[t * 2], ai = abar[t * 2 + 1];
    float br[16], bi[16], cr[16], ci[16];
    const float* c_re = dir ? c_re_b : c_re_f; const float* c_im = dir ? c_im_b : c_im_f;
#pragma unroll
    for (int c = 0; c < 16; ++c) {
        br[c] = bbar[(t * 16 + c) * 2]; bi[c] = bbar[(t * 16 + c) * 2 + 1];
        cr[c] = c_re[(g * 16 + c) * NP_ + p]; ci[c] = c_im[(g * 16 + c) * NP_ + p];
    }
    float sr = 0.f, si = 0.f;
    float* yo = ydir + (size_t)dir * L_ * DS_;
    for (int step = 0; step < L_; ++step) {
        const int l = dir ? (L_ - 1 - step) : step;
        const float* up = proj + (size_t)l * DIN_ + g * 16;
        float bur = 0.f, bui = 0.f;
#pragma unroll
        for (int c = 0; c < 16; ++c) { const float u = up[c]; bur = fmaf(u, br[c], bur); bui = fmaf(u, bi[c], bui); }
        const float nsr = ar * sr - ai * si + bur;
        const float nsi = ar * si + ai * sr + bui;
        sr = nsr; si = nsi;
#pragma unroll
        for (int c = 0; c < 16; ++c) red[c][p] = cr[c] * sr - ci[c] * si;
        __syncthreads();
        {
            const int c = p & 15, q = p >> 4;
            float s = 0.f;
#pragma unroll
            for (int j = 0; j < 16; ++j) s += red[c][q * 16 + j];
            s += __shfl_xor(s, 16);
            s += __shfl_xor(s, 32);
            if (p < 16) yo[(size_t)l * DS_ + g * 16 + c] = s;
        }
        __syncthreads();
    }
}

__device__ __forceinline__ float gelu_tanh(float x) {
    const float k0 = 0.7978845608028654f, k1 = 0.044715f;
    return 0.5f * x * (1.f + tanhf(k0 * (x + k1 * x * x * x)));
}

__global__ void k_ssm_combine(const float* __restrict__ ydir, const float* __restrict__ proj, const float* __restrict__ dskip, float* __restrict__ ypre) {
    const size_t i = (size_t)blockIdx.x * blockDim.x + threadIdx.x;
    if (i >= (size_t)L_ * DS_) return;
    const int l = (int)(i / DS_), c = (int)(i % DS_);
    const float u = proj[(size_t)l * DIN_ + c];
    ypre[i] = gelu_tanh(ydir[i] + ydir[(size_t)L_ * DS_ + i] + dskip[c] * u);
}
__global__ void k_glu(const float* __restrict__ ypre, const float* __restrict__ z, const float* __restrict__ b, float* __restrict__ yssm) {
    const size_t i = (size_t)blockIdx.x * blockDim.x + threadIdx.x;
    if (i >= (size_t)L_ * DS_) return;
    const int c = (int)(i % DS_);
    const float t = z[i] + b[c];
    yssm[i] = ypre[i] / (1.f + expf(-t));
}

__global__ __launch_bounds__(64) void k_na(const float* __restrict__ proj, const float* __restrict__ rpb, float* __restrict__ yna) {
    const int gid = blockIdx.x * 64 + threadIdx.x;
    const int token = gid >> 4, h = gid & 15;
    const int r = token >> 6, c = token & 63;
    int rs = r - 4; rs = rs < 0 ? 0 : (rs > 120 ? 120 : rs);
    int cs = c - 8; cs = cs < 0 ? 0 : (cs > 48 ? 48 : cs);
    float q[64], o[64];
    const float* qp = proj + (size_t)token * DIN_ + 1024 + h * 64;
#pragma unroll
    for (int d = 0; d < 64; ++d) { q[d] = qp[d]; o[d] = 0.f; }
    float m = -1e30f, lsum = 0.f;
    for (int i = 0; i < 8; ++i) {
        for (int j = 0; j < 16; ++j) {
            const int kt = (rs + i) * 64 + cs + j;
            const float* kp = proj + (size_t)kt * DIN_ + 2048 + h * 64;
            const float* vp = proj + (size_t)kt * DIN_ + 3072 + h * 64;
            float s = 0.f;
#pragma unroll
            for (int d = 0; d < 64; ++d) s = fmaf(q[d], kp[d], s);
            const int dy = rs + i - r + 7, dx = cs + j - c + 15;
            s = s * 0.125f + rpb[(h * 15 + dy) * 31 + dx];
            const float mn = fmaxf(m, s);
            const float alpha = expf(m - mn), pexp = expf(s - mn);
            lsum = lsum * alpha + pexp;
#pragma unroll
            for (int d = 0; d < 64; ++d) o[d] = o[d] * alpha + pexp * vp[d];
            m = mn;
        }
    }
    const float inv = 1.f / lsum;
    float* op = yna + (size_t)token * DS_ + h * 64;
#pragma unroll
    for (int d = 0; d < 64; ++d) op[d] = o[d] * inv;
}

__global__ void k_add(const float* __restrict__ a, const float* __restrict__ b, float* __restrict__ o, size_t n) {
    const size_t i = (size_t)blockIdx.x * blockDim.x + threadIdx.x;
    if (i < n) o[i] = a[i] + b[i];
}

__global__ __launch_bounds__(256) void k_router(const float* __restrict__ h2, const float* __restrict__ wr, float* __restrict__ aff_t) {
    const int token = blockIdx.x * 4 + (threadIdx.x >> 6), lane = threadIdx.x & 63;
    float acc[16];
#pragma unroll
    for (int e = 0; e < 16; ++e) acc[e] = 0.f;
    const float* hp = h2 + (size_t)token * D_;
    for (int k = lane; k < D_; k += 64) {
        const float hv = hp[k];
        const float4* w4 = (const float4*)(wr + (size_t)k * 16);
        const float4 w0 = w4[0], w1 = w4[1], w2 = w4[2], w3 = w4[3];
        acc[0] = fmaf(hv, w0.x, acc[0]); acc[1] = fmaf(hv, w0.y, acc[1]); acc[2] = fmaf(hv, w0.z, acc[2]); acc[3] = fmaf(hv, w0.w, acc[3]);
        acc[4] = fmaf(hv, w1.x, acc[4]); acc[5] = fmaf(hv, w1.y, acc[5]); acc[6] = fmaf(hv, w1.z, acc[6]); acc[7] = fmaf(hv, w1.w, acc[7]);
        acc[8] = fmaf(hv, w2.x, acc[8]); acc[9] = fmaf(hv, w2.y, acc[9]); acc[10] = fmaf(hv, w2.z, acc[10]); acc[11] = fmaf(hv, w2.w, acc[11]);
        acc[12] = fmaf(hv, w3.x, acc[12]); acc[13] = fmaf(hv, w3.y, acc[13]); acc[14] = fmaf(hv, w3.z, acc[14]); acc[15] = fmaf(hv, w3.w, acc[15]);
    }
    float mx = -1e30f;
#pragma unroll
    for (int e = 0; e < 16; ++e) { acc[e] = wave_sum(acc[e]); mx = fmaxf(mx, acc[e]); }
    float sum = 0.f;
#pragma unroll
    for (int e = 0; e < 16; ++e) { acc[e] = expf(acc[e] - mx); sum += acc[e]; }
    const float inv = 1.f / sum;
    if (lane == 0) {
#pragma unroll
        for (int e = 0; e < 16; ++e) aff_t[(size_t)e * L_ + token] = acc[e] * inv;
    }
}

__global__ __launch_bounds__(256) void k_topk(const float* __restrict__ aff_t, int* __restrict__ idx, float* __restrict__ gate) {
    const int e = blockIdx.y, i = blockIdx.x * 256 + threadIdx.x;
    const float* a = aff_t + (size_t)e * L_;
    const float v = a[i];
    int rank = 0;
    for (int j = 0; j < L_; ++j) { const float w = a[j]; rank += (w > v || (w == v && j < i)) ? 1 : 0; }
    if (rank < CAP_) { idx[e * CAP_ + rank] = i; gate[e * CAP_ + rank] = v; }
}

__global__ void k_silu_mul(float* __restrict__ G, const float* __restrict__ U, size_t n) {
    const size_t i = (size_t)blockIdx.x * blockDim.x + threadIdx.x;
    if (i < n) { const float g = G[i]; G[i] = g / (1.f + expf(-g)) * U[i]; }
}

__global__ __launch_bounds__(256) void k_scatter(const float* __restrict__ ye, const int* __restrict__ idx, const float* __restrict__ gate, float* __restrict__ x2) {
    const int em = blockIdx.x;
    const int token = idx[em]; const float gt = gate[em];
    const float* yp = ye + (size_t)em * D_;
    float* xp = x2 + (size_t)token * D_;
    for (int c = threadIdx.x; c < D_; c += 256) atomicAdd(xp + c, gt * yp[c]);
}

extern "C" void kernel_launch(void* const* d_in, const int* in_sizes, int n_in, void* d_out, int out_size, void* d_ws, size_t ws_size,
                              hipStream_t stream) {
    const float* x = (const float*)d_in[0];
    const float* g_mix = (const float*)d_in[1];
    const float* w_in = (const float*)d_in[2];
    const float* ssm_d = (const float*)d_in[17];
    const float* w_glu = (const float*)d_in[18];
    const float* b_glu = (const float*)d_in[19];
    const float* rpb = (const float*)d_in[20];
    const float* g_ssm = (const float*)d_in[21];
    const float* g_na = (const float*)d_in[22];
    const float* w_out = (const float*)d_in[23];
    const float* g_ffn = (const float*)d_in[24];
    const float* w_router = (const float*)d_in[25];
    const float* w_gate = (const float*)d_in[26];
    const float* w_up = (const float*)d_in[27];
    const float* w_down = (const float*)d_in[28];
    const float* g_final = (const float*)d_in[29];
    float* out = (float*)d_out;

    float* ws = (float*)d_ws;
    size_t off = 0;
    auto take = [&](size_t n) { float* p = ws + off; off += (n + 63) & ~(size_t)63; return p; };
    float* h = take((size_t)L_ * D_);
    float* proj = take((size_t)L_ * DIN_);
    float* abar = take(2 * NG_ * NP_ * 2);
    float* bbar = take(2 * NG_ * NP_ * 16 * 2);
    float* ydir = take((size_t)2 * L_ * DS_);
    float* ypre = take((size_t)L_ * DS_);
    float* zglu = take((size_t)L_ * DS_);
    float* yssm = take((size_t)L_ * DS_);
    float* yna = take((size_t)L_ * DS_);
    float* ymix = take((size_t)L_ * D_);
    float* tmp = take((size_t)L_ * D_);
    float* x1 = take((size_t)L_ * D_);
    float* h2 = take((size_t)L_ * D_);
    float* aff_t = take((size_t)NE_ * L_);
    int* idx = (int*)take((size_t)NE_ * CAP_);
    float* gate = take((size_t)NE_ * CAP_);
    float* Gb = take((size_t)NE_ * CAP_ * FF_);
    float* Ub = take((size_t)NE_ * CAP_ * FF_);
    float* x2 = take((size_t)L_ * D_);
    float* ye = proj;
    (void)ws_size; (void)n_in; (void)in_sizes; (void)out_size;

    k_rmsnorm<<<L_, 256, 0, stream>>>(x, D_, g_mix, h, D_, D_);
    k_gemm_f32<false><<<dim3(DIN_ / 64, L_ / 64, 1), 256, 0, stream>>>(h, D_, 0, nullptr, 0, w_in, DIN_, 0, proj, DIN_, 0, D_);
    k_ssm_setup<<<(2 * NG_ * NP_ + 255) / 256, 256, 0, stream>>>((const float*)d_in[3], (const float*)d_in[4], (const float*)d_in[5], (const float*)d_in[6], (const float*)d_in[7],
                                                                  (const float*)d_in[10], (const float*)d_in[11], (const float*)d_in[12], (const float*)d_in[13], (const float*)d_in[14], abar, bbar);
    k_ssm_scan<<<2 * NG_, 64, 0, stream>>>(proj, abar, bbar, (const float*)d_in[8], (const float*)d_in[9], (const float*)d_in[15], (const float*)d_in[16], ydir);
    k_ssm_combine<<<(L_ * DS_) / 256, 256, 0, stream>>>(ydir, proj, ssm_d, ypre);
    k_gemm_f32<false><<<dim3(DS_ / 64, L_ / 64, 1), 256, 0, stream>>>(ypre, DS_, 0, nullptr, 0, w_glu, DS_, 0, zglu, DS_, 0, DS_);
    k_glu<<<(L_ * DS_) / 256, 256, 0, stream>>>(ypre, zglu, b_glu, yssm);
    k_na<<<(L_ * 16) / 64, 64, 0, stream>>>(proj, rpb, yna);
    k_rmsnorm<<<L_, 256, 0, stream>>>(yssm, DS_, g_ssm, ymix, D_, DS_);
    k_rmsnorm<<<L_, 256, 0, stream>>>(yna, DS_, g_na, ymix + DS_, D_, DS_);
    k_gemm_f32<false><<<dim3(D_ / 64, L_ / 64, 1), 256, 0, stream>>>(ymix, D_, 0, nullptr, 0, w_out, D_, 0, tmp, D_, 0, D_);
    k_add<<<(unsigned)(((size_t)L_ * D_) / 256), 256, 0, stream>>>(x, tmp, x1, (size_t)L_ * D_);
    k_rmsnorm<<<L_, 256, 0, stream>>>(x1, D_, g_ffn, h2, D_, D_);
    k_router<<<L_ / 4, 256, 0, stream>>>(h2, w_router, aff_t);
    k_topk<<<dim3(L_ / 256, NE_), 256, 0, stream>>>(aff_t, idx, gate);
    k_gemm_f32<true><<<dim3(FF_ / 64, CAP_ / 64, NE_), 256, 0, stream>>>(h2, D_, 0, idx, CAP_, w_gate, FF_, (long)D_ * FF_, Gb, FF_, (long)CAP_ * FF_, D_);
    k_gemm_f32<true><<<dim3(FF_ / 64, CAP_ / 64, NE_), 256, 0, stream>>>(h2, D_, 0, idx, CAP_, w_up, FF_, (long)D_ * FF_, Ub, FF_, (long)CAP_ * FF_, D_);
    k_silu_mul<<<(unsigned)(((size_t)NE_ * CAP_ * FF_) / 256), 256, 0, stream>>>(Gb, Ub, (size_t)NE_ * CAP_ * FF_);
    k_gemm_f32<false><<<dim3(D_ / 64, CAP_ / 64, NE_), 256, 0, stream>>>(Gb, FF_, (long)CAP_ * FF_, nullptr, 0, w_down, D_, (long)FF_ * D_, ye, D_, (long)CAP_ * D_, FF_);
    hipMemcpyAsync(x2, x1, (size_t)L_ * D_ * sizeof(float), hipMemcpyDeviceToDevice, stream);
    k_scatter<<<NE_ * CAP_, 256, 0, stream>>>(ye, idx, gate, x2);
    k_rmsnorm<<<L_, 256, 0, stream>>>(x2, D_, g_final, out, D_, D_);
}
```

```cpp
#include <hip/hip_runtime.h>
#include <math.h>
#include <stdint.h>

#define L_   8192
#define D_   2048
#define DIN_ 4096
#define DS_  1024
#define NG_  64
#define NP_  64
#define NE_  16
#define CAP_ 1024
#define FF_  2048

__device__ __forceinline__ float wave_sum(float v) {
#pragma unroll
    for (int o = 32; o >= 1; o >>= 1) v += __shfl_xor(v, o);
    return v;
}

#include <hip/hip_cooperative_groups.h>
namespace cg = cooperative_groups;
#define XB_TMO      128
#define XB_XCNT(j)  (256  + 64 * (j))
#define XB_XSUB(j)  (1280 + 64 * (j))
#define XB_XGEN(j)  (2304 + 64 * (j))
#define XB_TOP      3328
#define XB_TOPGEN   3392
#define XCD_BAR_WORDS 3456
#define XB_SPIN_CAP (1u << 18)
#define LAS __attribute__((address_space(3)))
__device__ __forceinline__ unsigned xb_ld(unsigned* p)              { return __hip_atomic_load(p, __ATOMIC_RELAXED, __HIP_MEMORY_SCOPE_AGENT); }
__device__ __forceinline__ unsigned xb_add(unsigned* p, unsigned v) { return __hip_atomic_fetch_add(p, v, __ATOMIC_RELAXED, __HIP_MEMORY_SCOPE_AGENT); }
__device__ __forceinline__ unsigned xb_xcc_id() { return (unsigned)__builtin_amdgcn_s_getreg((3 << 11) | 20) & 0xFu; }
#define XB_SPIN(cond, bar) do { unsigned _sp = 0; while (cond) { __builtin_amdgcn_s_sleep(1); \
    if ((++_sp & 255u) == 0u) { if (xb_ld(&(bar)[XB_TMO])) break; if (_sp > XB_SPIN_CAP) { atomicAdd(&(bar)[XB_TMO], 1u); break; } } } } while (0)
struct XcdBarrier { unsigned* bar; unsigned x; volatile LAS unsigned* st; };
__device__ __forceinline__ XcdBarrier xcd_barrier_post(unsigned* bar, volatile LAS unsigned* st) {
    XcdBarrier b; b.bar = bar; b.x = xb_xcc_id(); b.st = st;
    if (threadIdx.x == 0) (void)xb_add(&bar[XB_XCNT(b.x)], 1u);
    return b;
}
__device__ __forceinline__ void xcd_barrier_complete(unsigned* bar, unsigned x, unsigned& nloc, unsigned& nx) {
    const unsigned G = gridDim.x * gridDim.y * gridDim.z;
    unsigned sum, cnt, mine, sp = 0u;
    for (;;) {
        sum = 0u; cnt = 0u; mine = 0u;
#pragma unroll
        for (unsigned j = 0; j < 16; ++j) { const unsigned c = xb_ld(&bar[XB_XCNT(j)]); sum += c; cnt += (c > 0u) ? 1u : 0u; mine = (j == x) ? c : mine; }
        if (sum == G) break;
        __builtin_amdgcn_s_sleep(1);
        if ((++sp & 255u) == 0u) { if (xb_ld(&bar[XB_TMO])) break; if (sp > XB_SPIN_CAP) { atomicAdd(&bar[XB_TMO], 1u); break; } }
    }
    nloc = mine > 0u ? mine : 1u; nx = cnt > 0u ? cnt : 1u;
}
__device__ __forceinline__ void xcd_barrier(const XcdBarrier& b) {
    asm volatile("s_waitcnt vmcnt(0)" ::: "memory");
    __syncthreads();
    if (threadIdx.x == 0) {
        unsigned* bar = b.bar;
        __builtin_amdgcn_s_waitcnt(0);
        unsigned nloc = b.st[0], nx = b.st[1];
        if (nloc == 0u) { xcd_barrier_complete(bar, b.x, nloc, nx); b.st[0] = nloc; b.st[1] = nx; }
        const unsigned old = xb_add(&bar[XB_XSUB(b.x)], 1u);
        const unsigned gen = old / nloc;
        if (old + 1u == (gen + 1u) * nloc) {
            __builtin_amdgcn_fence(__ATOMIC_RELEASE, "agent");
            asm volatile("s_waitcnt vmcnt(0)" ::: "memory");
            const unsigned og = xb_add(&bar[XB_TOP], 1u);
            const unsigned tg = og / nx;
            if (og + 1u == (tg + 1u) * nx) xb_add(&bar[XB_TOPGEN], 1u);
            else XB_SPIN(xb_ld(&bar[XB_TOPGEN]) == tg, bar);
            __builtin_amdgcn_fence(__ATOMIC_ACQUIRE, "agent");
            xb_add(&bar[XB_XGEN(b.x)], 1u);
            asm volatile("s_waitcnt vmcnt(0)" ::: "memory");
        } else {
            XB_SPIN(xb_ld(&bar[XB_XGEN(b.x)]) == gen, bar);
            __builtin_amdgcn_fence(__ATOMIC_ACQUIRE, "agent");
            asm volatile("s_waitcnt vmcnt(0)" ::: "memory");
        }
    }
    __syncthreads();
}

typedef short bf16x8 __attribute__((ext_vector_type(8)));
typedef float f32x4 __attribute__((ext_vector_type(4)));
typedef float f32x2 __attribute__((ext_vector_type(2)));
typedef __bf16 bf16x2v __attribute__((ext_vector_type(2)));
typedef unsigned short bf16_t;
#define NT_ 512
#define SM_MISC 0
#define SM_GEMM 1024
#define MK_LDS (144 * 1024)

__device__ __forceinline__ unsigned pk2(float lo, float hi) {
    f32x2 v = {lo, hi};
    return __builtin_bit_cast(unsigned, __builtin_convertvector(v, bf16x2v));
}
__device__ __forceinline__ float bf2f(bf16_t h) { return __uint_as_float(((unsigned)h) << 16); }
__device__ __forceinline__ float bflo(unsigned w) { return __uint_as_float(w << 16); }
__device__ __forceinline__ float bfhi(unsigned w) { return __uint_as_float(w & 0xffff0000u); }

struct MKParams {
    const float *x, *g_mix, *w_in;
    const float *a_re_f, *a_im_f, *ldt_f, *b_re_f, *b_im_f, *c_re_f, *c_im_f;
    const float *a_re_b, *a_im_b, *ldt_b, *b_re_b, *b_im_b, *c_re_b, *c_im_b;
    const float *ssm_d, *w_glu, *b_glu, *rpb, *g_ssm, *g_na, *w_out, *g_ffn, *w_router, *w_gate, *w_up, *w_down, *g_final;
    float* out;
    bf16_t* xn;
    float* rstd_x;
    bf16_t* ug;
    bf16_t* qb;
    bf16_t* kb;
    bf16_t* vT;
    bf16_t* KT;
    bf16_t* PBt;
    bf16_t* QBt;
    float* A64;
    float* Ebuf;
    bf16_t* ypre;
    bf16_t* ymix;
    float* ssq_na;
    float* ssq_ssm;
    bf16_t* x1g;
    float* ssq_x1;
    bf16_t* wrT;
    float* aff_t;
    float* rstd_x1;
    int* idx;
    float* gate;
    int* slot_of;
    bf16_t* act;
    bf16_t* ye;
    unsigned* bar;
    int never; int pad;
};

__device__ __forceinline__ int tile_off(int row, int chunk) { return row * 128 + (((chunk ^ (row >> 1)) & 7) << 4); }

template <int MT, bool TR, int BMODE, class ALoad, class BLoad, class Mid, class Epi>
__device__ __forceinline__ void gemm_tile(unsigned char* smem, const ALoad& al, const BLoad& bl, int ldb, int nkt, const Mid& mid, const Epi& epi) {
    int tid_ = threadIdx.x; asm volatile("" : "+v"(tid_));
    const int tid = tid_, lane = tid & 63, wave = tid >> 6;
    const int wr = wave >> 2, wc = wave & 3, fr = lane & 15, fq = lane >> 4;
    constexpr int AR = MT / 2;
    const bf16_t* aptr[AR];
#pragma unroll
    for (int i = 0; i < AR; ++i) {
        const int row = i * 64 + (tid >> 3);
        aptr[i] = al.row_ptr(row) + ((((lane & 7) ^ (row >> 1)) & 7) << 3);
    }
    const int a_lds = __builtin_amdgcn_readfirstlane(wave * 1024);
    const int b_kg = lane & 7, b_n4 = ((wave << 3) | (lane >> 3)) << 2;
    const float* bptr = nullptr;
    const bf16_t* bptr16[4];
    if constexpr (BMODE == 0) { bptr = bl.col_ptr(b_n4) + (size_t)(b_kg * 8) * ldb; }
    else {
#pragma unroll
        for (int i = 0; i < 4; ++i) { const int row = i * 64 + (tid >> 3); bptr16[i] = bl.row_ptr(row) + ((((lane & 7) ^ (row >> 1)) & 7) << 3); }
    }
    unsigned char* const sA = smem + SM_GEMM;
    unsigned char* const sB = smem + SM_GEMM + 32768;
    const int key = (fr >> 1) & 7;
    const int c0 = ((fq ^ key) & 7) << 4, c1 = (((fq | 4) ^ key) & 7) << 4;
    const int a_frag = (wr * (MT * 16) + fr) * 128;
    const int b_frag = (wc * 64 + fr) * 128;

    f32x4 acc[MT][4];
#pragma unroll
    for (int m = 0; m < MT; ++m)
#pragma unroll
        for (int n = 0; n < 4; ++n) acc[m][n] = (f32x4){0.f, 0.f, 0.f, 0.f};

    float4 rb[8];
    __syncthreads();
#pragma unroll
    for (int i = 0; i < AR; ++i)
        __builtin_amdgcn_global_load_lds((const unsigned*)aptr[i], (__attribute__((address_space(3))) unsigned*)(sA + a_lds + i * 8192), 16, 0, 0);
    if constexpr (BMODE == 0) {
#pragma unroll
        for (int j = 0; j < 8; ++j) rb[j] = *(const float4*)(bptr + (size_t)j * ldb);
        const float* f = (const float*)rb;
#pragma unroll
        for (int i = 0; i < 4; ++i) {
            uint4 w; w.x = pk2(f[0 * 4 + i], f[1 * 4 + i]); w.y = pk2(f[2 * 4 + i], f[3 * 4 + i]); w.z = pk2(f[4 * 4 + i], f[5 * 4 + i]); w.w = pk2(f[6 * 4 + i], f[7 * 4 + i]);
            *(uint4*)(sB + tile_off(b_n4 + i, b_kg)) = w;
        }
    } else {
#pragma unroll
        for (int i = 0; i < 4; ++i)
            __builtin_amdgcn_global_load_lds((const unsigned*)bptr16[i], (__attribute__((address_space(3))) unsigned*)(sB + a_lds + i * 8192), 16, 0, 0);
    }
    __syncthreads();
    for (int kt = 0; kt < nkt; ++kt) {
        const int cur = (kt & 1) * 65536;
        const int nxt = cur ^ 65536;
        const bool more = (kt + 1 < nkt);
        if (more) {
#pragma unroll
            for (int i = 0; i < AR; ++i)
                __builtin_amdgcn_global_load_lds((const unsigned*)(aptr[i] + (kt + 1) * 64), (__attribute__((address_space(3))) unsigned*)(sA + nxt + a_lds + i * 8192), 16, 0, 0);
            if constexpr (BMODE == 0) {
#pragma unroll
                for (int j = 0; j < 8; ++j) rb[j] = *(const float4*)(bptr + (size_t)((kt + 1) * 64 + j) * ldb);
            } else {
#pragma unroll
                for (int i = 0; i < 4; ++i)
                    __builtin_amdgcn_global_load_lds((const unsigned*)(bptr16[i] + (kt + 1) * 64), (__attribute__((address_space(3))) unsigned*)(sB + nxt + a_lds + i * 8192), 16, 0, 0);
            }
        }
        mid(kt, acc, wr, fr, fq);
#pragma unroll
        for (int ks = 0; ks < 2; ++ks) {
            const int co = ks ? c1 : c0;
            bf16x8 bfr[4];
#pragma unroll
            for (int n = 0; n < 4; ++n) bfr[n] = *(const bf16x8*)(sB + cur + b_frag + n * 2048 + co);
#pragma unroll
            for (int mh = 0; mh < MT / 4; ++mh) {
                bf16x8 af[4];
#pragma unroll
                for (int m = 0; m < 4; ++m) af[m] = *(const bf16x8*)(sA + cur + a_frag + (mh * 4 + m) * 2048 + co);
#pragma unroll
                for (int m = 0; m < 4; ++m)
#pragma unroll
                    for (int n = 0; n < 4; ++n)
                        acc[mh * 4 + m][n] = TR ? __builtin_amdgcn_mfma_f32_16x16x32_bf16(bfr[n], af[m], acc[mh * 4 + m][n], 0, 0, 0)
                                                : __builtin_amdgcn_mfma_f32_16x16x32_bf16(af[m], bfr[n], acc[mh * 4 + m][n], 0, 0, 0);
            }
        }
        if (BMODE == 0 && more) {
            const float* f = (const float*)rb;
#pragma unroll
            for (int i = 0; i < 4; ++i) {
                uint4 w; w.x = pk2(f[0 * 4 + i], f[1 * 4 + i]); w.y = pk2(f[2 * 4 + i], f[3 * 4 + i]); w.z = pk2(f[4 * 4 + i], f[5 * 4 + i]); w.w = pk2(f[6 * 4 + i], f[7 * 4 + i]);
                *(uint4*)(sB + nxt + tile_off(b_n4 + i, b_kg)) = w;
            }
        }
        __syncthreads();
    }
    epi(acc, wr, wc, fr, fq);
}

struct NoMid { template <class ACC> __device__ __forceinline__ void operator()(int, ACC&, int, int, int) const {} };
struct ARows { const bf16_t* base; int lda; __device__ __forceinline__ const bf16_t* row_ptr(int r) const { return base + (size_t)r * lda; } };
struct BCols { const float* base; __device__ __forceinline__ const float* col_ptr(int n4) const { return base + n4; } };

__device__ __forceinline__ void phase_prep(const MKParams& p) {
    const int lane = threadIdx.x & 63, wave = threadIdx.x >> 6;
    for (int row = blockIdx.x * 8 + wave; row < L_; row += gridDim.x * 8) {
        const float4* xr = (const float4*)(p.x + (size_t)row * D_);
        const float4* gr = (const float4*)p.g_mix;
        float s = 0.f;
        uint2* o = (uint2*)(p.xn + (size_t)row * D_);
#pragma unroll
        for (int j = 0; j < 8; ++j) {
            const float4 v = xr[lane + 64 * j]; const float4 g = gr[lane + 64 * j];
            s += v.x * v.x + v.y * v.y + v.z * v.z + v.w * v.w;
            uint2 w; w.x = pk2(v.x * g.x, v.y * g.y); w.y = pk2(v.z * g.z, v.w * g.w);
            o[lane + 64 * j] = w;
        }
        s = wave_sum(s);
        if (lane == 0) p.rstd_x[row] = 1.0f / sqrtf(s * (1.0f / D_) + 1e-6f);
    }
}

template <bool TR>
struct EpiInProj {
    const MKParams& p; int m0, n0;
    __device__ __forceinline__ void operator()(f32x4 (&acc)[8][4], int wr, int wc, int fr, int fq) const {
        if (TR) {
#pragma unroll
            for (int m = 0; m < 8; ++m) {
                const int token = m0 + wr * 128 + m * 16 + fr;
                const float rs = p.rstd_x[token];
#pragma unroll
                for (int nn = 0; nn < 4; ++nn) {
                    const int col = n0 + wc * 64 + nn * 16 + fq * 4;
                    const f32x4 a = acc[m][nn];
                    uint2 w;
                    if (n0 < 1024) {
                        w.x = pk2(a[0] * rs, a[1] * rs); w.y = pk2(a[2] * rs, a[3] * rs);
                        *(uint2*)(p.ug + ((size_t)(col >> 4) * L_ + token) * 16 + (col & 15)) = w;
                    } else if (n0 < 2048) {
                        const float r8 = rs * 0.125f;
                        w.x = pk2(a[0] * r8, a[1] * r8); w.y = pk2(a[2] * r8, a[3] * r8);
                        *(uint2*)(p.qb + (size_t)token * 1024 + (col - 1024)) = w;
                    } else {
                        w.x = pk2(a[0] * rs, a[1] * rs); w.y = pk2(a[2] * rs, a[3] * rs);
                        *(uint2*)(p.kb + (size_t)token * 1024 + (col - 2048)) = w;
                    }
                }
            }
        } else {
#pragma unroll
            for (int m = 0; m < 8; ++m) {
                const int token = m0 + wr * 128 + m * 16 + fq * 4;
                const float4 rs = *(const float4*)(p.rstd_x + token);
#pragma unroll
                for (int nn = 0; nn < 4; ++nn) {
                    const int f = n0 - 3072 + wc * 64 + nn * 16 + fr;
                    const f32x4 a = acc[m][nn];
                    uint2 w; w.x = pk2(a[0] * rs.x, a[1] * rs.y); w.y = pk2(a[2] * rs.z, a[3] * rs.w);
                    *(uint2*)(p.vT + (size_t)f * L_ + token) = w;
                }
            }
        }
    }
};

__device__ __forceinline__ void phase_inproj(const MKParams& p, unsigned char* smem) {
    for (int it = blockIdx.x; it < 512; it += gridDim.x) {
        const int xcd = it & 7, q = it >> 3;
        const int pn = (q & 1) * 8 + xcd;
        const int pm = q >> 1;
        const int m0 = pm * 256, n0 = pn * 256;
        ARows al{p.xn + (size_t)m0 * D_, D_};
        BCols bl{p.w_in + n0};
        if (n0 < 3072) gemm_tile<8, true, 0>(smem, al, bl, DIN_, D_ / 64, NoMid{}, EpiInProj<true>{p, m0, n0});
        else           gemm_tile<8, false, 0>(smem, al, bl, DIN_, D_ / 64, NoMid{}, EpiInProj<false>{p, m0, n0});
    }
}

struct BRows16 { const bf16_t* base; int ld; __device__ __forceinline__ const bf16_t* row_ptr(int r) const { return base + (size_t)r * ld; } };

__device__ __forceinline__ void ssm_tables(const MKParams& p, unsigned char* smem, int g, int part) {
    float2* apow = (float2*)(smem + SM_GEMM);
    float2* bbar = apow + 2 * 65 * 64;
    float2* cc = bbar + 2 * 64 * 16;
    const int tid = threadIdx.x;
    __syncthreads();
    for (int idx = tid; idx < 2 * 65 * 64; idx += NT_) {
        const int d = idx / (65 * 64), t = (idx % (65 * 64)) >> 6, pp = idx & 63;
        const float lr = (d ? p.a_re_b : p.a_re_f)[g * 64 + pp], li = (d ? p.a_im_b : p.a_im_f)[g * 64 + pp];
        const float dt = expf((d ? p.ldt_b : p.ldt_f)[g]);
        const float x = lr * dt * (float)t, y = li * dt * (float)t;
        const float ex = expf(x);
        apow[idx] = make_float2(ex * cosf(y), ex * sinf(y));
    }
    for (int idx = tid; idx < 2 * 64 * 16; idx += NT_) {
        {
            const int d = idx >> 10, pp = (idx >> 4) & 63, ci = idx & 15;
            const float lr = (d ? p.a_re_b : p.a_re_f)[g * 64 + pp], li = (d ? p.a_im_b : p.a_im_f)[g * 64 + pp];
            const float dt = expf((d ? p.ldt_b : p.ldt_f)[g]);
            const float x = lr * dt, y = li * dt;
            const float ex = expf(x), cy = cosf(y), sy = sinf(y), sh = sinf(0.5f * y);
            const float nr = expm1f(x) * cy - 2.f * sh * sh, ni = ex * sy;
            const float den = lr * lr + li * li;
            const float fr_ = (nr * lr + ni * li) / den, fi_ = (ni * lr - nr * li) / den;
            const float br = (d ? p.b_re_b : p.b_re_f)[(g * 64 + pp) * 16 + ci], bi = (d ? p.b_im_b : p.b_im_f)[(g * 64 + pp) * 16 + ci];
            bbar[idx] = make_float2(fr_ * br - fi_ * bi, fr_ * bi + fi_ * br);
        }
        {
            const int d = idx >> 10, co = (idx >> 6) & 15, pp = idx & 63;
            cc[idx] = make_float2((d ? p.c_re_b : p.c_re_f)[(g * 16 + co) * 64 + pp], (d ? p.c_im_b : p.c_im_f)[(g * 16 + co) * 64 + pp]);
        }
    }
    __syncthreads();
    if (part == 0 && tid < 128) {
        const int d = tid >> 6, pp = tid & 63;
        const float2 a = apow[(d * 65 + 64) * 64 + pp];
        *(float2*)(p.A64 + ((size_t)(g * 2 + d) * 64 + pp) * 2) = a;
    }
    {
        const int di = part * 32 + (tid >> 4), co = tid & 15;
        if (di < 127) {
            const int delta = di - 63;
            float acc[16];
#pragma unroll
            for (int i = 0; i < 16; ++i) acc[i] = 0.f;
#pragma unroll
            for (int d = 0; d < 2; ++d) {
                const bool on = d ? (delta <= 0) : (delta >= 0);
                if (on) {
                    const int t = d ? -delta : delta;
                    const float2* ap = apow + (d * 65 + t) * 64;
                    const float2* cp = cc + (d * 16 + co) * 64;
                    for (int q = 0; q < 64; ++q) {
                        const float2 a = ap[q], c = cp[q];
                        const float car = c.x * a.x - c.y * a.y, cai = c.x * a.y + c.y * a.x;
                        const float2* bp = bbar + (d * 64 + q) * 16;
#pragma unroll
                        for (int i = 0; i < 16; ++i) { const float2 b = bp[i]; acc[i] = fmaf(car, b.x, fmaf(-cai, b.y, acc[i])); }
                    }
                }
            }
            uint4 w0, w1;
            w0.x = pk2(acc[0], acc[1]); w0.y = pk2(acc[2], acc[3]); w0.z = pk2(acc[4], acc[5]); w0.w = pk2(acc[6], acc[7]);
            w1.x = pk2(acc[8], acc[9]); w1.y = pk2(acc[10], acc[11]); w1.z = pk2(acc[12], acc[13]); w1.w = pk2(acc[14], acc[15]);
            uint4* o = (uint4*)(p.KT + (((size_t)g * 127 + di) * 16 + co) * 16);
            o[0] = w0; o[1] = w1;
        }
    }
#pragma unroll 1
    for (int i = 0; i < 16; ++i) {
        const int it = tid + NT_ * i;
        const int n = part * 64 + (it >> 7), kc = it & 127;
        const int d = n >> 7, pp = (n >> 1) & 63, ri = n & 1, j = kc >> 1, half = kc & 1;
        const int t = d ? j : 63 - j;
        const float2 a = apow[(d * 65 + t) * 64 + pp];
        const float2* bp = bbar + (d * 64 + pp) * 16 + half * 8;
        float v[8];
#pragma unroll
        for (int q = 0; q < 8; ++q) { const float2 b = bp[q]; v[q] = ri ? (a.x * b.y + a.y * b.x) : (a.x * b.x - a.y * b.y); }
        uint4 w; w.x = pk2(v[0], v[1]); w.y = pk2(v[2], v[3]); w.z = pk2(v[4], v[5]); w.w = pk2(v[6], v[7]);
        *(uint4*)(p.PBt + ((size_t)g * 256 + n) * 1024 + kc * 8) = w;
    }
#pragma unroll 1
    for (int i = 0; i < 16; ++i) {
        const int it = tid + NT_ * i;
        const int n = part * 256 + (it >> 5), k2 = (it & 31) * 8;
        const int l = n >> 4, co = n & 15, d = k2 >> 7, pp0 = (k2 >> 1) & 63;
        const int t = d ? (64 - l) : (l + 1);
        float v[8];
#pragma unroll
        for (int q = 0; q < 4; ++q) {
            const float2 a = apow[(d * 65 + t) * 64 + pp0 + q], c = cc[(d * 16 + co) * 64 + pp0 + q];
            v[2 * q] = c.x * a.x - c.y * a.y; v[2 * q + 1] = -(c.x * a.y + c.y * a.x);
        }
        uint4 w; w.x = pk2(v[0], v[1]); w.y = pk2(v[2], v[3]); w.z = pk2(v[4], v[5]); w.w = pk2(v[6], v[7]);
        *(uint4*)(p.QBt + ((size_t)g * 1024 + n) * 256 + k2) = w;
    }
    __syncthreads();
}

struct EpiE {
    float* E;
    __device__ __forceinline__ void operator()(f32x4 (&acc)[4][4], int wr, int wc, int fr, int fq) const {
#pragma unroll
        for (int m = 0; m < 4; ++m)
#pragma unroll
            for (int nn = 0; nn < 4; ++nn)
                *(f32x4*)(E + (size_t)(wr * 64 + m * 16 + fr) * 256 + wc * 64 + nn * 16 + fq * 4) = acc[m][nn];
    }
};
__device__ __forceinline__ void ssm_e_item(const MKParams& p, unsigned char* smem, int g) {
    ARows al{p.ug + (size_t)g * L_ * 16, 1024};
    BRows16 bl{p.PBt + (size_t)g * 256 * 1024, 1024};
    gemm_tile<4, true, 1>(smem, al, bl, 0, 16, NoMid{}, EpiE{p.Ebuf + (size_t)g * 128 * 256});
}

#define SY_A   (SM_GEMM)
#define SY_S   (SM_GEMM + 32768)
#define SY_KT  (SM_GEMM + 98304)
__device__ __forceinline__ float gelu_tanh_f(float x) {
    const float k0 = 0.7978845608028654f, k1 = 0.044715f;
    const float z = k0 * (x + k1 * x * x * x);
    const float e = __expf(2.f * z);
    return 0.5f * x * (2.f - 2.f / (1.f + e));
}
__device__ __forceinline__ void ssm_y_item(const MKParams& p, unsigned char* smem, int g, int nq) {
    int tid_ = threadIdx.x; asm volatile("" : "+v"(tid_));
    const int tid = tid_, lane = tid & 63, wave = tid >> 6;
    const int wr = wave >> 2, wc = wave & 3, fr = lane & 15, fq = lane >> 4;
    __syncthreads();
    {
        const uint4* src = (const uint4*)(p.KT + ((size_t)g * 127 + 16 * nq) * 256);
        uint4* dst = (uint4*)(smem + SY_KT);
        for (int i = tid; i < 79 * 32; i += NT_) dst[i] = src[i];
    }
    if (tid < 128) {
        const int d = tid >> 6, pp = tid & 63;
        const float2 A = *(const float2*)(p.A64 + ((size_t)(g * 2 + d) * 64 + pp) * 2);
        const float* E = p.Ebuf + (size_t)g * 128 * 256 + d * 128 + pp * 2;
        unsigned char* sb = smem + SY_S + (d * 2 + (pp >> 5)) * 16384 + (pp & 3) * 4;
        const int chunk = (pp & 31) >> 2;
        float sr = 0.f, si = 0.f;
#pragma unroll 8
        for (int s = 0; s < 128; ++s) {
            const int c = d ? (127 - s) : s;
            const float2 e = *(const float2*)(E + (size_t)c * 256);
            *(unsigned*)(sb + tile_off(c, chunk)) = pk2(sr, si);
            const float nr = A.x * sr - A.y * si + e.x, ni = A.x * si + A.y * sr + e.y;
            sr = nr; si = ni;
        }
    }
    const bf16_t* aptr[2];
#pragma unroll
    for (int i = 0; i < 2; ++i) {
        const int row = i * 64 + (tid >> 3);
        aptr[i] = p.ug + (size_t)g * L_ * 16 + (size_t)row * 1024 + ((((lane & 7) ^ (row >> 1)) & 7) << 3);
    }
    const int a_lds = __builtin_amdgcn_readfirstlane(wave * 1024);
    const int key = (fr >> 1) & 7;
    const int c0 = ((fq ^ key) & 7) << 4, c1 = (((fq | 4) ^ key) & 7) << 4;
    const int a_frag = (wr * 64 + fr) * 128;
    f32x4 acc[4][4];
#pragma unroll
    for (int m = 0; m < 4; ++m)
#pragma unroll
        for (int n = 0; n < 4; ++n) acc[m][n] = (f32x4){0.f, 0.f, 0.f, 0.f};
#pragma unroll
    for (int i = 0; i < 2; ++i)
        __builtin_amdgcn_global_load_lds((const unsigned*)aptr[i], (__attribute__((address_space(3))) unsigned*)(smem + SY_A + a_lds + i * 8192), 16, 0, 0);
    __syncthreads();
    const int kt_lane = SY_KT + fr * 32 + (fq & 1) * 16;
    for (int kt = 0; kt < 16; ++kt) {
        const int cur = (kt & 1) * 16384, nxt = cur ^ 16384;
        if (kt + 1 < 16) {
#pragma unroll
            for (int i = 0; i < 2; ++i)
                __builtin_amdgcn_global_load_lds((const unsigned*)(aptr[i] + (kt + 1) * 64), (__attribute__((address_space(3))) unsigned*)(smem + SY_A + nxt + a_lds + i * 8192), 16, 0, 0);
        }
#pragma unroll
        for (int ks = 0; ks < 2; ++ks) {
            const int co = ks ? c1 : c0;
            const int j = kt * 4 + ks * 2 + (fq >> 1);
            bf16x8 bfr[4], af[4];
#pragma unroll
            for (int nn = 0; nn < 4; ++nn) bfr[nn] = *(const bf16x8*)(smem + kt_lane + (wc * 4 + nn - j + 63) * 512);
#pragma unroll
            for (int m = 0; m < 4; ++m) af[m] = *(const bf16x8*)(smem + SY_A + cur + a_frag + m * 2048 + co);
#pragma unroll
            for (int m = 0; m < 4; ++m)
#pragma unroll
                for (int nn = 0; nn < 4; ++nn) acc[m][nn] = __builtin_amdgcn_mfma_f32_16x16x32_bf16(bfr[nn], af[m], acc[m][nn], 0, 0, 0);
        }
        __syncthreads();
    }
    {
        const bf16_t* qrow = p.QBt + ((size_t)g * 1024 + (16 * nq + wc * 4) * 16 + fr) * 256 + fq * 8;
#pragma unroll 1
        for (int kt2 = 0; kt2 < 4; ++kt2) {
#pragma unroll
            for (int ks = 0; ks < 2; ++ks) {
                const int co = ks ? c1 : c0;
                bf16x8 bfr[4], af[4];
#pragma unroll
                for (int nn = 0; nn < 4; ++nn) bfr[nn] = *(const bf16x8*)(qrow + (size_t)nn * 16 * 256 + kt2 * 64 + ks * 32);
#pragma unroll
                for (int m = 0; m < 4; ++m) af[m] = *(const bf16x8*)(smem + SY_S + kt2 * 16384 + a_frag + m * 2048 + co);
#pragma unroll
                for (int m = 0; m < 4; ++m)
#pragma unroll
                    for (int nn = 0; nn < 4; ++nn) acc[m][nn] = __builtin_amdgcn_mfma_f32_16x16x32_bf16(bfr[nn], af[m], acc[m][nn], 0, 0, 0);
            }
        }
    }
    {
        const float4 dsk = *(const float4*)(p.ssm_d + g * 16 + fq * 4);
#pragma unroll
        for (int m = 0; m < 4; ++m)
#pragma unroll
            for (int nn = 0; nn < 4; ++nn) {
                const int token = (wr * 64 + m * 16 + fr) * 64 + 16 * nq + wc * 4 + nn;
                const uint2 uu = *(const uint2*)(p.ug + ((size_t)g * L_ + token) * 16 + fq * 4);
                const f32x4 a = acc[m][nn];
                const float y0 = gelu_tanh_f(a[0] + dsk.x * bflo(uu.x)), y1 = gelu_tanh_f(a[1] + dsk.y * bfhi(uu.x));
                const float y2 = gelu_tanh_f(a[2] + dsk.z * bflo(uu.y)), y3 = gelu_tanh_f(a[3] + dsk.w * bfhi(uu.y));
                uint2 w; w.x = pk2(y0, y1); w.y = pk2(y2, y3);
                *(uint2*)(p.ypre + (size_t)token * DS_ + g * 16 + fq * 4) = w;
            }
    }
}

#define NA_RPB (SM_GEMM + 1024)
__device__ __forceinline__ void na_item(const MKParams& p, unsigned char* smem, int r, int half) {
    int tid_ = threadIdx.x; asm volatile("" : "+v"(tid_));
    const int tid = tid_, lane = tid & 63, wave = tid >> 6, fr = lane & 15, fq = lane >> 4;
    const int h = half * 8 + wave;
    __syncthreads();
    { float* dst = (float*)(smem + NA_RPB); for (int i = tid; i < 16 * 15 * 31; i += NT_) dst[i] = p.rpb[i]; }
    __syncthreads();
    int rs = r - 4; rs = rs < 0 ? 0 : (rs > 120 ? 120 : rs);
    bf16x8 qf[4][2];
#pragma unroll
    for (int qb = 0; qb < 4; ++qb)
#pragma unroll
        for (int ks = 0; ks < 2; ++ks) qf[qb][ks] = *(const bf16x8*)(p.qb + (size_t)(r * 64 + qb * 16 + fr) * 1024 + h * 64 + ks * 32 + fq * 8);
    int kbq[4], dxq[4];
#pragma unroll
    for (int qb = 0; qb < 4; ++qb) {
        const int c = qb * 16 + fr;
        int cs = c - 8; cs = cs < 0 ? 0 : (cs > 48 ? 48 : cs);
        kbq[qb] = 8 * fq - cs;
        dxq[qb] = (8 * fq - c + 15) * 4;
    }
    f32x4 o[4][4];
    float mrow[4], lrow[4];
#pragma unroll
    for (int qb = 0; qb < 4; ++qb) {
        mrow[qb] = -1e30f; lrow[qb] = 0.f;
#pragma unroll
        for (int mt = 0; mt < 4; ++mt) o[qb][mt] = (f32x4){0.f, 0.f, 0.f, 0.f};
    }
    const int krow_lane = (8 * (fr >> 2) + (fr & 3)) * 1024 + h * 64 + fq * 8;
    const size_t v_lane = (size_t)(h * 64 + fr) * L_ + 8 * fq;
#pragma unroll 1
    for (int i = 0; i < 8; ++i) {
        const int tok0 = (rs + i) * 64;
        const bf16_t* kbase = p.kb + (size_t)tok0 * 1024 + krow_lane;
        const unsigned char* brow = smem + NA_RPB + ((h * 15 + (rs + i - r + 7)) * 31) * 4;
        f32x4 s[2][2][4];
#pragma unroll
        for (int P = 0; P < 2; ++P)
#pragma unroll
            for (int sx = 0; sx < 2; ++sx) {
                const bf16x8 k0 = *(const bf16x8*)(kbase + (32 * P + 4 * sx) * 1024);
                const bf16x8 k1 = *(const bf16x8*)(kbase + (32 * P + 4 * sx) * 1024 + 32);
#pragma unroll
                for (int qb = 0; qb < 4; ++qb) {
                    f32x4 a = (f32x4){0.f, 0.f, 0.f, 0.f};
                    a = __builtin_amdgcn_mfma_f32_16x16x32_bf16(k0, qf[qb][0], a, 0, 0, 0);
                    a = __builtin_amdgcn_mfma_f32_16x16x32_bf16(k1, qf[qb][1], a, 0, 0, 0);
                    s[P][sx][qb] = a;
                }
            }
        unsigned pp[4][2][4];
#pragma unroll
        for (int qb = 0; qb < 4; ++qb) {
            const unsigned char* bq = brow + dxq[qb];
            float mx = -1e30f;
#pragma unroll
            for (int P = 0; P < 2; ++P)
#pragma unroll
                for (int sx = 0; sx < 2; ++sx)
#pragma unroll
                    for (int rg = 0; rg < 4; ++rg) {
                        const int cst = 32 * P + 4 * sx + rg;
                        const bool valid = (unsigned)(cst + kbq[qb]) < 16u;
                        const float b = *(const float*)(bq + cst * 4);
                        const float v = valid ? (s[P][sx][qb][rg] + b) : -1e30f;
                        s[P][sx][qb][rg] = v;
                        mx = fmaxf(mx, v);
                    }
            mx = fmaxf(mx, __shfl_xor(mx, 16));
            mx = fmaxf(mx, __shfl_xor(mx, 32));
            const float mn = fmaxf(mrow[qb], mx);
            const float alpha = __expf(mrow[qb] - mn);
            mrow[qb] = mn;
            float ls = 0.f;
#pragma unroll
            for (int P = 0; P < 2; ++P)
#pragma unroll
                for (int sx = 0; sx < 2; ++sx) {
                    float e[4];
#pragma unroll
                    for (int rg = 0; rg < 4; ++rg) { e[rg] = __expf(s[P][sx][qb][rg] - mn); ls += e[rg]; }
                    pp[qb][P][sx * 2 + 0] = pk2(e[0], e[1]);
                    pp[qb][P][sx * 2 + 1] = pk2(e[2], e[3]);
                }
            lrow[qb] = lrow[qb] * alpha + ls;
#pragma unroll
            for (int mt = 0; mt < 4; ++mt) o[qb][mt] *= alpha;
        }
#pragma unroll
        for (int P = 0; P < 2; ++P)
#pragma unroll
            for (int mt = 0; mt < 4; ++mt) {
                const bf16x8 vf = *(const bf16x8*)(p.vT + v_lane + (size_t)mt * 16 * L_ + tok0 + 32 * P);
#pragma unroll
                for (int qb = 0; qb < 4; ++qb) {
                    uint4 w; w.x = pp[qb][P][0]; w.y = pp[qb][P][1]; w.z = pp[qb][P][2]; w.w = pp[qb][P][3];
                    o[qb][mt] = __builtin_amdgcn_mfma_f32_16x16x32_bf16(vf, __builtin_bit_cast(bf16x8, w), o[qb][mt], 0, 0, 0);
                }
            }
    }
#pragma unroll
    for (int qb = 0; qb < 4; ++qb) {
        float l = lrow[qb];
        l += __shfl_xor(l, 16); l += __shfl_xor(l, 32);
        const float inv = 1.f / l;
        const int token = r * 64 + qb * 16 + fr;
        float ss = 0.f;
#pragma unroll
        for (int mt = 0; mt < 4; ++mt) {
            const float4 g = *(const float4*)(p.g_na + h * 64 + mt * 16 + 4 * fq);
            const f32x4 v = o[qb][mt] * inv;
            ss += v[0] * v[0] + v[1] * v[1] + v[2] * v[2] + v[3] * v[3];
            uint2 w; w.x = pk2(v[0] * g.x, v[1] * g.y); w.y = pk2(v[2] * g.z, v[3] * g.w);
            *(uint2*)(p.ymix + (size_t)token * D_ + DS_ + h * 64 + mt * 16 + 4 * fq) = w;
        }
        ss += __shfl_xor(ss, 16); ss += __shfl_xor(ss, 32);
        if (fq == 0) p.ssq_na[token * 16 + h] = ss;
    }
}

struct EpiGlu {
    const MKParams& p; int m0, n0, pn;
    __device__ __forceinline__ void operator()(f32x4 (&acc)[4][4], int wr, int wc, int fr, int fq) const {
#pragma unroll
        for (int m = 0; m < 4; ++m) {
            const int token = m0 + wr * 64 + m * 16 + fr;
            float ss = 0.f;
#pragma unroll
            for (int nn = 0; nn < 4; ++nn) {
                const int col = n0 + wc * 64 + nn * 16 + fq * 4;
                const float4 b = *(const float4*)(p.b_glu + col);
                const float4 g = *(const float4*)(p.g_ssm + col);
                const uint2 yy = *(const uint2*)(p.ypre + (size_t)token * DS_ + col);
                const f32x4 a = acc[m][nn];
                const float y0 = bflo(yy.x) / (1.f + __expf(-(a[0] + b.x))), y1 = bfhi(yy.x) / (1.f + __expf(-(a[1] + b.y)));
                const float y2 = bflo(yy.y) / (1.f + __expf(-(a[2] + b.z))), y3 = bfhi(yy.y) / (1.f + __expf(-(a[3] + b.w)));
                ss += y0 * y0 + y1 * y1 + y2 * y2 + y3 * y3;
                uint2 w; w.x = pk2(y0 * g.x, y1 * g.y); w.y = pk2(y2 * g.z, y3 * g.w);
                *(uint2*)(p.ymix + (size_t)token * D_ + col) = w;
            }
            ss += __shfl_xor(ss, 16); ss += __shfl_xor(ss, 32);
            if (fq == 0) p.ssq_ssm[token * 16 + pn * 4 + wc] = ss;
        }
    }
};
__device__ __forceinline__ void glu_item(const MKParams& p, unsigned char* smem, int it) {
    const int q = it >> 3, pn = q & 3, pm = (it & 7) + 8 * (q >> 2);
    const int m0 = pm * 128, n0 = pn * 256;
    ARows al{p.ypre + (size_t)m0 * DS_, DS_};
    BCols bl{p.w_glu + n0};
    gemm_tile<4, true, 0>(smem, al, bl, DS_, DS_ / 64, NoMid{}, EpiGlu{p, m0, n0, pn});
}

__device__ __forceinline__ float rstd16(const float* part) {
    const float4 a = ((const float4*)part)[0], b = ((const float4*)part)[1], c = ((const float4*)part)[2], d = ((const float4*)part)[3];
    const float s = ((a.x + a.y) + (a.z + a.w)) + ((b.x + b.y) + (b.z + b.w)) + ((c.x + c.y) + (c.z + c.w)) + ((d.x + d.y) + (d.z + d.w));
    return 1.0f / sqrtf(s * (1.0f / DS_) + 1e-6f);
}
struct MidOut {
    const MKParams& p; int m0;
    __device__ __forceinline__ void operator()(int kt, f32x4 (&acc)[8][4], int wr, int fr, int fq) const {
        if (kt == 16) {
#pragma unroll
            for (int m = 0; m < 8; ++m) {
                const int token = m0 + wr * 128 + m * 16 + fr;
                const float ratio = rstd16(p.ssq_ssm + token * 16) / rstd16(p.ssq_na + token * 16);
#pragma unroll
                for (int nn = 0; nn < 4; ++nn) acc[m][nn] *= ratio;
            }
        }
    }
};
struct EpiOut {
    const MKParams& p; int m0, n0, pn;
    __device__ __forceinline__ void operator()(f32x4 (&acc)[8][4], int wr, int wc, int fr, int fq) const {
#pragma unroll
        for (int m = 0; m < 8; ++m) {
            const int token = m0 + wr * 128 + m * 16 + fr;
            const float rn = rstd16(p.ssq_na + token * 16);
            float ss = 0.f;
#pragma unroll
            for (int nn = 0; nn < 4; ++nn) {
                const int col = n0 + wc * 64 + nn * 16 + fq * 4;
                const float4 xv = *(const float4*)(p.x + (size_t)token * D_ + col);
                const float4 g = *(const float4*)(p.g_ffn + col);
                const f32x4 a = acc[m][nn];
                const float v0 = xv.x + a[0] * rn, v1 = xv.y + a[1] * rn, v2 = xv.z + a[2] * rn, v3 = xv.w + a[3] * rn;
                ss += v0 * v0 + v1 * v1 + v2 * v2 + v3 * v3;
                uint2 w; w.x = pk2(v0 * g.x, v1 * g.y); w.y = pk2(v2 * g.z, v3 * g.w);
                *(uint2*)(p.x1g + (size_t)token * D_ + col) = w;
            }
            ss += __shfl_xor(ss, 16); ss += __shfl_xor(ss, 32);
            if (fq == 0) p.ssq_x1[token * 32 + pn * 4 + wc] = ss;
        }
    }
};
__device__ __forceinline__ void outproj_item(const MKParams& p, unsigned char* smem, int it) {
    const int pn = it & 7, pm = it >> 3;
    const int m0 = pm * 256, n0 = pn * 256;
    ARows al{p.ymix + (size_t)m0 * D_, D_};
    BCols bl{p.w_out + n0};
    gemm_tile<8, true, 0>(smem, al, bl, D_, D_ / 64, MidOut{p, m0}, EpiOut{p, m0, n0, pn});
}

__device__ __forceinline__ void router_tile(const MKParams& p, int tile, int lane) {
    const int fr = lane & 15, fq = lane >> 4;
    const int token = tile * 16 + fr;
    const bf16_t* xr = p.x1g + (size_t)token * D_ + fq * 8;
    const bf16_t* wh = p.wrT + (size_t)fr * D_ + fq * 8;
    const bf16_t* wl = wh + 16 * D_;
    f32x4 ah = (f32x4){0.f, 0.f, 0.f, 0.f}, alo = (f32x4){0.f, 0.f, 0.f, 0.f};
#pragma unroll 4
    for (int k = 0; k < D_; k += 32) {
        const bf16x8 xb = *(const bf16x8*)(xr + k);
        ah = __builtin_amdgcn_mfma_f32_16x16x32_bf16(*(const bf16x8*)(wh + k), xb, ah, 0, 0, 0);
        alo = __builtin_amdgcn_mfma_f32_16x16x32_bf16(*(const bf16x8*)(wl + k), xb, alo, 0, 0, 0);
    }
    const float4 s0 = *(const float4*)(p.ssq_x1 + token * 32 + fq * 8), s1 = *(const float4*)(p.ssq_x1 + token * 32 + fq * 8 + 4);
    float ss = ((s0.x + s0.y) + (s0.z + s0.w)) + ((s1.x + s1.y) + (s1.z + s1.w));
    ss += __shfl_xor(ss, 16); ss += __shfl_xor(ss, 32);
    const float rs = 1.0f / sqrtf(ss * (1.0f / D_) + 1e-6f);
    float l[4];
#pragma unroll
    for (int i = 0; i < 4; ++i) l[i] = (ah[i] + alo[i]) * rs;
    float mx = fmaxf(fmaxf(l[0], l[1]), fmaxf(l[2], l[3]));
    mx = fmaxf(mx, __shfl_xor(mx, 16)); mx = fmaxf(mx, __shfl_xor(mx, 32));
    float e[4], sum = 0.f;
#pragma unroll
    for (int i = 0; i < 4; ++i) { e[i] = expf(l[i] - mx); sum += e[i]; }
    sum += __shfl_xor(sum, 16); sum += __shfl_xor(sum, 32);
    const float inv = 1.f / sum;
#pragma unroll
    for (int i = 0; i < 4; ++i) p.aff_t[(size_t)(4 * fq + i) * L_ + token] = e[i] * inv;
    if (fq == 0) p.rstd_x1[token] = rs;
}

#define TK_HIST (SM_GEMM)
#define TK_MISC (SM_GEMM + 1024)
#define TK_LIST (SM_GEMM + 2048)
__device__ __forceinline__ void topk_item(const MKParams& p, unsigned char* smem, int e) {
    const int tid = threadIdx.x, lane = tid & 63;
    unsigned* hist = (unsigned*)(smem + TK_HIST);
    unsigned* misc = (unsigned*)(smem + TK_MISC);
    unsigned* list = (unsigned*)(smem + TK_LIST);
    const float* a = p.aff_t + (size_t)e * L_;
    unsigned key[16];
#pragma unroll
    for (int i = 0; i < 16; ++i) key[i] = __float_as_uint(a[tid + NT_ * i]);
    __syncthreads();
    if (tid == 0) { misc[0] = 0u; misc[1] = CAP_; misc[2] = 0u; misc[3] = 0u; }
#pragma unroll 1
    for (int pass = 0; pass < 4; ++pass) {
        const int shift = 24 - 8 * pass;
        if (tid < 256) hist[tid] = 0u;
        __syncthreads();
        const unsigned prefix = misc[0];
        const unsigned himask = pass == 0 ? 0u : (0xffffffffu << (shift + 8));
#pragma unroll
        for (int i = 0; i < 16; ++i)
            if ((key[i] & himask) == prefix) atomicAdd(&hist[(key[i] >> shift) & 255u], 1u);
        __syncthreads();
        if (tid < 64) {
            const unsigned h0 = hist[4 * lane], h1 = hist[4 * lane + 1], h2 = hist[4 * lane + 2], h3 = hist[4 * lane + 3];
            const unsigned own = h0 + h1 + h2 + h3;
            unsigned suf = own;
#pragma unroll
            for (int o = 1; o < 64; o <<= 1) { const unsigned t = __shfl_down(suf, o); if (lane + o < 64) suf += t; }
            const unsigned above = suf - own;
            const unsigned k = misc[1];
            if (above < k && k <= suf) {
                unsigned cnt = above, dsel, kk;
                if (cnt + h3 >= k) { dsel = 3; kk = k - cnt; }
                else { cnt += h3; if (cnt + h2 >= k) { dsel = 2; kk = k - cnt; }
                else { cnt += h2; if (cnt + h1 >= k) { dsel = 1; kk = k - cnt; }
                else { cnt += h1; dsel = 0; kk = k - cnt; } } }
                misc[0] = prefix | ((4u * lane + dsel) << shift);
                misc[1] = kk;
            }
        }
        __syncthreads();
    }
    const unsigned tau = misc[0], krem = misc[1];
#pragma unroll
    for (int i = 0; i < 16; ++i)
        if (key[i] == tau) { const unsigned s = atomicAdd(&misc[3], 1u); list[s] = (unsigned)(tid + NT_ * i); }
    __syncthreads();
    const unsigned neq = misc[3];
#pragma unroll
    for (int i = 0; i < 16; ++i) {
        const int token = tid + NT_ * i;
        bool sel = key[i] > tau;
        if (key[i] == tau) {
            if (neq == krem) sel = true;
            else { unsigned rank = 0; for (unsigned j = 0; j < neq; ++j) rank += (list[j] < (unsigned)token) ? 1u : 0u; sel = rank < krem; }
        }
        int slot = -1;
        if (sel) {
            slot = (int)atomicAdd(&misc[2], 1u);
            p.idx[e * CAP_ + slot] = token;
            p.gate[e * CAP_ + slot] = __uint_as_float(key[i]);
        }
        p.slot_of[token * NE_ + e] = slot;
    }
    __syncthreads();
}

struct AGather { const bf16_t* base; const int* rows; __device__ __forceinline__ const bf16_t* row_ptr(int r) const { return base + (size_t)rows[r] * D_; } };
struct BMoe1 {
    const float* wg; long up_minus_gate; int col0;
    __device__ __forceinline__ const float* col_ptr(int n4) const {
        const int wc = n4 >> 6, nn = (n4 >> 4) & 3, i = n4 & 15;
        return wg + (long)(nn >> 1) * up_minus_gate + col0 + wc * 32 + (nn & 1) * 16 + i;
    }
};
struct EpiMoe1 {
    const MKParams& p; int e, mt, nt;
    __device__ __forceinline__ void operator()(f32x4 (&acc)[8][4], int wr, int wc, int fr, int fq) const {
#pragma unroll
        for (int m = 0; m < 8; ++m) {
            const int slot = mt * 256 + wr * 128 + m * 16 + fr;
            const float rs = p.rstd_x1[p.idx[e * CAP_ + slot]];
#pragma unroll
            for (int nn = 0; nn < 2; ++nn) {
                const f32x4 g = acc[m][nn] * rs, u = acc[m][nn + 2] * rs;
                float a[4];
#pragma unroll
                for (int i = 0; i < 4; ++i) a[i] = g[i] / (1.f + __expf(-g[i])) * u[i];
                uint2 w; w.x = pk2(a[0], a[1]); w.y = pk2(a[2], a[3]);
                *(uint2*)(p.act + (size_t)(e * CAP_ + slot) * FF_ + nt * 128 + wc * 32 + nn * 16 + fq * 4) = w;
            }
        }
    }
};
__device__ __forceinline__ void moe1_item(const MKParams& p, unsigned char* smem, int it) {
    const int rnd = it >> 8, b = it & 255, xcd = b & 7, s = b >> 3;
    const int mt = s & 3, wt = rnd * 64 + xcd * 8 + (s >> 2);
    const int e = wt >> 4, nt = wt & 15;
    AGather al{p.x1g, p.idx + e * CAP_ + mt * 256};
    BMoe1 bl{p.w_gate + (size_t)e * D_ * FF_, (long)(p.w_up - p.w_gate), nt * 128};
    gemm_tile<8, true, 0>(smem, al, bl, FF_, D_ / 64, NoMid{}, EpiMoe1{p, e, mt, nt});
}

struct EpiMoe2 {
    const MKParams& p; int e, mt, nt;
    __device__ __forceinline__ void operator()(f32x4 (&acc)[8][4], int wr, int wc, int fr, int fq) const {
#pragma unroll
        for (int m = 0; m < 8; ++m) {
            const int slot = mt * 256 + wr * 128 + m * 16 + fr;
            const float gt = p.gate[e * CAP_ + slot];
#pragma unroll
            for (int nn = 0; nn < 4; ++nn) {
                const f32x4 a = acc[m][nn] * gt;
                uint2 w; w.x = pk2(a[0], a[1]); w.y = pk2(a[2], a[3]);
                *(uint2*)(p.ye + (size_t)(e * CAP_ + slot) * D_ + nt * 256 + wc * 64 + nn * 16 + fq * 4) = w;
            }
        }
    }
};
__device__ __forceinline__ void moe2_item(const MKParams& p, unsigned char* smem, int it) {
    const int rnd = it >> 8, b = it & 255, xcd = b & 7, s = b >> 3;
    const int mt = s & 3, wt = rnd * 64 + xcd * 8 + (s >> 2);
    const int e = wt >> 3, nt = wt & 7;
    ARows al{p.act + (size_t)(e * CAP_ + mt * 256) * FF_, FF_};
    BCols bl{p.w_down + (size_t)e * FF_ * D_ + nt * 256};
    gemm_tile<8, true, 0>(smem, al, bl, D_, FF_ / 64, NoMid{}, EpiMoe2{p, e, mt, nt});
}

__device__ __forceinline__ void final_token(const MKParams& p, int token, int lane) {
    float v[4][8];
#pragma unroll
    for (int j = 0; j < 4; ++j) {
        const int n = j * 512 + lane * 8;
        const uint4 w = *(const uint4*)(p.x1g + (size_t)token * D_ + n);
        const float4 g0 = *(const float4*)(p.g_ffn + n), g1 = *(const float4*)(p.g_ffn + n + 4);
        v[j][0] = bflo(w.x) / g0.x; v[j][1] = bfhi(w.x) / g0.y; v[j][2] = bflo(w.y) / g0.z; v[j][3] = bfhi(w.y) / g0.w;
        v[j][4] = bflo(w.z) / g1.x; v[j][5] = bfhi(w.z) / g1.y; v[j][6] = bflo(w.w) / g1.z; v[j][7] = bfhi(w.w) / g1.w;
    }
#pragma unroll 1
    for (int e = 0; e < NE_; ++e) {
        const int slot = p.slot_of[token * NE_ + e];
        if (slot >= 0) {
            const bf16_t* yr = p.ye + (size_t)(e * CAP_ + slot) * D_;
#pragma unroll
            for (int j = 0; j < 4; ++j) {
                const uint4 w = *(const uint4*)(yr + j * 512 + lane * 8);
                v[j][0] += bflo(w.x); v[j][1] += bfhi(w.x); v[j][2] += bflo(w.y); v[j][3] += bfhi(w.y);
                v[j][4] += bflo(w.z); v[j][5] += bfhi(w.z); v[j][6] += bflo(w.w); v[j][7] += bfhi(w.w);
            }
        }
    }
    float ss = 0.f;
#pragma unroll
    for (int j = 0; j < 4; ++j)
#pragma unroll
        for (int i = 0; i < 8; ++i) ss += v[j][i] * v[j][i];
    ss = wave_sum(ss);
    const float rs = 1.0f / sqrtf(ss * (1.0f / D_) + 1e-6f);
#pragma unroll
    for (int j = 0; j < 4; ++j) {
        const int n = j * 512 + lane * 8;
        const float4 g0 = *(const float4*)(p.g_final + n), g1 = *(const float4*)(p.g_final + n + 4);
        float4 o0, o1;
        o0.x = v[j][0] * rs * g0.x; o0.y = v[j][1] * rs * g0.y; o0.z = v[j][2] * rs * g0.z; o0.w = v[j][3] * rs * g0.w;
        o1.x = v[j][4] * rs * g1.x; o1.y = v[j][5] * rs * g1.y; o1.z = v[j][6] * rs * g1.z; o1.w = v[j][7] * rs * g1.w;
        *(float4*)(p.out + (size_t)token * D_ + n) = o0;
        *(float4*)(p.out + (size_t)token * D_ + n + 4) = o1;
    }
}


__global__ __launch_bounds__(NT_, 2) void k_mega(MKParams p) {
    extern __shared__ __attribute__((aligned(16))) unsigned char smem[];
    volatile LAS unsigned* st = (volatile LAS unsigned*)smem;
    if (threadIdx.x < 4) st[threadIdx.x] = 0u;
    __syncthreads();
    XcdBarrier xb = xcd_barrier_post(p.bar, st);
    if (p.never) cg::this_grid().sync();
    const int G = gridDim.x, b = blockIdx.x;
    for (int it = b; it < 256; it += G) ssm_tables(p, smem, it >> 2, it & 3);
    phase_prep(p);
    for (int i = b * NT_ + threadIdx.x; i < NE_ * D_; i += G * NT_) {
        const int e = i >> 11, n = i & (D_ - 1);
        const float w = p.w_router[n * NE_ + e];
        const unsigned hi = pk2(w, 0.f) & 0xffffu;
        const float rem = w - __uint_as_float(hi << 16);
        p.wrT[i] = (bf16_t)hi; p.wrT[NE_ * D_ + i] = (bf16_t)(pk2(rem, 0.f) & 0xffffu);
    }
    xcd_barrier(xb);
    phase_inproj(p, smem);
    xcd_barrier(xb);
    for (int it = b; it < 64 + 256; it += G) {
        if (it < 64) ssm_e_item(p, smem, it);
        else { const int j = it - 64, q = j >> 3; na_item(p, smem, (j & 7) * 16 + (q >> 1), q & 1); }
    }
    xcd_barrier(xb);
    for (int it = b; it < 256; it += G) { const int q = it >> 3; ssm_y_item(p, smem, (it & 7) + 8 * (q >> 2), q & 3); }
    xcd_barrier(xb);
    for (int it = b; it < 256; it += G) glu_item(p, smem, it);
    xcd_barrier(xb);
    for (int it = b; it < 256; it += G) outproj_item(p, smem, it);
    xcd_barrier(xb);
    for (int t = b * 8 + (threadIdx.x >> 6); t < L_ / 16; t += G * 8) router_tile(p, t, threadIdx.x & 63);
    xcd_barrier(xb);
    for (int it = b; it < NE_; it += G) topk_item(p, smem, it);
    xcd_barrier(xb);
    for (int it = b; it < 1024; it += G) moe1_item(p, smem, it);
    xcd_barrier(xb);
    for (int it = b; it < 512; it += G) moe2_item(p, smem, it);
    xcd_barrier(xb);
    for (int t = b * 8 + (threadIdx.x >> 6); t < L_; t += G * 8) final_token(p, t, threadIdx.x & 63);
}

extern "C" void kernel_launch(void* const* d_in, const int* in_sizes, int n_in, void* d_out, int out_size, void* d_ws, size_t ws_size,
                              hipStream_t stream) {
    (void)in_sizes; (void)n_in; (void)out_size; (void)ws_size;
    static int grid = 0;
    if (!grid) {
        int dev = 0, cus = 0, per_cu = 0;
        (void)hipGetDevice(&dev);
        (void)hipDeviceGetAttribute(&cus, hipDeviceAttributeMultiprocessorCount, dev);
        (void)hipFuncSetAttribute((const void*)k_mega, hipFuncAttributeMaxDynamicSharedMemorySize, MK_LDS);
        (void)hipOccupancyMaxActiveBlocksPerMultiprocessor(&per_cu, (const void*)k_mega, NT_, MK_LDS);
        if (per_cu < 1) per_cu = 1;
        grid = cus;
    }
    MKParams mp{};
    const float* const* in = (const float* const*)d_in;
    mp.x = in[0]; mp.g_mix = in[1]; mp.w_in = in[2];
    mp.a_re_f = in[3]; mp.a_im_f = in[4]; mp.ldt_f = in[5]; mp.b_re_f = in[6]; mp.b_im_f = in[7]; mp.c_re_f = in[8]; mp.c_im_f = in[9];
    mp.a_re_b = in[10]; mp.a_im_b = in[11]; mp.ldt_b = in[12]; mp.b_re_b = in[13]; mp.b_im_b = in[14]; mp.c_re_b = in[15]; mp.c_im_b = in[16];
    mp.ssm_d = in[17]; mp.w_glu = in[18]; mp.b_glu = in[19]; mp.rpb = in[20]; mp.g_ssm = in[21]; mp.g_na = in[22]; mp.w_out = in[23];
    mp.g_ffn = in[24]; mp.w_router = in[25]; mp.w_gate = in[26]; mp.w_up = in[27]; mp.w_down = in[28]; mp.g_final = in[29];
    mp.out = (float*)d_out;
    unsigned char* ws = (unsigned char*)d_ws;
    size_t off = 0;
    auto take = [&](size_t bytes) { unsigned char* q = ws + off; off += (bytes + 255) & ~(size_t)255; return q; };
    mp.bar = (unsigned*)take(XCD_BAR_WORDS * 4);
    mp.xn = (bf16_t*)take((size_t)L_ * D_ * 2);
    mp.rstd_x = (float*)take(L_ * 4);
    mp.ug = (bf16_t*)take((size_t)L_ * DS_ * 2);
    mp.qb = (bf16_t*)take((size_t)L_ * DS_ * 2);
    mp.kb = (bf16_t*)take((size_t)L_ * DS_ * 2);
    mp.vT = (bf16_t*)take((size_t)L_ * DS_ * 2);
    mp.KT = (bf16_t*)take((size_t)64 * 127 * 256 * 2);
    mp.PBt = (bf16_t*)take((size_t)64 * 256 * 1024 * 2);
    mp.QBt = (bf16_t*)take((size_t)64 * 1024 * 256 * 2);
    mp.A64 = (float*)take(64 * 2 * 64 * 2 * 4);
    mp.Ebuf = (float*)take((size_t)64 * 128 * 256 * 4);
    mp.ypre = (bf16_t*)take((size_t)L_ * DS_ * 2);
    mp.ymix = (bf16_t*)take((size_t)L_ * D_ * 2);
    mp.ssq_na = (float*)take((size_t)L_ * 16 * 4);
    mp.ssq_ssm = (float*)take((size_t)L_ * 16 * 4);
    mp.x1g = (bf16_t*)take((size_t)L_ * D_ * 2);
    mp.ssq_x1 = (float*)take((size_t)L_ * 32 * 4);
    mp.wrT = (bf16_t*)take((size_t)2 * NE_ * D_ * 2);
    mp.aff_t = (float*)take((size_t)NE_ * L_ * 4);
    mp.rstd_x1 = (float*)take(L_ * 4);
    mp.idx = (int*)take(NE_ * CAP_ * 4);
    mp.gate = (float*)take(NE_ * CAP_ * 4);
    mp.slot_of = (int*)take((size_t)L_ * NE_ * 4);
    mp.act = (bf16_t*)take((size_t)NE_ * CAP_ * FF_ * 2);
    mp.ye = (bf16_t*)take((size_t)NE_ * CAP_ * D_ * 2);
    mp.never = 0; mp.pad = 0;
    (void)hipMemsetAsync(mp.bar, 0, XCD_BAR_WORDS * sizeof(unsigned), stream);
    void* args[] = {&mp};
    (void)hipLaunchCooperativeKernel((const void*)k_mega, dim3(grid), dim3(NT_), args, MK_LDS, stream);
}
```

```cpp
#include <hip/hip_runtime.h>
#include <math.h>
#include <stdint.h>

#define L_   8192
#define D_   2048
#define DIN_ 4096
#define DS_  1024
#define NG_  64
#define NP_  64
#define NE_  16
#define CAP_ 1024
#define FF_  2048

__device__ __forceinline__ float wave_sum(float v) {
#pragma unroll
    for (int o = 32; o >= 1; o >>= 1) v += __shfl_xor(v, o);
    return v;
}

#include <hip/hip_cooperative_groups.h>
namespace cg = cooperative_groups;
#define XB_TMO      128
#define XB_XCNT(j)  (256  + 64 * (j))
#define XB_XSUB(j)  (1280 + 64 * (j))
#define XB_XGEN(j)  (2304 + 64 * (j))
#define XB_TOP      3328
#define XB_TOPGEN   3392
#define XCD_BAR_WORDS 3456
#define XB_SPIN_CAP (1u << 18)
#define LAS __attribute__((address_space(3)))
__device__ __forceinline__ unsigned xb_ld(unsigned* p)              { return __hip_atomic_load(p, __ATOMIC_RELAXED, __HIP_MEMORY_SCOPE_AGENT); }
__device__ __forceinline__ unsigned xb_add(unsigned* p, unsigned v) { return __hip_atomic_fetch_add(p, v, __ATOMIC_RELAXED, __HIP_MEMORY_SCOPE_AGENT); }
__device__ __forceinline__ unsigned xb_xcc_id() { return (unsigned)__builtin_amdgcn_s_getreg((3 << 11) | 20) & 0xFu; }
#define XB_SPIN(cond, bar) do { unsigned _sp = 0; while (cond) { __builtin_amdgcn_s_sleep(1); \
    if ((++_sp & 255u) == 0u) { if (xb_ld(&(bar)[XB_TMO])) break; if (_sp > XB_SPIN_CAP) { atomicAdd(&(bar)[XB_TMO], 1u); break; } } } } while (0)
__device__ __forceinline__ void xcd_barrier_post(unsigned* bar, volatile LAS unsigned* st) {
    if (threadIdx.x == 0) { const unsigned x = xb_xcc_id(); const unsigned r = xb_add(&bar[XB_XCNT(x)], 1u); st[2] = x; st[3] = r; }
}
__device__ __forceinline__ void xcd_barrier_complete(unsigned* bar, unsigned x, unsigned& nloc, unsigned& nx) {
    const unsigned G = gridDim.x * gridDim.y * gridDim.z;
    unsigned sum, cnt, mine, sp = 0u;
    for (;;) {
        sum = 0u; cnt = 0u; mine = 0u;
#pragma unroll
        for (unsigned j = 0; j < 16; ++j) { const unsigned c = xb_ld(&bar[XB_XCNT(j)]); sum += c; cnt += (c > 0u) ? 1u : 0u; mine = (j == x) ? c : mine; }
        if (sum == G) break;
        __builtin_amdgcn_s_sleep(1);
        if ((++sp & 255u) == 0u) { if (xb_ld(&bar[XB_TMO])) break; if (sp > XB_SPIN_CAP) { atomicAdd(&bar[XB_TMO], 1u); break; } }
    }
    nloc = mine > 0u ? mine : 1u; nx = cnt > 0u ? cnt : 1u;
}
__device__ __forceinline__ void xcd_barrier(unsigned* bar, volatile LAS unsigned* st) {
    asm volatile("s_waitcnt vmcnt(0)" ::: "memory");
    __syncthreads();
    if (threadIdx.x == 0) {
        __builtin_amdgcn_s_waitcnt(0);
        const unsigned x = xb_xcc_id();
        unsigned nloc = st[0], nx = st[1];
        if (nloc == 0u) { xcd_barrier_complete(bar, x, nloc, nx); st[0] = nloc; st[1] = nx; }
        const unsigned old = xb_add(&bar[XB_XSUB(x)], 1u);
        const unsigned gen = old / nloc;
        if (old + 1u == (gen + 1u) * nloc) {
            __builtin_amdgcn_fence(__ATOMIC_RELEASE, "agent");
            asm volatile("s_waitcnt vmcnt(0)" ::: "memory");
            const unsigned og = xb_add(&bar[XB_TOP], 1u);
            const unsigned tg = og / nx;
            if (og + 1u == (tg + 1u) * nx) xb_add(&bar[XB_TOPGEN], 1u);
            else XB_SPIN(xb_ld(&bar[XB_TOPGEN]) == tg, bar);
            __builtin_amdgcn_fence(__ATOMIC_ACQUIRE, "agent");
            xb_add(&bar[XB_XGEN(x)], 1u);
            asm volatile("s_waitcnt vmcnt(0)" ::: "memory");
        } else {
            XB_SPIN(xb_ld(&bar[XB_XGEN(x)]) == gen, bar);
            __builtin_amdgcn_fence(__ATOMIC_ACQUIRE, "agent");
            asm volatile("s_waitcnt vmcnt(0)" ::: "memory");
        }
    }
    __syncthreads();
}

typedef short bf16x8 __attribute__((ext_vector_type(8)));
typedef float f32x4 __attribute__((ext_vector_type(4)));
typedef float f32x2 __attribute__((ext_vector_type(2)));
typedef __bf16 bf16x2v __attribute__((ext_vector_type(2)));
typedef unsigned short bf16_t;
#define NT_ 512
#define XN_LD (D_ + 64)
#define SM_MISC 0
#define SM_ROWS 1024
#define SM_GEMM 4096
#define MK_LDS (144 * 1024)

__device__ __forceinline__ unsigned pk2(float lo, float hi) {
    f32x2 v = {lo, hi};
    return __builtin_bit_cast(unsigned, __builtin_convertvector(v, bf16x2v));
}
__device__ __forceinline__ float bf2f(bf16_t h) { return __uint_as_float(((unsigned)h) << 16); }
__device__ __forceinline__ float bflo(unsigned w) { return __uint_as_float(w << 16); }
__device__ __forceinline__ float bfhi(unsigned w) { return __uint_as_float(w & 0xffff0000u); }

struct MKParams {
    const float *x, *g_mix, *w_in;
    const float *a_re_f, *a_im_f, *ldt_f, *b_re_f, *b_im_f, *c_re_f, *c_im_f;
    const float *a_re_b, *a_im_b, *ldt_b, *b_re_b, *b_im_b, *c_re_b, *c_im_b;
    const float *ssm_d, *w_glu, *b_glu, *rpb, *g_ssm, *g_na, *w_out, *g_ffn, *w_router, *w_gate, *w_up, *w_down, *g_final;
    float* out;
    bf16_t* xn;
    float* rstd_x;
    bf16_t* ug;
    bf16_t* qb;
    bf16_t* kb;
    bf16_t* vT;
    bf16_t* KT;
    bf16_t* PBt;
    bf16_t* QBt;
    float* A64;
    float* Ebuf;
    bf16_t* ypre;
    bf16_t* ymix;
    float* ssq_na;
    float* ssq_ssm;
    bf16_t* x1g;
    float* ssq_x1;
    bf16_t* wrT;
    float* aff_t;
    float* rstd_x1;
    int* idx;
    float* gate;
    int* slot_of;
    bf16_t* act;
    bf16_t* ye;
    bf16_t* w_in_t;
    bf16_t* w_out_t;
    bf16_t *w_gate_t, *w_up_t, *w_down_t;
    unsigned* bar;
    int never; int pad;
};

#define GAS __attribute__((address_space(1)))
template <class T> __device__ __forceinline__ const GAS T* uniform_ptr(const T* p) {
    const unsigned long long v = (unsigned long long)p;
    const unsigned lo = __builtin_amdgcn_readfirstlane((unsigned)v), hi = __builtin_amdgcn_readfirstlane((unsigned)(v >> 32));
    return (const GAS T*)(((unsigned long long)hi << 32) | lo);
}
__device__ __forceinline__ int tile_off(int row, int chunk) { return row * 128 + (((chunk ^ (row >> 1)) & 7) << 4); }

template <int MT, bool TR, int BMODE, class ALoad, class BLoad, class Mid, class Epi>
__device__ __forceinline__ void gemm_tile(unsigned char* smem, const ALoad& al, const BLoad& bl, int ldb, int nkt, const Mid& mid, const Epi& epi) {
    int tid_ = threadIdx.x; asm volatile("" : "+v"(tid_));
    const int tid = tid_, lane = tid & 63, wave = tid >> 6;
    const int wr = wave >> 2, wc = wave & 3, fr = lane & 15, fq = lane >> 4;
    constexpr int AR = MT / 2;
    const GAS bf16_t* const abase = uniform_ptr(al.ubase());
    unsigned aoff[AR];
#pragma unroll
    for (int i = 0; i < AR; ++i) {
        const int row = i * 64 + (tid >> 3);
        aoff[i] = al.row_off(row) + (unsigned)((((lane & 7) ^ (row >> 1)) & 7) << 3);
    }
    const int a_lds = __builtin_amdgcn_readfirstlane(wave * 1024);
    const int b_kg = lane & 7, b_n4 = ((wave << 3) | (lane >> 3)) << 2;
    const auto* const bbase = uniform_ptr(bl.ubase(__builtin_amdgcn_readfirstlane(wave)));
    unsigned boff = 0, boff16[4];
    if constexpr (BMODE == 0) { boff = bl.col_off(b_n4) + (unsigned)(b_kg * 8) * (unsigned)ldb; }
    else {
#pragma unroll
        for (int i = 0; i < 4; ++i) { const int row = i * 64 + (tid >> 3); boff16[i] = bl.row_off(row) + (unsigned)((((lane & 7) ^ (row >> 1)) & 7) << 3); }
    }
    unsigned char* const sA = smem + SM_GEMM;
    unsigned char* const sB = smem + SM_GEMM + 32768;
    const int key = (fr >> 1) & 7;
    const int c0 = ((fq ^ key) & 7) << 4, c1 = (((fq | 4) ^ key) & 7) << 4;
    const int a_frag = (wr * (MT * 16) + fr) * 128;
    const int b_frag = (wc * 64 + fr) * 128;

    f32x4 acc[MT][4];
#pragma unroll
    for (int m = 0; m < MT; ++m)
#pragma unroll
        for (int n = 0; n < 4; ++n) acc[m][n] = (f32x4){0.f, 0.f, 0.f, 0.f};

    f32x4 rb[8];
    __syncthreads();
#pragma unroll
    for (int i = 0; i < AR; ++i)
        __builtin_amdgcn_global_load_lds((const GAS unsigned*)(abase + aoff[i]), (__attribute__((address_space(3))) unsigned*)(sA + a_lds + i * 8192), 16, 0, 0);
    if constexpr (BMODE == 0) {
#pragma unroll
        for (int j = 0; j < 8; ++j) rb[j] = *(const GAS f32x4*)((const GAS float*)bbase + (size_t)j * ldb + boff);
        const float* f = (const float*)rb;
#pragma unroll
        for (int i = 0; i < 4; ++i) {
            uint4 w; w.x = pk2(f[0 * 4 + i], f[1 * 4 + i]); w.y = pk2(f[2 * 4 + i], f[3 * 4 + i]); w.z = pk2(f[4 * 4 + i], f[5 * 4 + i]); w.w = pk2(f[6 * 4 + i], f[7 * 4 + i]);
            *(uint4*)(sB + tile_off(b_n4 + i, b_kg)) = w;
        }
    } else {
#pragma unroll
        for (int i = 0; i < 4; ++i)
            __builtin_amdgcn_global_load_lds((const GAS unsigned*)((const GAS bf16_t*)bbase + boff16[i]), (__attribute__((address_space(3))) unsigned*)(sB + a_lds + i * 8192), 16, 0, 0);
    }
    __syncthreads();
    for (int kt = 0; kt < nkt; ++kt) {
        const int cur = (kt & 1) * 65536;
        const int nxt = cur ^ 65536;
        const bool more = (kt + 1 < nkt);
        if (more) {
#pragma unroll
            for (int i = 0; i < AR; ++i)
                __builtin_amdgcn_global_load_lds((const GAS unsigned*)(abase + (kt + 1) * 64 + aoff[i]), (__attribute__((address_space(3))) unsigned*)(sA + nxt + a_lds + i * 8192), 16, 0, 0);
            if constexpr (BMODE == 0) {
#pragma unroll
                for (int j = 0; j < 8; ++j) rb[j] = *(const GAS f32x4*)((const GAS float*)bbase + (size_t)((kt + 1) * 64 + j) * ldb + boff);
            } else {
#pragma unroll
                for (int i = 0; i < 4; ++i)
                    __builtin_amdgcn_global_load_lds((const GAS unsigned*)((const GAS bf16_t*)bbase + (kt + 1) * 64 + boff16[i]), (__attribute__((address_space(3))) unsigned*)(sB + nxt + a_lds + i * 8192), 16, 0, 0);
            }
        }
        mid(kt, acc, wr, fr, fq);
        constexpr int GQ = MT / 2, NG = 2 * GQ;
        bf16x8 bfr[4], af[2][2];
#pragma unroll
        for (int n = 0; n < 4; ++n) bfr[n] = *(const bf16x8*)(sB + cur + b_frag + n * 2048 + c0);
#pragma unroll
        for (int m = 0; m < 2; ++m) af[0][m] = *(const bf16x8*)(sA + cur + a_frag + m * 2048 + c0);
#pragma unroll
        for (int g = 0; g < NG; ++g) {
            const int ks = g / GQ, mq = g % GQ;
            if (g + 1 < NG) {
                const int ks1 = (g + 1) / GQ, mq1 = (g + 1) % GQ;
#pragma unroll
                for (int m = 0; m < 2; ++m) af[(g + 1) & 1][m] = *(const bf16x8*)(sA + cur + a_frag + (mq1 * 2 + m) * 2048 + (ks1 ? c1 : c0));
            }
#pragma unroll
            for (int m = 0; m < 2; ++m)
#pragma unroll
                for (int n = 0; n < 4; ++n)
                    acc[mq * 2 + m][n] = TR ? __builtin_amdgcn_mfma_f32_16x16x32_bf16(bfr[n], af[g & 1][m], acc[mq * 2 + m][n], 0, 0, 0)
                                            : __builtin_amdgcn_mfma_f32_16x16x32_bf16(af[g & 1][m], bfr[n], acc[mq * 2 + m][n], 0, 0, 0);
            if (g == GQ - 1) {
#pragma unroll
                for (int n = 0; n < 4; ++n) bfr[n] = *(const bf16x8*)(sB + cur + b_frag + n * 2048 + c1);
            }
            if (BMODE == 0 && g == NG - 2) {
                if (more) {
                    const float* f = (const float*)rb;
#pragma unroll
                    for (int i = 0; i < 4; ++i) {
                        uint4 w; w.x = pk2(f[0 * 4 + i], f[1 * 4 + i]); w.y = pk2(f[2 * 4 + i], f[3 * 4 + i]); w.z = pk2(f[4 * 4 + i], f[5 * 4 + i]); w.w = pk2(f[6 * 4 + i], f[7 * 4 + i]);
                        *(uint4*)(sB + nxt + tile_off(b_n4 + i, b_kg)) = w;
                    }
                }
            }
            __builtin_amdgcn_sched_barrier(0);
        }
        __syncthreads();
    }
    epi(acc, wr, wc, fr, fq);
}

struct NoMid { template <class ACC> __device__ __forceinline__ void operator()(int, ACC&, int, int, int) const {} };
struct ARows { const bf16_t* base; int lda; __device__ __forceinline__ const bf16_t* ubase() const { return base; } __device__ __forceinline__ unsigned row_off(int r) const { return (unsigned)r * (unsigned)lda; } };
struct BRows16 { const bf16_t* base; int ld; __device__ __forceinline__ const bf16_t* ubase(int) const { return base; } __device__ __forceinline__ unsigned row_off(int r) const { return (unsigned)r * (unsigned)ld; } };
struct BCols { const float* base; __device__ __forceinline__ const float* ubase(int) const { return base; } __device__ __forceinline__ unsigned col_off(int n4) const { return (unsigned)n4; } };

#define G8_HT 16384
__device__ __forceinline__ void g8_stage_rc(int b, int& R, int& C) { const int st = b / 1024, sb = b % 1024, swz = sb ^ (((sb >> 9) & 1) << 5); R = (st >> 1) * 16 + swz / 64; C = (st & 1) * 32 + (swz % 64) / 2; }
#define G8_WAIT_V(n) asm volatile("s_waitcnt vmcnt(" #n ")" ::: "memory")
#define G8_WAIT_L(n) asm volatile("s_waitcnt lgkmcnt(" #n ")" ::: "memory")
#define G8_BAR __builtin_amdgcn_s_barrier()
#define G8_SCHED __builtin_amdgcn_sched_barrier(0)

template <bool TR, class ALoad, class BLoad, class Mid, class Epi>
__device__ __forceinline__ void gemm8_tile(unsigned char* smem, const ALoad& al, const BLoad& bl, int nt, const Mid& mid, const Epi& epi) {
    int tid_ = threadIdx.x; asm volatile("" : "+v"(tid_));
    const int tid = tid_, lane = tid & 63, wid = tid >> 6, wr = wid >> 2, wc = wid & 3, fr = lane & 15, fq = lane >> 4;
    unsigned char* const shm = smem + SM_GEMM;
    const GAS bf16_t* const abase = uniform_ptr(al.ubase());
    const GAS bf16_t* const bbase0 = uniform_ptr(bl.half_base(0));
    const GAS bf16_t* const bbase1 = uniform_ptr(bl.half_base(1));
    unsigned aoff[2][2], boff[2];
#pragma unroll
    for (int i = 0; i < 2; ++i) {
        int R, C; g8_stage_rc(tid * 16 + i * 8192, R, C);
        aoff[0][i] = al.row_off(R) + (unsigned)C; aoff[1][i] = al.row_off(128 + R) + (unsigned)C; boff[i] = bl.row_off(R) + (unsigned)C;
    }
    const int wlds = __builtin_amdgcn_readfirstlane(wid * 1024);
    const int lane_off = fr * 64 + ((fq * 16) ^ ((fr >> 3) << 5));
#define G8_SA(b, h) (shm + ((b) * 2 + (h)) * G8_HT)
#define G8_SB(b, h) (shm + (4 + (b) * 2 + (h)) * G8_HT)
#define G8_STAGE_A(b, h, kt) do { _Pragma("unroll") for (int _i = 0; _i < 2; ++_i) \
        __builtin_amdgcn_global_load_lds((const GAS unsigned*)(abase + (size_t)(kt) * 64 + aoff[h][_i]), (LAS unsigned*)(G8_SA(b, h) + wlds + _i * 8192), 16, 0, 0); } while (0)
#define G8_STAGE_B(b, h, kt) do { _Pragma("unroll") for (int _i = 0; _i < 2; ++_i) \
        __builtin_amdgcn_global_load_lds((const GAS unsigned*)(((h) ? bbase1 : bbase0) + (size_t)(kt) * 64 + boff[_i]), (LAS unsigned*)(G8_SB(b, h) + wlds + _i * 8192), 16, 0, 0); } while (0)
#define G8_LDA(dst, b, h) do { _Pragma("unroll") for (int _m = 0; _m < 4; ++_m) _Pragma("unroll") for (int _k = 0; _k < 2; ++_k) \
        dst[_m][_k] = *(const bf16x8*)(G8_SA(b, h) + ((wr * 4 + _m) * 2 + _k) * 1024 + lane_off); } while (0)
#define G8_LDB(dst, b, h) do { _Pragma("unroll") for (int _n = 0; _n < 2; ++_n) _Pragma("unroll") for (int _k = 0; _k < 2; ++_k) \
        dst[_n][_k] = *(const bf16x8*)(G8_SB(b, h) + ((wc * 2 + _n) * 2 + _k) * 1024 + lane_off); } while (0)
#define G8_MMA(ai, bj, AT, BT) do { __builtin_amdgcn_s_setprio(1); \
        _Pragma("unroll") for (int _m = 0; _m < 4; ++_m) _Pragma("unroll") for (int _n = 0; _n < 2; ++_n) _Pragma("unroll") for (int _k = 0; _k < 2; ++_k) \
            acc[ai][bj][_m][_n] = TR ? __builtin_amdgcn_mfma_f32_16x16x32_bf16(BT[_n][_k], AT[_m][_k], acc[ai][bj][_m][_n], 0, 0, 0) \
                                     : __builtin_amdgcn_mfma_f32_16x16x32_bf16(AT[_m][_k], BT[_n][_k], acc[ai][bj][_m][_n], 0, 0, 0); \
        __builtin_amdgcn_s_setprio(0); } while (0)

    f32x4 acc[2][2][4][2];
#pragma unroll
    for (int a = 0; a < 2; ++a)
#pragma unroll
        for (int b = 0; b < 2; ++b)
#pragma unroll
            for (int m = 0; m < 4; ++m)
#pragma unroll
                for (int n = 0; n < 2; ++n) acc[a][b][m][n] = (f32x4){0.f, 0.f, 0.f, 0.f};
    bf16x8 At[4][2], B0[2][2], B1[2][2];
    __syncthreads();
    G8_STAGE_B(0, 0, 0); G8_STAGE_A(0, 0, 0); G8_STAGE_B(0, 1, 0); G8_STAGE_A(0, 1, 0);
    if (wr == 1) G8_BAR;
    G8_WAIT_V(4); G8_BAR;
    G8_STAGE_B(1, 0, 1); G8_STAGE_A(1, 0, 1); G8_STAGE_B(1, 1, 1);
    G8_WAIT_V(6); G8_BAR;
    for (int t = 0; t < nt - 2; t += 2) {
        mid(t, acc, wr, fr, fq);
        G8_LDB(B0, 0, 0); G8_SCHED; G8_LDA(At, 0, 0); G8_STAGE_A(1, 1, t + 1);
        G8_WAIT_L(8); G8_BAR; G8_WAIT_L(0); G8_MMA(0, 0, At, B0); G8_BAR; G8_SCHED;
        G8_LDB(B1, 0, 1); G8_STAGE_B(0, 0, t + 2);
        G8_BAR; G8_WAIT_L(0); G8_MMA(0, 1, At, B1); G8_BAR;
        G8_LDA(At, 0, 1); G8_STAGE_A(0, 0, t + 2);
        G8_BAR; G8_WAIT_L(0); G8_MMA(1, 0, At, B0); G8_BAR; G8_SCHED;
        G8_STAGE_B(0, 1, t + 2);
        G8_WAIT_V(6); G8_BAR; G8_MMA(1, 1, At, B1); G8_BAR;
        G8_LDB(B0, 1, 0); G8_SCHED; G8_LDA(At, 1, 0); G8_STAGE_A(0, 1, t + 2);
        G8_WAIT_L(8); G8_BAR; G8_WAIT_L(0); G8_MMA(0, 0, At, B0); G8_BAR; G8_SCHED;
        G8_LDB(B1, 1, 1); G8_STAGE_B(1, 0, t + 3);
        G8_BAR; G8_WAIT_L(0); G8_MMA(0, 1, At, B1); G8_BAR;
        G8_LDA(At, 1, 1); G8_STAGE_A(1, 0, t + 3);
        G8_BAR; G8_WAIT_L(0); G8_MMA(1, 0, At, B0); G8_BAR; G8_SCHED;
        G8_STAGE_B(1, 1, t + 3);
        G8_WAIT_V(6); G8_BAR; G8_MMA(1, 1, At, B1); G8_BAR;
    }
    { G8_LDB(B0, 0, 0); G8_LDA(At, 0, 0); G8_STAGE_A(1, 1, nt - 1);
      G8_BAR; G8_WAIT_L(0); G8_MMA(0, 0, At, B0); G8_BAR;
      G8_LDB(B1, 0, 1); G8_BAR; G8_WAIT_L(0); G8_MMA(0, 1, At, B1); G8_BAR;
      G8_LDA(At, 0, 1); G8_WAIT_V(4); G8_BAR; G8_WAIT_L(0); G8_MMA(1, 0, At, B0); G8_MMA(1, 1, At, B1); G8_BAR; }
    { G8_LDB(B0, 1, 0); G8_LDA(At, 1, 0); G8_WAIT_V(2); G8_BAR; G8_WAIT_L(0); G8_MMA(0, 0, At, B0); G8_BAR;
      G8_LDB(B1, 1, 1); G8_WAIT_V(0); G8_BAR; G8_WAIT_L(0); G8_MMA(0, 1, At, B1); G8_BAR;
      G8_LDA(At, 1, 1); G8_BAR; G8_WAIT_L(0); G8_MMA(1, 0, At, B0); G8_MMA(1, 1, At, B1); G8_BAR; }
    if (wr == 0) G8_BAR;
    epi(acc, wr, wc, fr, fq);
}
struct NoMid8 { template <class ACC> __device__ __forceinline__ void operator()(int, ACC&, int, int, int) const {} };
struct BHalves { const bf16_t* h0; const bf16_t* h1; int ld;
    __device__ __forceinline__ const bf16_t* half_base(int h) const { return h ? h1 : h0; }
    __device__ __forceinline__ unsigned row_off(int r) const { return (unsigned)r * (unsigned)ld; } };

__device__ __forceinline__ void conv_w_item(const float* __restrict__ src, int N, int ldd, bf16_t* __restrict__ dst, int kt, int ntile) {
    const int lane = threadIdx.x & 63, wave = threadIdx.x >> 6;
    const int kg = lane & 7, n4 = ((wave << 3) | (lane >> 3)) << 2;
    const float* s = src + (size_t)(kt * 64 + kg * 8) * N + ntile * 256 + n4;
    f32x4 r[8];
#pragma unroll
    for (int j = 0; j < 8; ++j) r[j] = *(const f32x4*)(s + (size_t)j * N);
#pragma unroll
    for (int i = 0; i < 4; ++i) {
        uint4 w; w.x = pk2(r[0][i], r[1][i]); w.y = pk2(r[2][i], r[3][i]); w.z = pk2(r[4][i], r[5][i]); w.w = pk2(r[6][i], r[7][i]);
        *(uint4*)(dst + (size_t)(ntile * 256 + n4 + i) * ldd + kt * 64 + kg * 8) = w;
    }
}
__device__ __forceinline__ void conv_all(const MKParams& p, int b, int G) {
    for (int it = b; it < 512 + 256 + 48 * 256; it += G) {
        if (it < 512) conv_w_item(p.w_in, DIN_, XN_LD, p.w_in_t, it >> 4, it & 15);
        else if (it < 768) { const int j = it - 512; conv_w_item(p.w_out, D_, D_, p.w_out_t, j >> 3, j & 7); }
        else {
            const int j = it - 768, mat = j >> 8, r = j & 255, which = mat >> 4, e = mat & 15;
            const float* src = (which == 0 ? p.w_gate : (which == 1 ? p.w_up : p.w_down)) + (size_t)e * D_ * FF_;
            bf16_t* dst = (which == 0 ? p.w_gate_t : (which == 1 ? p.w_up_t : p.w_down_t)) + (size_t)e * D_ * FF_;
            conv_w_item(src, 2048, 2048, dst, r >> 3, r & 7);
        }
    }
}

template <bool TR>
struct EpiInProj8 {
    const MKParams& p; int m0, n0;
    __device__ __forceinline__ void operator()(f32x4 (&acc)[2][2][4][2], int wr, int wc, int fr, int fq) const {
#pragma unroll
        for (int ai = 0; ai < 2; ++ai)
#pragma unroll
            for (int m = 0; m < 4; ++m) {
                if (TR) {
                    const int token = m0 + ai * 128 + wr * 64 + m * 16 + fr;
                    const float rs = p.rstd_x[token];
#pragma unroll
                    for (int bj = 0; bj < 2; ++bj)
#pragma unroll
                        for (int n = 0; n < 2; ++n) {
                            const int col = n0 + bj * 128 + wc * 32 + n * 16 + fq * 4;
                            const f32x4 a = acc[ai][bj][m][n];
                            uint2 w;
                            if (n0 < 1024) {
                                w.x = pk2(a[0] * rs, a[1] * rs); w.y = pk2(a[2] * rs, a[3] * rs);
                                *(uint2*)(p.ug + ((size_t)(col >> 4) * L_ + token) * 16 + (col & 15)) = w;
                            } else if (n0 < 2048) {
                                const float r8 = rs * 0.125f;
                                w.x = pk2(a[0] * r8, a[1] * r8); w.y = pk2(a[2] * r8, a[3] * r8);
                                *(uint2*)(p.qb + (size_t)token * 1024 + (col - 1024)) = w;
                            } else {
                                w.x = pk2(a[0] * rs, a[1] * rs); w.y = pk2(a[2] * rs, a[3] * rs);
                                *(uint2*)(p.kb + (size_t)token * 1024 + (col - 2048)) = w;
                            }
                        }
                } else {
                    const int token = m0 + ai * 128 + wr * 64 + m * 16 + fq * 4;
                    const float4 rs = *(const float4*)(p.rstd_x + token);
#pragma unroll
                    for (int bj = 0; bj < 2; ++bj)
#pragma unroll
                        for (int n = 0; n < 2; ++n) {
                            const int f = n0 - 3072 + bj * 128 + wc * 32 + n * 16 + fr;
                            const f32x4 a = acc[ai][bj][m][n];
                            uint2 w; w.x = pk2(a[0] * rs.x, a[1] * rs.y); w.y = pk2(a[2] * rs.z, a[3] * rs.w);
                            *(uint2*)(p.vT + (size_t)f * L_ + token) = w;
                        }
                }
            }
    }
};
struct MidOut8 {
    const float* rows;
    __device__ __forceinline__ void operator()(int t, f32x4 (&acc)[2][2][4][2], int wr, int fr, int fq) const {
        if (t == 16) {
#pragma unroll
            for (int ai = 0; ai < 2; ++ai)
#pragma unroll
                for (int m = 0; m < 4; ++m) {
                    const float ratio = rows[ai * 128 + wr * 64 + m * 16 + fr];
#pragma unroll
                    for (int bj = 0; bj < 2; ++bj)
#pragma unroll
                        for (int n = 0; n < 2; ++n) acc[ai][bj][m][n] *= ratio;
                }
        }
    }
};
struct EpiOut8 {
    const MKParams& p; const float* rows; int m0, n0, pn;
    __device__ __forceinline__ void operator()(f32x4 (&acc)[2][2][4][2], int wr, int wc, int fr, int fq) const {
#pragma unroll
        for (int ai = 0; ai < 2; ++ai)
#pragma unroll
            for (int m = 0; m < 4; ++m) {
                const int rt = ai * 128 + wr * 64 + m * 16 + fr, token = m0 + rt;
                const float rn = rows[256 + rt];
                float ss = 0.f;
#pragma unroll
                for (int bj = 0; bj < 2; ++bj)
#pragma unroll
                    for (int n = 0; n < 2; ++n) {
                        const int col = n0 + bj * 128 + wc * 32 + n * 16 + fq * 4;
                        const float4 xv = *(const float4*)(p.x + (size_t)token * D_ + col);
                        const float4 g = *(const float4*)(p.g_ffn + col);
                        const f32x4 a = acc[ai][bj][m][n];
                        const float v0 = xv.x + a[0] * rn, v1 = xv.y + a[1] * rn, v2 = xv.z + a[2] * rn, v3 = xv.w + a[3] * rn;
                        ss += v0 * v0 + v1 * v1 + v2 * v2 + v3 * v3;
                        uint2 w; w.x = pk2(v0 * g.x, v1 * g.y); w.y = pk2(v2 * g.z, v3 * g.w);
                        *(uint2*)(p.x1g + (size_t)token * D_ + col) = w;
                    }
                ss += __shfl_xor(ss, 16); ss += __shfl_xor(ss, 32);
                if (fq == 0) p.ssq_x1[token * 32 + pn * 4 + wc] = ss;
            }
    }
};
struct EpiMoe1_8 {
    const MKParams& p; int e, mt, nt;
    __device__ __forceinline__ void operator()(f32x4 (&acc)[2][2][4][2], int wr, int wc, int fr, int fq) const {
#pragma unroll
        for (int ai = 0; ai < 2; ++ai)
#pragma unroll
            for (int m = 0; m < 4; ++m) {
                const int slot = mt * 256 + ai * 128 + wr * 64 + m * 16 + fr;
                const float rs = p.rstd_x1[p.idx[e * CAP_ + slot]];
#pragma unroll
                for (int n = 0; n < 2; ++n) {
                    const f32x4 g = acc[ai][0][m][n] * rs, u = acc[ai][1][m][n] * rs;
                    float a[4];
#pragma unroll
                    for (int i = 0; i < 4; ++i) a[i] = g[i] / (1.f + __expf(-g[i])) * u[i];
                    uint2 w; w.x = pk2(a[0], a[1]); w.y = pk2(a[2], a[3]);
                    *(uint2*)(p.act + (size_t)(e * CAP_ + slot) * FF_ + nt * 128 + wc * 32 + n * 16 + fq * 4) = w;
                }
            }
    }
};
struct EpiMoe2_8 {
    const MKParams& p; int e, mt, nt;
    __device__ __forceinline__ void operator()(f32x4 (&acc)[2][2][4][2], int wr, int wc, int fr, int fq) const {
#pragma unroll
        for (int ai = 0; ai < 2; ++ai)
#pragma unroll
            for (int m = 0; m < 4; ++m) {
                const int slot = mt * 256 + ai * 128 + wr * 64 + m * 16 + fr;
                const float gt = p.gate[e * CAP_ + slot];
#pragma unroll
                for (int bj = 0; bj < 2; ++bj)
#pragma unroll
                    for (int n = 0; n < 2; ++n) {
                        const f32x4 a = acc[ai][bj][m][n] * gt;
                        uint2 w; w.x = pk2(a[0], a[1]); w.y = pk2(a[2], a[3]);
                        *(uint2*)(p.ye + (size_t)(e * CAP_ + slot) * D_ + nt * 256 + bj * 128 + wc * 32 + n * 16 + fq * 4) = w;
                    }
            }
    }
};

__device__ __forceinline__ void phase_prep(const MKParams& p) {
    const int lane = threadIdx.x & 63, wave = threadIdx.x >> 6;
    for (int row = blockIdx.x * 8 + wave; row < L_; row += gridDim.x * 8) {
        const float4* xr = (const float4*)(p.x + (size_t)row * D_);
        const float4* gr = (const float4*)p.g_mix;
        float s = 0.f;
        uint2* o = (uint2*)(p.xn + (size_t)row * XN_LD);
#pragma unroll
        for (int j = 0; j < 8; ++j) {
            const float4 v = xr[lane + 64 * j]; const float4 g = gr[lane + 64 * j];
            s += v.x * v.x + v.y * v.y + v.z * v.z + v.w * v.w;
            uint2 w; w.x = pk2(v.x * g.x, v.y * g.y); w.y = pk2(v.z * g.z, v.w * g.w);
            o[lane + 64 * j] = w;
        }
        s = wave_sum(s);
        if (lane == 0) p.rstd_x[row] = 1.0f / sqrtf(s * (1.0f / D_) + 1e-6f);
    }
}

template <bool TR>
struct EpiInProj {
    const MKParams& p; int m0, n0;
    __device__ __forceinline__ void operator()(f32x4 (&acc)[8][4], int wr, int wc, int fr, int fq) const {
        if (TR) {
#pragma unroll
            for (int m = 0; m < 8; ++m) {
                const int token = m0 + wr * 128 + m * 16 + fr;
                const float rs = p.rstd_x[token];
#pragma unroll
                for (int nn = 0; nn < 4; ++nn) {
                    const int col = n0 + wc * 64 + nn * 16 + fq * 4;
                    const f32x4 a = acc[m][nn];
                    uint2 w;
                    if (n0 < 1024) {
                        w.x = pk2(a[0] * rs, a[1] * rs); w.y = pk2(a[2] * rs, a[3] * rs);
                        *(uint2*)(p.ug + ((size_t)(col >> 4) * L_ + token) * 16 + (col & 15)) = w;
                    } else if (n0 < 2048) {
                        const float r8 = rs * 0.125f;
                        w.x = pk2(a[0] * r8, a[1] * r8); w.y = pk2(a[2] * r8, a[3] * r8);
                        *(uint2*)(p.qb + (size_t)token * 1024 + (col - 1024)) = w;
                    } else {
                        w.x = pk2(a[0] * rs, a[1] * rs); w.y = pk2(a[2] * rs, a[3] * rs);
                        *(uint2*)(p.kb + (size_t)token * 1024 + (col - 2048)) = w;
                    }
                }
            }
        } else {
#pragma unroll
            for (int m = 0; m < 8; ++m) {
                const int token = m0 + wr * 128 + m * 16 + fq * 4;
                const float4 rs = *(const float4*)(p.rstd_x + token);
#pragma unroll
                for (int nn = 0; nn < 4; ++nn) {
                    const int f = n0 - 3072 + wc * 64 + nn * 16 + fr;
                    const f32x4 a = acc[m][nn];
                    uint2 w; w.x = pk2(a[0] * rs.x, a[1] * rs.y); w.y = pk2(a[2] * rs.z, a[3] * rs.w);
                    *(uint2*)(p.vT + (size_t)f * L_ + token) = w;
                }
            }
        }
    }
};

__device__ __forceinline__ void phase_inproj(const MKParams& p, unsigned char* smem, int b) {
    for (int it = b; it < 512; it += gridDim.x) {
        const int xcd = it & 7, q = it >> 3;
        const int pn = (q & 1) * 8 + xcd;
        const int pm = q >> 1;
        const int m0 = pm * 256, n0 = pn * 256;
        ARows al{p.xn + (size_t)m0 * XN_LD, XN_LD};
        BHalves bl{p.w_in_t + (size_t)n0 * XN_LD, p.w_in_t + (size_t)(n0 + 128) * XN_LD, XN_LD};
        if (n0 < 3072) gemm8_tile<true>(smem, al, bl, D_ / 64, NoMid8{}, EpiInProj8<true>{p, m0, n0});
        else           gemm8_tile<false>(smem, al, bl, D_ / 64, NoMid8{}, EpiInProj8<false>{p, m0, n0});
    }
}


__device__ __forceinline__ void ssm_tables(const MKParams& p, unsigned char* smem, int g, int part) {
    float2* apow = (float2*)(smem + SM_GEMM);
    float2* bbar = apow + 2 * 65 * 64;
    float2* cc = bbar + 2 * 64 * 16;
    const int tid = threadIdx.x;
    __syncthreads();
    for (int idx = tid; idx < 2 * 65 * 64; idx += NT_) {
        const int d = idx / (65 * 64), t = (idx % (65 * 64)) >> 6, pp = idx & 63;
        const float lr = (d ? p.a_re_b : p.a_re_f)[g * 64 + pp], li = (d ? p.a_im_b : p.a_im_f)[g * 64 + pp];
        const float dt = expf((d ? p.ldt_b : p.ldt_f)[g]);
        const float x = lr * dt * (float)t, y = li * dt * (float)t;
        const float ex = expf(x);
        apow[idx] = make_float2(ex * cosf(y), ex * sinf(y));
    }
    for (int idx = tid; idx < 2 * 64 * 16; idx += NT_) {
        {
            const int d = idx >> 10, pp = (idx >> 4) & 63, ci = idx & 15;
            const float lr = (d ? p.a_re_b : p.a_re_f)[g * 64 + pp], li = (d ? p.a_im_b : p.a_im_f)[g * 64 + pp];
            const float dt = expf((d ? p.ldt_b : p.ldt_f)[g]);
            const float x = lr * dt, y = li * dt;
            const float ex = expf(x), cy = cosf(y), sy = sinf(y), sh = sinf(0.5f * y);
            const float nr = expm1f(x) * cy - 2.f * sh * sh, ni = ex * sy;
            const float den = lr * lr + li * li;
            const float fr_ = (nr * lr + ni * li) / den, fi_ = (ni * lr - nr * li) / den;
            const float br = (d ? p.b_re_b : p.b_re_f)[(g * 64 + pp) * 16 + ci], bi = (d ? p.b_im_b : p.b_im_f)[(g * 64 + pp) * 16 + ci];
            bbar[idx] = make_float2(fr_ * br - fi_ * bi, fr_ * bi + fi_ * br);
        }
        {
            const int d = idx >> 10, co = (idx >> 6) & 15, pp = idx & 63;
            cc[idx] = make_float2((d ? p.c_re_b : p.c_re_f)[(g * 16 + co) * 64 + pp], (d ? p.c_im_b : p.c_im_f)[(g * 16 + co) * 64 + pp]);
        }
    }
    __syncthreads();
    if (part == 0 && tid < 128) {
        const int d = tid >> 6, pp = tid & 63;
        const float2 a = apow[(d * 65 + 64) * 64 + pp];
        *(float2*)(p.A64 + ((size_t)(g * 2 + d) * 64 + pp) * 2) = a;
    }
    {
        const int di = part * 32 + (tid >> 4), co = tid & 15;
        if (di < 127) {
            const int delta = di - 63;
            float acc[16];
#pragma unroll
            for (int i = 0; i < 16; ++i) acc[i] = 0.f;
#pragma unroll
            for (int d = 0; d < 2; ++d) {
                const bool on = d ? (delta <= 0) : (delta >= 0);
                if (on) {
                    const int t = d ? -delta : delta;
                    const float2* ap = apow + (d * 65 + t) * 64;
                    const float2* cp = cc + (d * 16 + co) * 64;
                    for (int q = 0; q < 64; ++q) {
                        const float2 a = ap[q], c = cp[q];
                        const float car = c.x * a.x - c.y * a.y, cai = c.x * a.y + c.y * a.x;
                        const float2* bp = bbar + (d * 64 + q) * 16;
#pragma unroll
                        for (int i = 0; i < 16; ++i) { const float2 b = bp[i]; acc[i] = fmaf(car, b.x, fmaf(-cai, b.y, acc[i])); }
                    }
                }
            }
            uint4 w0, w1;
            w0.x = pk2(acc[0], acc[1]); w0.y = pk2(acc[2], acc[3]); w0.z = pk2(acc[4], acc[5]); w0.w = pk2(acc[6], acc[7]);
            w1.x = pk2(acc[8], acc[9]); w1.y = pk2(acc[10], acc[11]); w1.z = pk2(acc[12], acc[13]); w1.w = pk2(acc[14], acc[15]);
            uint4* o = (uint4*)(p.KT + (((size_t)g * 127 + di) * 16 + co) * 16);
            o[0] = w0; o[1] = w1;
        }
    }
#pragma unroll 1
    for (int i = 0; i < 16; ++i) {
        const int it = tid + NT_ * i;
        const int n = part * 64 + (it >> 7), kc = it & 127;
        const int d = n >> 7, pp = (n >> 1) & 63, ri = n & 1, j = kc >> 1, half = kc & 1;
        const int t = d ? j : 63 - j;
        const float2 a = apow[(d * 65 + t) * 64 + pp];
        const float2* bp = bbar + (d * 64 + pp) * 16 + half * 8;
        float v[8];
#pragma unroll
        for (int q = 0; q < 8; ++q) { const float2 b = bp[q]; v[q] = ri ? (a.x * b.y + a.y * b.x) : (a.x * b.x - a.y * b.y); }
        uint4 w; w.x = pk2(v[0], v[1]); w.y = pk2(v[2], v[3]); w.z = pk2(v[4], v[5]); w.w = pk2(v[6], v[7]);
        *(uint4*)(p.PBt + ((size_t)g * 256 + n) * 1024 + kc * 8) = w;
    }
#pragma unroll 1
    for (int i = 0; i < 16; ++i) {
        const int it = tid + NT_ * i;
        const int n = part * 256 + (it >> 5), k2 = (it & 31) * 8;
        const int l = n >> 4, co = n & 15, d = k2 >> 7, pp0 = (k2 >> 1) & 63;
        const int t = d ? (64 - l) : (l + 1);
        float v[8];
#pragma unroll
        for (int q = 0; q < 4; ++q) {
            const float2 a = apow[(d * 65 + t) * 64 + pp0 + q], c = cc[(d * 16 + co) * 64 + pp0 + q];
            v[2 * q] = c.x * a.x - c.y * a.y; v[2 * q + 1] = -(c.x * a.y + c.y * a.x);
        }
        uint4 w; w.x = pk2(v[0], v[1]); w.y = pk2(v[2], v[3]); w.z = pk2(v[4], v[5]); w.w = pk2(v[6], v[7]);
        *(uint4*)(p.QBt + ((size_t)g * 1024 + n) * 256 + k2) = w;
    }
    __syncthreads();
}

struct EpiE {
    float* E;
    __device__ __forceinline__ void operator()(f32x4 (&acc)[4][4], int wr, int wc, int fr, int fq) const {
#pragma unroll
        for (int m = 0; m < 4; ++m)
#pragma unroll
            for (int nn = 0; nn < 4; ++nn)
                *(f32x4*)(E + (size_t)(wr * 64 + m * 16 + fr) * 256 + wc * 64 + nn * 16 + fq * 4) = acc[m][nn];
    }
};
__device__ __forceinline__ void ssm_e_item(const MKParams& p, unsigned char* smem, int g) {
    ARows al{p.ug + (size_t)g * L_ * 16, 1024};
    BRows16 bl{p.PBt + (size_t)g * 256 * 1024, 1024};
    gemm_tile<4, true, 1>(smem, al, bl, 0, 16, NoMid{}, EpiE{p.Ebuf + (size_t)g * 128 * 256});
}

#define SY_A   (SM_GEMM)
#define SY_S   (SM_GEMM + 32768)
#define SY_KT  (SM_GEMM + 98304)
__device__ __forceinline__ float gelu_tanh_f(float x) {
    const float k0 = 0.7978845608028654f, k1 = 0.044715f;
    const float z = k0 * (x + k1 * x * x * x);
    const float e = __expf(2.f * z);
    return 0.5f * x * (2.f - 2.f / (1.f + e));
}
__device__ __forceinline__ void ssm_y_item(const MKParams& p, unsigned char* smem, int g, int nq) {
    int tid_ = threadIdx.x; asm volatile("" : "+v"(tid_));
    const int tid = tid_, lane = tid & 63, wave = tid >> 6;
    const int wr = wave >> 2, wc = wave & 3, fr = lane & 15, fq = lane >> 4;
    __syncthreads();
    {
        const uint4* src = (const uint4*)(p.KT + ((size_t)g * 127 + 16 * nq) * 256);
        uint4* dst = (uint4*)(smem + SY_KT);
        for (int i = tid; i < 79 * 32; i += NT_) dst[i] = src[i];
    }
    if (tid < 128) {
        const int d = tid >> 6, pp = tid & 63;
        const float2 A = *(const float2*)(p.A64 + ((size_t)(g * 2 + d) * 64 + pp) * 2);
        const float* E = p.Ebuf + (size_t)g * 128 * 256 + d * 128 + pp * 2;
        unsigned char* sb = smem + SY_S + (d * 2 + (pp >> 5)) * 16384 + (pp & 3) * 4;
        const int chunk = (pp & 31) >> 2;
        float sr = 0.f, si = 0.f;
#pragma unroll 8
        for (int s = 0; s < 128; ++s) {
            const int c = d ? (127 - s) : s;
            const float2 e = *(const float2*)(E + (size_t)c * 256);
            *(unsigned*)(sb + tile_off(c, chunk)) = pk2(sr, si);
            const float nr = A.x * sr - A.y * si + e.x, ni = A.x * si + A.y * sr + e.y;
            sr = nr; si = ni;
        }
    }
    const bf16_t* aptr[2];
#pragma unroll
    for (int i = 0; i < 2; ++i) {
        const int row = i * 64 + (tid >> 3);
        aptr[i] = p.ug + (size_t)g * L_ * 16 + (size_t)row * 1024 + ((((lane & 7) ^ (row >> 1)) & 7) << 3);
    }
    const int a_lds = __builtin_amdgcn_readfirstlane(wave * 1024);
    const int key = (fr >> 1) & 7;
    const int c0 = ((fq ^ key) & 7) << 4, c1 = (((fq | 4) ^ key) & 7) << 4;
    const int a_frag = (wr * 64 + fr) * 128;
    f32x4 acc[4][4];
#pragma unroll
    for (int m = 0; m < 4; ++m)
#pragma unroll
        for (int n = 0; n < 4; ++n) acc[m][n] = (f32x4){0.f, 0.f, 0.f, 0.f};
#pragma unroll
    for (int i = 0; i < 2; ++i)
        __builtin_amdgcn_global_load_lds((const unsigned*)aptr[i], (__attribute__((address_space(3))) unsigned*)(smem + SY_A + a_lds + i * 8192), 16, 0, 0);
    __syncthreads();
    const int kt_lane = SY_KT + fr * 32 + (fq & 1) * 16;
    for (int kt = 0; kt < 16; ++kt) {
        const int cur = (kt & 1) * 16384, nxt = cur ^ 16384;
        if (kt + 1 < 16) {
#pragma unroll
            for (int i = 0; i < 2; ++i)
                __builtin_amdgcn_global_load_lds((const unsigned*)(aptr[i] + (kt + 1) * 64), (__attribute__((address_space(3))) unsigned*)(smem + SY_A + nxt + a_lds + i * 8192), 16, 0, 0);
        }
#pragma unroll
        for (int ks = 0; ks < 2; ++ks) {
            const int co = ks ? c1 : c0;
            const int j = kt * 4 + ks * 2 + (fq >> 1);
            bf16x8 bfr[4], af[4];
#pragma unroll
            for (int nn = 0; nn < 4; ++nn) bfr[nn] = *(const bf16x8*)(smem + kt_lane + (wc * 4 + nn - j + 63) * 512);
#pragma unroll
            for (int m = 0; m < 4; ++m) af[m] = *(const bf16x8*)(smem + SY_A + cur + a_frag + m * 2048 + co);
#pragma unroll
            for (int m = 0; m < 4; ++m)
#pragma unroll
                for (int nn = 0; nn < 4; ++nn) acc[m][nn] = __builtin_amdgcn_mfma_f32_16x16x32_bf16(bfr[nn], af[m], acc[m][nn], 0, 0, 0);
        }
        __syncthreads();
    }
    {
        const bf16_t* qrow = p.QBt + ((size_t)g * 1024 + (16 * nq + wc * 4) * 16 + fr) * 256 + fq * 8;
#pragma unroll 1
        for (int kt2 = 0; kt2 < 4; ++kt2) {
#pragma unroll
            for (int ks = 0; ks < 2; ++ks) {
                const int co = ks ? c1 : c0;
                bf16x8 bfr[4], af[4];
#pragma unroll
                for (int nn = 0; nn < 4; ++nn) bfr[nn] = *(const bf16x8*)(qrow + (size_t)nn * 16 * 256 + kt2 * 64 + ks * 32);
#pragma unroll
                for (int m = 0; m < 4; ++m) af[m] = *(const bf16x8*)(smem + SY_S + kt2 * 16384 + a_frag + m * 2048 + co);
#pragma unroll
                for (int m = 0; m < 4; ++m)
#pragma unroll
                    for (int nn = 0; nn < 4; ++nn) acc[m][nn] = __builtin_amdgcn_mfma_f32_16x16x32_bf16(bfr[nn], af[m], acc[m][nn], 0, 0, 0);
            }
        }
    }
    {
        const float4 dsk = *(const float4*)(p.ssm_d + g * 16 + fq * 4);
#pragma unroll
        for (int m = 0; m < 4; ++m)
#pragma unroll
            for (int nn = 0; nn < 4; ++nn) {
                const int token = (wr * 64 + m * 16 + fr) * 64 + 16 * nq + wc * 4 + nn;
                const uint2 uu = *(const uint2*)(p.ug + ((size_t)g * L_ + token) * 16 + fq * 4);
                const f32x4 a = acc[m][nn];
                const float y0 = gelu_tanh_f(a[0] + dsk.x * bflo(uu.x)), y1 = gelu_tanh_f(a[1] + dsk.y * bfhi(uu.x));
                const float y2 = gelu_tanh_f(a[2] + dsk.z * bflo(uu.y)), y3 = gelu_tanh_f(a[3] + dsk.w * bfhi(uu.y));
                uint2 w; w.x = pk2(y0, y1); w.y = pk2(y2, y3);
                *(uint2*)(p.ypre + (size_t)token * DS_ + g * 16 + fq * 4) = w;
            }
    }
}

#define NA_RPB (SM_GEMM + 1024)
__device__ __forceinline__ void na_item(const MKParams& p, unsigned char* smem, int r, int half) {
    int tid_ = threadIdx.x; asm volatile("" : "+v"(tid_));
    const int tid = tid_, lane = tid & 63, wave = tid >> 6, fr = lane & 15, fq = lane >> 4;
    const int h = half * 8 + wave;
    __syncthreads();
    { float* dst = (float*)(smem + NA_RPB); for (int i = tid; i < 16 * 15 * 31; i += NT_) dst[i] = p.rpb[i]; }
    __syncthreads();
    int rs = r - 4; rs = rs < 0 ? 0 : (rs > 120 ? 120 : rs);
    bf16x8 qf[4][2];
#pragma unroll
    for (int qb = 0; qb < 4; ++qb)
#pragma unroll
        for (int ks = 0; ks < 2; ++ks) qf[qb][ks] = *(const bf16x8*)(p.qb + (size_t)(r * 64 + qb * 16 + fr) * 1024 + h * 64 + ks * 32 + fq * 8);
    int kbq[4], dxq[4];
#pragma unroll
    for (int qb = 0; qb < 4; ++qb) {
        const int c = qb * 16 + fr;
        int cs = c - 8; cs = cs < 0 ? 0 : (cs > 48 ? 48 : cs);
        kbq[qb] = 8 * fq - cs;
        dxq[qb] = (8 * fq - c + 15) * 4;
    }
    f32x4 o[4][4];
    float mrow[4], lrow[4];
#pragma unroll
    for (int qb = 0; qb < 4; ++qb) {
        mrow[qb] = -1e30f; lrow[qb] = 0.f;
#pragma unroll
        for (int mt = 0; mt < 4; ++mt) o[qb][mt] = (f32x4){0.f, 0.f, 0.f, 0.f};
    }
    const int krow_lane = (8 * (fr >> 2) + (fr & 3)) * 1024 + h * 64 + fq * 8;
    const size_t v_lane = (size_t)(h * 64 + fr) * L_ + 8 * fq;
#pragma unroll 1
    for (int i = 0; i < 8; ++i) {
        const int tok0 = (rs + i) * 64;
        const bf16_t* kbase = p.kb + (size_t)tok0 * 1024 + krow_lane;
        const unsigned char* brow = smem + NA_RPB + ((h * 15 + (rs + i - r + 7)) * 31) * 4;
        f32x4 s[2][2][4];
#pragma unroll
        for (int P = 0; P < 2; ++P)
#pragma unroll
            for (int sx = 0; sx < 2; ++sx) {
                const bf16x8 k0 = *(const bf16x8*)(kbase + (32 * P + 4 * sx) * 1024);
                const bf16x8 k1 = *(const bf16x8*)(kbase + (32 * P + 4 * sx) * 1024 + 32);
#pragma unroll
                for (int qb = 0; qb < 4; ++qb) {
                    f32x4 a = (f32x4){0.f, 0.f, 0.f, 0.f};
                    a = __builtin_amdgcn_mfma_f32_16x16x32_bf16(k0, qf[qb][0], a, 0, 0, 0);
                    a = __builtin_amdgcn_mfma_f32_16x16x32_bf16(k1, qf[qb][1], a, 0, 0, 0);
                    s[P][sx][qb] = a;
                }
            }
        unsigned pp[4][2][4];
#pragma unroll
        for (int qb = 0; qb < 4; ++qb) {
            const unsigned char* bq = brow + dxq[qb];
            float mx = -1e30f;
#pragma unroll
            for (int P = 0; P < 2; ++P)
#pragma unroll
                for (int sx = 0; sx < 2; ++sx)
#pragma unroll
                    for (int rg = 0; rg < 4; ++rg) {
                        const int cst = 32 * P + 4 * sx + rg;
                        const bool valid = (unsigned)(cst + kbq[qb]) < 16u;
                        const float b = *(const float*)(bq + cst * 4);
                        const float v = valid ? (s[P][sx][qb][rg] + b) : -1e30f;
                        s[P][sx][qb][rg] = v;
                        mx = fmaxf(mx, v);
                    }
            mx = fmaxf(mx, __shfl_xor(mx, 16));
            mx = fmaxf(mx, __shfl_xor(mx, 32));
            const float mn = fmaxf(mrow[qb], mx);
            const float alpha = __expf(mrow[qb] - mn);
            mrow[qb] = mn;
            float ls = 0.f;
#pragma unroll
            for (int P = 0; P < 2; ++P)
#pragma unroll
                for (int sx = 0; sx < 2; ++sx) {
                    float e[4];
#pragma unroll
                    for (int rg = 0; rg < 4; ++rg) { e[rg] = __expf(s[P][sx][qb][rg] - mn); ls += e[rg]; }
                    pp[qb][P][sx * 2 + 0] = pk2(e[0], e[1]);
                    pp[qb][P][sx * 2 + 1] = pk2(e[2], e[3]);
                }
            lrow[qb] = lrow[qb] * alpha + ls;
#pragma unroll
            for (int mt = 0; mt < 4; ++mt) o[qb][mt] *= alpha;
        }
#pragma unroll
        for (int P = 0; P < 2; ++P)
#pragma unroll
            for (int mt = 0; mt < 4; ++mt) {
                const bf16x8 vf = *(const bf16x8*)(p.vT + v_lane + (size_t)mt * 16 * L_ + tok0 + 32 * P);
#pragma unroll
                for (int qb = 0; qb < 4; ++qb) {
                    uint4 w; w.x = pp[qb][P][0]; w.y = pp[qb][P][1]; w.z = pp[qb][P][2]; w.w = pp[qb][P][3];
                    o[qb][mt] = __builtin_amdgcn_mfma_f32_16x16x32_bf16(vf, __builtin_bit_cast(bf16x8, w), o[qb][mt], 0, 0, 0);
                }
            }
    }
#pragma unroll
    for (int qb = 0; qb < 4; ++qb) {
        float l = lrow[qb];
        l += __shfl_xor(l, 16); l += __shfl_xor(l, 32);
        const float inv = 1.f / l;
        const int token = r * 64 + qb * 16 + fr;
        float ss = 0.f;
#pragma unroll
        for (int mt = 0; mt < 4; ++mt) {
            const float4 g = *(const float4*)(p.g_na + h * 64 + mt * 16 + 4 * fq);
            const f32x4 v = o[qb][mt] * inv;
            ss += v[0] * v[0] + v[1] * v[1] + v[2] * v[2] + v[3] * v[3];
            uint2 w; w.x = pk2(v[0] * g.x, v[1] * g.y); w.y = pk2(v[2] * g.z, v[3] * g.w);
            *(uint2*)(p.ymix + (size_t)token * D_ + DS_ + h * 64 + mt * 16 + 4 * fq) = w;
        }
        ss += __shfl_xor(ss, 16); ss += __shfl_xor(ss, 32);
        if (fq == 0) p.ssq_na[token * 16 + h] = ss;
    }
}

struct EpiGlu {
    const MKParams& p; int m0, n0, pn;
    __device__ __forceinline__ void operator()(f32x4 (&acc)[4][4], int wr, int wc, int fr, int fq) const {
#pragma unroll
        for (int m = 0; m < 4; ++m) {
            const int token = m0 + wr * 64 + m * 16 + fr;
            float ss = 0.f;
#pragma unroll
            for (int nn = 0; nn < 4; ++nn) {
                const int col = n0 + wc * 64 + nn * 16 + fq * 4;
                const float4 b = *(const float4*)(p.b_glu + col);
                const float4 g = *(const float4*)(p.g_ssm + col);
                const uint2 yy = *(const uint2*)(p.ypre + (size_t)token * DS_ + col);
                const f32x4 a = acc[m][nn];
                const float y0 = bflo(yy.x) / (1.f + __expf(-(a[0] + b.x))), y1 = bfhi(yy.x) / (1.f + __expf(-(a[1] + b.y)));
                const float y2 = bflo(yy.y) / (1.f + __expf(-(a[2] + b.z))), y3 = bfhi(yy.y) / (1.f + __expf(-(a[3] + b.w)));
                ss += y0 * y0 + y1 * y1 + y2 * y2 + y3 * y3;
                uint2 w; w.x = pk2(y0 * g.x, y1 * g.y); w.y = pk2(y2 * g.z, y3 * g.w);
                *(uint2*)(p.ymix + (size_t)token * D_ + col) = w;
            }
            ss += __shfl_xor(ss, 16); ss += __shfl_xor(ss, 32);
            if (fq == 0) p.ssq_ssm[token * 16 + pn * 4 + wc] = ss;
        }
    }
};
__device__ __forceinline__ void glu_item(const MKParams& p, unsigned char* smem, int it) {
    const int q = it >> 3, pn = q & 3, pm = (it & 7) + 8 * (q >> 2);
    const int m0 = pm * 128, n0 = pn * 256;
    ARows al{p.ypre + (size_t)m0 * DS_, DS_};
    BCols bl{p.w_glu + n0};
    gemm_tile<4, true, 0>(smem, al, bl, DS_, DS_ / 64, NoMid{}, EpiGlu{p, m0, n0, pn});
}

__device__ __forceinline__ float rstd16(const float* part) {
    const float4 a = ((const float4*)part)[0], b = ((const float4*)part)[1], c = ((const float4*)part)[2], d = ((const float4*)part)[3];
    const float s = ((a.x + a.y) + (a.z + a.w)) + ((b.x + b.y) + (b.z + b.w)) + ((c.x + c.y) + (c.z + c.w)) + ((d.x + d.y) + (d.z + d.w));
    return 1.0f / sqrtf(s * (1.0f / DS_) + 1e-6f);
}
struct MidOut {
    const float* rows;
    __device__ __forceinline__ void operator()(int kt, f32x4 (&acc)[8][4], int wr, int fr, int fq) const {
        if (kt == 16) {
#pragma unroll
            for (int m = 0; m < 8; ++m) {
                const float ratio = rows[wr * 128 + m * 16 + fr];
#pragma unroll
                for (int nn = 0; nn < 4; ++nn) acc[m][nn] *= ratio;
            }
        }
    }
};
struct EpiOut {
    const MKParams& p; const float* rows; int m0, n0, pn;
    __device__ __forceinline__ void operator()(f32x4 (&acc)[8][4], int wr, int wc, int fr, int fq) const {
#pragma unroll
        for (int m = 0; m < 8; ++m) {
            const int token = m0 + wr * 128 + m * 16 + fr;
            const float rn = rows[256 + wr * 128 + m * 16 + fr];
            float ss = 0.f;
#pragma unroll
            for (int nn = 0; nn < 4; ++nn) {
                const int col = n0 + wc * 64 + nn * 16 + fq * 4;
                const float4 xv = *(const float4*)(p.x + (size_t)token * D_ + col);
                const float4 g = *(const float4*)(p.g_ffn + col);
                const f32x4 a = acc[m][nn];
                const float v0 = xv.x + a[0] * rn, v1 = xv.y + a[1] * rn, v2 = xv.z + a[2] * rn, v3 = xv.w + a[3] * rn;
                ss += v0 * v0 + v1 * v1 + v2 * v2 + v3 * v3;
                uint2 w; w.x = pk2(v0 * g.x, v1 * g.y); w.y = pk2(v2 * g.z, v3 * g.w);
                *(uint2*)(p.x1g + (size_t)token * D_ + col) = w;
            }
            ss += __shfl_xor(ss, 16); ss += __shfl_xor(ss, 32);
            if (fq == 0) p.ssq_x1[token * 32 + pn * 4 + wc] = ss;
        }
    }
};
__device__ __forceinline__ void outproj_item(const MKParams& p, unsigned char* smem, int it) {
    const int pn = it & 7, pm = it >> 3;
    const int m0 = pm * 256, n0 = pn * 256;
    float* rows = (float*)(smem + SM_ROWS);
    __syncthreads();
    if (threadIdx.x < 256) {
        const int token = m0 + threadIdx.x;
        const float rs = rstd16(p.ssq_ssm + token * 16), rn = rstd16(p.ssq_na + token * 16);
        rows[threadIdx.x] = rs / rn; rows[256 + threadIdx.x] = rn;
    }
    ARows al{p.ymix + (size_t)m0 * D_, D_};
    BHalves bl{p.w_out_t + (size_t)n0 * D_, p.w_out_t + (size_t)(n0 + 128) * D_, D_};
    gemm8_tile<true>(smem, al, bl, D_ / 64, MidOut8{rows}, EpiOut8{p, rows, m0, n0, pn});
}

__device__ __forceinline__ void router_tile(const MKParams& p, int tile, int lane) {
    const int fr = lane & 15, fq = lane >> 4;
    const int token = tile * 16 + fr;
    const bf16_t* xr = p.x1g + (size_t)token * D_ + fq * 8;
    const bf16_t* wh = p.wrT + (size_t)fr * D_ + fq * 8;
    const bf16_t* wl = wh + 16 * D_;
    f32x4 ah = (f32x4){0.f, 0.f, 0.f, 0.f}, alo = (f32x4){0.f, 0.f, 0.f, 0.f};
#pragma unroll 4
    for (int k = 0; k < D_; k += 32) {
        const bf16x8 xb = *(const bf16x8*)(xr + k);
        ah = __builtin_amdgcn_mfma_f32_16x16x32_bf16(*(const bf16x8*)(wh + k), xb, ah, 0, 0, 0);
        alo = __builtin_amdgcn_mfma_f32_16x16x32_bf16(*(const bf16x8*)(wl + k), xb, alo, 0, 0, 0);
    }
    const float4 s0 = *(const float4*)(p.ssq_x1 + token * 32 + fq * 8), s1 = *(const float4*)(p.ssq_x1 + token * 32 + fq * 8 + 4);
    float ss = ((s0.x + s0.y) + (s0.z + s0.w)) + ((s1.x + s1.y) + (s1.z + s1.w));
    ss += __shfl_xor(ss, 16); ss += __shfl_xor(ss, 32);
    const float rs = 1.0f / sqrtf(ss * (1.0f / D_) + 1e-6f);
    float l[4];
#pragma unroll
    for (int i = 0; i < 4; ++i) l[i] = (ah[i] + alo[i]) * rs;
    float mx = fmaxf(fmaxf(l[0], l[1]), fmaxf(l[2], l[3]));
    mx = fmaxf(mx, __shfl_xor(mx, 16)); mx = fmaxf(mx, __shfl_xor(mx, 32));
    float e[4], sum = 0.f;
#pragma unroll
    for (int i = 0; i < 4; ++i) { e[i] = expf(l[i] - mx); sum += e[i]; }
    sum += __shfl_xor(sum, 16); sum += __shfl_xor(sum, 32);
    const float inv = 1.f / sum;
#pragma unroll
    for (int i = 0; i < 4; ++i) p.aff_t[(size_t)(4 * fq + i) * L_ + token] = e[i] * inv;
    if (fq == 0) p.rstd_x1[token] = rs;
}

#define TK_HIST (SM_GEMM)
#define TK_MISC (SM_GEMM + 1024)
#define TK_LIST (SM_GEMM + 2048)
__device__ __forceinline__ void topk_item(const MKParams& p, unsigned char* smem, int e) {
    const int tid = threadIdx.x, lane = tid & 63;
    unsigned* hist = (unsigned*)(smem + TK_HIST);
    unsigned* misc = (unsigned*)(smem + TK_MISC);
    unsigned* list = (unsigned*)(smem + TK_LIST);
    const float* a = p.aff_t + (size_t)e * L_;
    unsigned key[16];
#pragma unroll
    for (int i = 0; i < 16; ++i) key[i] = __float_as_uint(a[tid + NT_ * i]);
    __syncthreads();
    if (tid == 0) { misc[0] = 0u; misc[1] = CAP_; misc[2] = 0u; misc[3] = 0u; }
#pragma unroll 1
    for (int pass = 0; pass < 4; ++pass) {
        const int shift = 24 - 8 * pass;
        if (tid < 256) hist[tid] = 0u;
        __syncthreads();
        const unsigned prefix = misc[0];
        const unsigned himask = pass == 0 ? 0u : (0xffffffffu << (shift + 8));
#pragma unroll
        for (int i = 0; i < 16; ++i)
            if ((key[i] & himask) == prefix) atomicAdd(&hist[(key[i] >> shift) & 255u], 1u);
        __syncthreads();
        if (tid < 64) {
            const unsigned h0 = hist[4 * lane], h1 = hist[4 * lane + 1], h2 = hist[4 * lane + 2], h3 = hist[4 * lane + 3];
            const unsigned own = h0 + h1 + h2 + h3;
            unsigned suf = own;
#pragma unroll
            for (int o = 1; o < 64; o <<= 1) { const unsigned t = __shfl_down(suf, o); if (lane + o < 64) suf += t; }
            const unsigned above = suf - own;
            const unsigned k = misc[1];
            if (above < k && k <= suf) {
                unsigned cnt = above, dsel, kk;
                if (cnt + h3 >= k) { dsel = 3; kk = k - cnt; }
                else { cnt += h3; if (cnt + h2 >= k) { dsel = 2; kk = k - cnt; }
                else { cnt += h2; if (cnt + h1 >= k) { dsel = 1; kk = k - cnt; }
                else { cnt += h1; dsel = 0; kk = k - cnt; } } }
                misc[0] = prefix | ((4u * lane + dsel) << shift);
                misc[1] = kk;
            }
        }
        __syncthreads();
    }
    const unsigned tau = misc[0], krem = misc[1];
#pragma unroll
    for (int i = 0; i < 16; ++i)
        if (key[i] == tau) { const unsigned s = atomicAdd(&misc[3], 1u); list[s] = (unsigned)(tid + NT_ * i); }
    __syncthreads();
    const unsigned neq = misc[3];
#pragma unroll
    for (int i = 0; i < 16; ++i) {
        const int token = tid + NT_ * i;
        bool sel = key[i] > tau;
        if (key[i] == tau) {
            if (neq == krem) sel = true;
            else { unsigned rank = 0; for (unsigned j = 0; j < neq; ++j) rank += (list[j] < (unsigned)token) ? 1u : 0u; sel = rank < krem; }
        }
        int slot = -1;
        if (sel) {
            slot = (int)atomicAdd(&misc[2], 1u);
            p.idx[e * CAP_ + slot] = token;
            p.gate[e * CAP_ + slot] = __uint_as_float(key[i]);
        }
        p.slot_of[token * NE_ + e] = slot;
    }
    __syncthreads();
}

struct AGather { const bf16_t* base; const int* rows; __device__ __forceinline__ const bf16_t* ubase() const { return base; } __device__ __forceinline__ unsigned row_off(int r) const { return (unsigned)rows[r] * (unsigned)D_; } };
struct BMoe1 {
    const float* wg; long up_minus_gate; int col0;
    __device__ __forceinline__ const float* ubase(int wave) const { return wg + (long)(wave & 1) * up_minus_gate; }
    __device__ __forceinline__ unsigned col_off(int n4) const {
        const int wc = n4 >> 6, nn = (n4 >> 4) & 3, i = n4 & 15;
        return (unsigned)(col0 + wc * 32 + (nn & 1) * 16 + i);
    }
};
struct EpiMoe1 {
    const MKParams& p; int e, mt, nt;
    __device__ __forceinline__ void operator()(f32x4 (&acc)[8][4], int wr, int wc, int fr, int fq) const {
#pragma unroll
        for (int m = 0; m < 8; ++m) {
            const int slot = mt * 256 + wr * 128 + m * 16 + fr;
            const float rs = p.rstd_x1[p.idx[e * CAP_ + slot]];
#pragma unroll
            for (int nn = 0; nn < 2; ++nn) {
                const f32x4 g = acc[m][nn] * rs, u = acc[m][nn + 2] * rs;
                float a[4];
#pragma unroll
                for (int i = 0; i < 4; ++i) a[i] = g[i] / (1.f + __expf(-g[i])) * u[i];
                uint2 w; w.x = pk2(a[0], a[1]); w.y = pk2(a[2], a[3]);
                *(uint2*)(p.act + (size_t)(e * CAP_ + slot) * FF_ + nt * 128 + wc * 32 + nn * 16 + fq * 4) = w;
            }
        }
    }
};
__device__ __forceinline__ void moe1_item(const MKParams& p, unsigned char* smem, int it) {
    const int rnd = it >> 8, b = it & 255, xcd = b & 7, s = b >> 3;
    const int mt = s & 3, wt = rnd * 64 + xcd * 8 + (s >> 2);
    const int e = wt >> 4, nt = wt & 15;
    AGather al{p.x1g, p.idx + e * CAP_ + mt * 256};
    BHalves bl{p.w_gate_t + ((size_t)e * FF_ + nt * 128) * D_, p.w_up_t + ((size_t)e * FF_ + nt * 128) * D_, D_};
    gemm8_tile<true>(smem, al, bl, D_ / 64, NoMid8{}, EpiMoe1_8{p, e, mt, nt});
}

struct EpiMoe2 {
    const MKParams& p; int e, mt, nt;
    __device__ __forceinline__ void operator()(f32x4 (&acc)[8][4], int wr, int wc, int fr, int fq) const {
#pragma unroll
        for (int m = 0; m < 8; ++m) {
            const int slot = mt * 256 + wr * 128 + m * 16 + fr;
            const float gt = p.gate[e * CAP_ + slot];
#pragma unroll
            for (int nn = 0; nn < 4; ++nn) {
                const f32x4 a = acc[m][nn] * gt;
                uint2 w; w.x = pk2(a[0], a[1]); w.y = pk2(a[2], a[3]);
                *(uint2*)(p.ye + (size_t)(e * CAP_ + slot) * D_ + nt * 256 + wc * 64 + nn * 16 + fq * 4) = w;
            }
        }
    }
};
__device__ __forceinline__ void moe2_item(const MKParams& p, unsigned char* smem, int it) {
    const int rnd = it >> 8, b = it & 255, xcd = b & 7, s = b >> 3;
    const int mt = s & 3, wt = rnd * 64 + xcd * 8 + (s >> 2);
    const int e = wt >> 3, nt = wt & 7;
    ARows al{p.act + (size_t)(e * CAP_ + mt * 256) * FF_, FF_};
    BHalves bl{p.w_down_t + ((size_t)e * D_ + nt * 256) * FF_, p.w_down_t + ((size_t)e * D_ + nt * 256 + 128) * FF_, FF_};
    gemm8_tile<true>(smem, al, bl, FF_ / 64, NoMid8{}, EpiMoe2_8{p, e, mt, nt});
}

__device__ __forceinline__ void final_token(const MKParams& p, int token, int lane) {
    float v[4][8];
#pragma unroll
    for (int j = 0; j < 4; ++j) {
        const int n = j * 512 + lane * 8;
        const uint4 w = *(const uint4*)(p.x1g + (size_t)token * D_ + n);
        const float4 g0 = *(const float4*)(p.g_ffn + n), g1 = *(const float4*)(p.g_ffn + n + 4);
        v[j][0] = bflo(w.x) / g0.x; v[j][1] = bfhi(w.x) / g0.y; v[j][2] = bflo(w.y) / g0.z; v[j][3] = bfhi(w.y) / g0.w;
        v[j][4] = bflo(w.z) / g1.x; v[j][5] = bfhi(w.z) / g1.y; v[j][6] = bflo(w.w) / g1.z; v[j][7] = bfhi(w.w) / g1.w;
    }
#pragma unroll 1
    for (int e = 0; e < NE_; ++e) {
        const int slot = p.slot_of[token * NE_ + e];
        if (slot >= 0) {
            const bf16_t* yr = p.ye + (size_t)(e * CAP_ + slot) * D_;
#pragma unroll
            for (int j = 0; j < 4; ++j) {
                const uint4 w = *(const uint4*)(yr + j * 512 + lane * 8);
                v[j][0] += bflo(w.x); v[j][1] += bfhi(w.x); v[j][2] += bflo(w.y); v[j][3] += bfhi(w.y);
                v[j][4] += bflo(w.z); v[j][5] += bfhi(w.z); v[j][6] += bflo(w.w); v[j][7] += bfhi(w.w);
            }
        }
    }
    float ss = 0.f;
#pragma unroll
    for (int j = 0; j < 4; ++j)
#pragma unroll
        for (int i = 0; i < 8; ++i) ss += v[j][i] * v[j][i];
    ss = wave_sum(ss);
    const float rs = 1.0f / sqrtf(ss * (1.0f / D_) + 1e-6f);
#pragma unroll
    for (int j = 0; j < 4; ++j) {
        const int n = j * 512 + lane * 8;
        const float4 g0 = *(const float4*)(p.g_final + n), g1 = *(const float4*)(p.g_final + n + 4);
        float4 o0, o1;
        o0.x = v[j][0] * rs * g0.x; o0.y = v[j][1] * rs * g0.y; o0.z = v[j][2] * rs * g0.z; o0.w = v[j][3] * rs * g0.w;
        o1.x = v[j][4] * rs * g1.x; o1.y = v[j][5] * rs * g1.y; o1.z = v[j][6] * rs * g1.z; o1.w = v[j][7] * rs * g1.w;
        *(float4*)(p.out + (size_t)token * D_ + n) = o0;
        *(float4*)(p.out + (size_t)token * D_ + n + 4) = o1;
    }
}


#ifndef REP0
#define REP0 1
#endif
#ifndef REP1
#define REP1 1
#endif
#ifndef REP2
#define REP2 1
#endif
#ifndef REP3
#define REP3 1
#endif
#ifndef REP4
#define REP4 1
#endif
#ifndef REP5
#define REP5 1
#endif
#ifndef REP6
#define REP6 1
#endif
#ifndef REP7
#define REP7 1
#endif
#ifndef REP8
#define REP8 1
#endif
#ifndef REP9
#define REP9 1
#endif
#ifndef REP10
#define REP10 1
#endif
__global__ __launch_bounds__(NT_, 2) void k_mega(MKParams p) {
    extern __shared__ __attribute__((aligned(16))) unsigned char smem[];
    volatile LAS unsigned* st = (volatile LAS unsigned*)smem;
    if (threadIdx.x < 4) st[threadIdx.x] = 0u;
    __syncthreads();
    xcd_barrier_post(p.bar, st);
    if (p.never) cg::this_grid().sync();
    const int G = gridDim.x, b0 = blockIdx.x;
    for (int it = b0; it < 256; it += G) ssm_tables(p, smem, it >> 2, it & 3);
    conv_all(p, b0, G);
    phase_prep(p);
    for (int i = b0 * NT_ + threadIdx.x; i < NE_ * D_; i += G * NT_) {
        const int e = i >> 11, n = i & (D_ - 1);
        const float w = p.w_router[n * NE_ + e];
        const unsigned hi = pk2(w, 0.f) & 0xffffu;
        const float rem = w - __uint_as_float(hi << 16);
        p.wrT[i] = (bf16_t)hi; p.wrT[NE_ * D_ + i] = (bf16_t)(pk2(rem, 0.f) & 0xffffu);
    }
    xcd_barrier(p.bar, st);
    if (threadIdx.x == 0) {
        bool even = (G % 8) == 0;
        for (int j = 0; j < 8; ++j) even = even && (xb_ld(&p.bar[XB_XCNT(j)]) == (unsigned)(G / 8));
        st[2] = even ? (st[2] + 8u * st[3]) : (unsigned)blockIdx.x;
    }
    __syncthreads();
    const int b = (int)st[2];
    for (int rep = 0; rep < REP1; ++rep) {
    phase_inproj(p, smem, b);
    xcd_barrier(p.bar, st);
    }
    for (int rep = 0; rep < REP2; ++rep) {
    for (int it = b; it < 64 + 256; it += G) {
        if (it < 64) ssm_e_item(p, smem, it);
        else { const int j = it - 64, q = j >> 3; na_item(p, smem, (j & 7) * 16 + (q >> 1), q & 1); }
    }
    xcd_barrier(p.bar, st);
    }
    for (int rep = 0; rep < REP3; ++rep) {
    for (int it = b; it < 256; it += G) { const int q = it >> 3; ssm_y_item(p, smem, (it & 7) + 8 * (q >> 2), q & 3); }
    xcd_barrier(p.bar, st);
    }
    for (int rep = 0; rep < REP4; ++rep) {
    for (int it = b; it < 256; it += G) glu_item(p, smem, it);
    xcd_barrier(p.bar, st);
    }
    for (int rep = 0; rep < REP5; ++rep) {
    for (int it = b; it < 256; it += G) outproj_item(p, smem, it);
    xcd_barrier(p.bar, st);
    }
    for (int rep = 0; rep < REP6; ++rep) {
    { int tq = threadIdx.x; asm volatile("" : "+v"(tq));
      for (int t = b * 8 + (tq >> 6); t < L_ / 16; t += G * 8) router_tile(p, t, tq & 63); }
    xcd_barrier(p.bar, st);
    }
    for (int rep = 0; rep < REP7; ++rep) {
    for (int it = b; it < NE_; it += G) topk_item(p, smem, it);
    xcd_barrier(p.bar, st);
    }
    for (int rep = 0; rep < REP8; ++rep) {
    for (int it = b; it < 1024; it += G) moe1_item(p, smem, it);
    xcd_barrier(p.bar, st);
    }
    for (int rep = 0; rep < REP9; ++rep) {
    for (int it = b; it < 512; it += G) moe2_item(p, smem, it);
    xcd_barrier(p.bar, st);
    }
    { int tq = threadIdx.x; asm volatile("" : "+v"(tq));
      for (int t = b * 8 + (tq >> 6); t < L_; t += G * 8) final_token(p, t, tq & 63); }
}

extern "C" void kernel_launch(void* const* d_in, const int* in_sizes, int n_in, void* d_out, int out_size, void* d_ws, size_t ws_size,
                              hipStream_t stream) {
    (void)in_sizes; (void)n_in; (void)out_size; (void)ws_size;
    static int grid = 0;
    if (!grid) {
        int dev = 0, cus = 0, per_cu = 0;
        (void)hipGetDevice(&dev);
        (void)hipDeviceGetAttribute(&cus, hipDeviceAttributeMultiprocessorCount, dev);
        (void)hipFuncSetAttribute((const void*)k_mega, hipFuncAttributeMaxDynamicSharedMemorySize, MK_LDS);
        (void)hipOccupancyMaxActiveBlocksPerMultiprocessor(&per_cu, (const void*)k_mega, NT_, MK_LDS);
        if (per_cu < 1) per_cu = 1;
        grid = cus;
    }
    MKParams mp{};
    const float* const* in = (const float* const*)d_in;
    mp.x = in[0]; mp.g_mix = in[1]; mp.w_in = in[2];
    mp.a_re_f = in[3]; mp.a_im_f = in[4]; mp.ldt_f = in[5]; mp.b_re_f = in[6]; mp.b_im_f = in[7]; mp.c_re_f = in[8]; mp.c_im_f = in[9];
    mp.a_re_b = in[10]; mp.a_im_b = in[11]; mp.ldt_b = in[12]; mp.b_re_b = in[13]; mp.b_im_b = in[14]; mp.c_re_b = in[15]; mp.c_im_b = in[16];
    mp.ssm_d = in[17]; mp.w_glu = in[18]; mp.b_glu = in[19]; mp.rpb = in[20]; mp.g_ssm = in[21]; mp.g_na = in[22]; mp.w_out = in[23];
    mp.g_ffn = in[24]; mp.w_router = in[25]; mp.w_gate = in[26]; mp.w_up = in[27]; mp.w_down = in[28]; mp.g_final = in[29];
    mp.out = (float*)d_out;
    unsigned char* ws = (unsigned char*)d_ws;
    size_t off = 0;
    auto take = [&](size_t bytes) { unsigned char* q = ws + off; off += (bytes + 255) & ~(size_t)255; return q; };
    mp.bar = (unsigned*)take(XCD_BAR_WORDS * 4);
    mp.xn = (bf16_t*)take((size_t)L_ * XN_LD * 2);
    mp.rstd_x = (float*)take(L_ * 4);
    mp.ug = (bf16_t*)take((size_t)L_ * DS_ * 2);
    mp.qb = (bf16_t*)take((size_t)L_ * DS_ * 2);
    mp.kb = (bf16_t*)take((size_t)L_ * DS_ * 2);
    mp.vT = (bf16_t*)take((size_t)L_ * DS_ * 2);
    mp.KT = (bf16_t*)take((size_t)64 * 127 * 256 * 2);
    mp.PBt = (bf16_t*)take((size_t)64 * 256 * 1024 * 2);
    mp.QBt = (bf16_t*)take((size_t)64 * 1024 * 256 * 2);
    mp.A64 = (float*)take(64 * 2 * 64 * 2 * 4);
    mp.Ebuf = (float*)take((size_t)64 * 128 * 256 * 4);
    mp.ypre = (bf16_t*)take((size_t)L_ * DS_ * 2);
    mp.ymix = (bf16_t*)take((size_t)L_ * D_ * 2);
    mp.ssq_na = (float*)take((size_t)L_ * 16 * 4);
    mp.ssq_ssm = (float*)take((size_t)L_ * 16 * 4);
    mp.x1g = (bf16_t*)take((size_t)L_ * D_ * 2);
    mp.ssq_x1 = (float*)take((size_t)L_ * 32 * 4);
    mp.wrT = (bf16_t*)take((size_t)2 * NE_ * D_ * 2);
    mp.aff_t = (float*)take((size_t)NE_ * L_ * 4);
    mp.rstd_x1 = (float*)take(L_ * 4);
    mp.idx = (int*)take(NE_ * CAP_ * 4);
    mp.gate = (float*)take(NE_ * CAP_ * 4);
    mp.slot_of = (int*)take((size_t)L_ * NE_ * 4);
    mp.act = (bf16_t*)take((size_t)NE_ * CAP_ * FF_ * 2);
    mp.ye = (bf16_t*)take((size_t)NE_ * CAP_ * D_ * 2);
    mp.w_in_t = (bf16_t*)take((size_t)DIN_ * XN_LD * 2);
    mp.w_out_t = (bf16_t*)take((size_t)D_ * D_ * 2);
    mp.w_gate_t = (bf16_t*)take((size_t)NE_ * D_ * FF_ * 2);
    mp.w_up_t = (bf16_t*)take((size_t)NE_ * D_ * FF_ * 2);
    mp.w_down_t = (bf16_t*)take((size_t)NE_ * D_ * FF_ * 2);
    mp.never = 0; mp.pad = 0;
    (void)hipMemsetAsync(mp.bar, 0, XCD_BAR_WORDS * sizeof(unsigned), stream);
    void* args[] = {&mp};
    (void)hipLaunchCooperativeKernel((const void*)k_mega, dim3(grid), dim3(NT_), args, MK_LDS, stream);
}
```

```cpp
#include <hip/hip_runtime.h>
#include <math.h>
#include <stdint.h>

#define L_   8192
#define D_   2048
#define DIN_ 4096
#define DS_  1024
#define NG_  64
#define NP_  64
#define NE_  16
#define CAP_ 1024
#define FF_  2048

__device__ __forceinline__ float wave_sum(float v) {
#pragma unroll
    for (int o = 32; o >= 1; o >>= 1) v += __shfl_xor(v, o);
    return v;
}

#include <hip/hip_cooperative_groups.h>
namespace cg = cooperative_groups;
#define XB_TMO      128
#define XB_XCNT(j)  (256  + 64 * (j))
#define XB_XSUB(j)  (1280 + 64 * (j))
#define XB_XGEN(j)  (2304 + 64 * (j))
#define XB_TOP      3328
#define XB_TOPGEN   3392
#define XCD_BAR_WORDS 3456
#define XB_SPIN_CAP (1u << 18)
#define LAS __attribute__((address_space(3)))
__device__ __forceinline__ unsigned xb_ld(unsigned* p)              { return __hip_atomic_load(p, __ATOMIC_RELAXED, __HIP_MEMORY_SCOPE_AGENT); }
__device__ __forceinline__ unsigned xb_add(unsigned* p, unsigned v) { return __hip_atomic_fetch_add(p, v, __ATOMIC_RELAXED, __HIP_MEMORY_SCOPE_AGENT); }
__device__ __forceinline__ unsigned xb_xcc_id() { return (unsigned)__builtin_amdgcn_s_getreg((3 << 11) | 20) & 0xFu; }
#define XB_SPIN(cond, bar) do { unsigned _sp = 0; while (cond) { __builtin_amdgcn_s_sleep(1); \
    if ((++_sp & 255u) == 0u) { if (xb_ld(&(bar)[XB_TMO])) break; if (_sp > XB_SPIN_CAP) { atomicAdd(&(bar)[XB_TMO], 1u); break; } } } } while (0)
__device__ __forceinline__ void xcd_barrier_post(unsigned* bar, volatile LAS unsigned* st) {
    if (threadIdx.x == 0) { const unsigned x = xb_xcc_id(); const unsigned r = xb_add(&bar[XB_XCNT(x)], 1u); st[2] = x; st[3] = r; }
}
__device__ __forceinline__ void xcd_barrier_complete(unsigned* bar, unsigned x, unsigned& nloc, unsigned& nx) {
    const unsigned G = gridDim.x * gridDim.y * gridDim.z;
    unsigned sum, cnt, mine, sp = 0u;
    for (;;) {
        sum = 0u; cnt = 0u; mine = 0u;
#pragma unroll
        for (unsigned j = 0; j < 16; ++j) { const unsigned c = xb_ld(&bar[XB_XCNT(j)]); sum += c; cnt += (c > 0u) ? 1u : 0u; mine = (j == x) ? c : mine; }
        if (sum == G) break;
        __builtin_amdgcn_s_sleep(1);
        if ((++sp & 255u) == 0u) { if (xb_ld(&bar[XB_TMO])) break; if (sp > XB_SPIN_CAP) { atomicAdd(&bar[XB_TMO], 1u); break; } }
    }
    nloc = mine > 0u ? mine : 1u; nx = cnt > 0u ? cnt : 1u;
}
__device__ __forceinline__ void xcd_barrier(unsigned* bar, volatile LAS unsigned* st) {
    asm volatile("s_waitcnt vmcnt(0)" ::: "memory");
    __syncthreads();
    if (threadIdx.x == 0) {
        __builtin_amdgcn_s_waitcnt(0);
        const unsigned x = xb_xcc_id();
        unsigned nloc = st[0], nx = st[1];
        if (nloc == 0u) { xcd_barrier_complete(bar, x, nloc, nx); st[0] = nloc; st[1] = nx; }
        const unsigned old = xb_add(&bar[XB_XSUB(x)], 1u);
        const unsigned gen = old / nloc;
        if (old + 1u == (gen + 1u) * nloc) {
            __builtin_amdgcn_fence(__ATOMIC_RELEASE, "agent");
            asm volatile("s_waitcnt vmcnt(0)" ::: "memory");
            const unsigned og = xb_add(&bar[XB_TOP], 1u);
            const unsigned tg = og / nx;
            if (og + 1u == (tg + 1u) * nx) xb_add(&bar[XB_TOPGEN], 1u);
            else XB_SPIN(xb_ld(&bar[XB_TOPGEN]) == tg, bar);
            __builtin_amdgcn_fence(__ATOMIC_ACQUIRE, "agent");
            xb_add(&bar[XB_XGEN(x)], 1u);
            asm volatile("s_waitcnt vmcnt(0)" ::: "memory");
        } else {
            XB_SPIN(xb_ld(&bar[XB_XGEN(x)]) == gen, bar);
            __builtin_amdgcn_fence(__ATOMIC_ACQUIRE, "agent");
            asm volatile("s_waitcnt vmcnt(0)" ::: "memory");
        }
    }
    __syncthreads();
}

typedef short bf16x8 __attribute__((ext_vector_type(8)));
typedef float f32x4 __attribute__((ext_vector_type(4)));
typedef float f32x2 __attribute__((ext_vector_type(2)));
typedef __bf16 bf16x2v __attribute__((ext_vector_type(2)));
typedef unsigned short bf16_t;
#define NT_ 512
#define XN_LD (D_ + 64)
#define SM_MISC 0
#define SM_ROWS 1024
#define SM_GEMM 4096
#define MK_LDS (144 * 1024)

__device__ __forceinline__ unsigned pk2(float lo, float hi) {
    f32x2 v = {lo, hi};
    return __builtin_bit_cast(unsigned, __builtin_convertvector(v, bf16x2v));
}
__device__ __forceinline__ float bf2f(bf16_t h) { return __uint_as_float(((unsigned)h) << 16); }
__device__ __forceinline__ float bflo(unsigned w) { return __uint_as_float(w << 16); }
__device__ __forceinline__ float bfhi(unsigned w) { return __uint_as_float(w & 0xffff0000u); }

struct MKParams {
    const float *x, *g_mix, *w_in;
    const float *a_re_f, *a_im_f, *ldt_f, *b_re_f, *b_im_f, *c_re_f, *c_im_f;
    const float *a_re_b, *a_im_b, *ldt_b, *b_re_b, *b_im_b, *c_re_b, *c_im_b;
    const float *ssm_d, *w_glu, *b_glu, *rpb, *g_ssm, *g_na, *w_out, *g_ffn, *w_router, *w_gate, *w_up, *w_down, *g_final;
    float* out;
    bf16_t* xn;
    float* rstd_x;
    bf16_t* ua;
    bf16_t* qb;
    bf16_t* kb;
    bf16_t* vT;
    bf16_t* PBt;
    bf16_t* WyT;
    float* A32;
    bf16_t* ypre;
    bf16_t* ymix;
    float* ssq_na;
    float* ssq_ssm;
    bf16_t* x1g;
    float* ssq_x1;
    bf16_t* wrT;
    float* aff_t;
    float* rstd_x1;
    int* idx;
    float* gate;
    int* slot_of;
    unsigned* ahist;
    bf16_t* act;
    bf16_t* ye;
    bf16_t* w_in_t;
    bf16_t* w_out_t;
    bf16_t* w_glu_t;
    bf16_t *w_gate_t, *w_up_t, *w_down_t;
    unsigned* bar;
    int rep[12];
    int never; int pad;
};

#define GAS __attribute__((address_space(1)))
__device__ __forceinline__ int opaque_tid() { int t = threadIdx.x; asm volatile("" : "+v"(t)); return t; }
template <class T> __device__ __forceinline__ const GAS T* uniform_ptr(const T* p) {
    const unsigned long long v = (unsigned long long)p;
    const unsigned lo = __builtin_amdgcn_readfirstlane((unsigned)v), hi = __builtin_amdgcn_readfirstlane((unsigned)(v >> 32));
    return (const GAS T*)(((unsigned long long)hi << 32) | lo);
}
__device__ __forceinline__ int tile_off(int row, int chunk) { return row * 128 + (((chunk ^ (row >> 1)) & 7) << 4); }

template <int MT, bool TR, int BMODE, class ALoad, class BLoad, class Mid, class Epi>
__device__ __forceinline__ void gemm_tile(unsigned char* smem, const ALoad& al, const BLoad& bl, int ldb, int nkt, const Mid& mid, const Epi& epi) {
    int tid_ = threadIdx.x; asm volatile("" : "+v"(tid_));
    const int tid = tid_, lane = tid & 63, wave = tid >> 6;
    const int wr = wave >> 2, wc = wave & 3, fr = lane & 15, fq = lane >> 4;
    constexpr int AR = MT / 2;
    const GAS bf16_t* const abase = uniform_ptr(al.ubase());
    unsigned aoff[AR];
#pragma unroll
    for (int i = 0; i < AR; ++i) {
        const int row = i * 64 + (tid >> 3);
        aoff[i] = al.row_off(row) + (unsigned)((((lane & 7) ^ (row >> 1)) & 7) << 3);
    }
    const int a_lds = __builtin_amdgcn_readfirstlane(wave * 1024);
    const int b_kg = lane & 7, b_n4 = ((wave << 3) | (lane >> 3)) << 2;
    const auto* const bbase = uniform_ptr(bl.ubase(__builtin_amdgcn_readfirstlane(wave)));
    unsigned boff = 0, boff16[4];
    if constexpr (BMODE == 0) { boff = bl.col_off(b_n4) + (unsigned)(b_kg * 8) * (unsigned)ldb; }
    else {
#pragma unroll
        for (int i = 0; i < 4; ++i) { const int row = i * 64 + (tid >> 3); boff16[i] = bl.row_off(row) + (unsigned)((((lane & 7) ^ (row >> 1)) & 7) << 3); }
    }
    unsigned char* const sA = smem + SM_GEMM;
    unsigned char* const sB = smem + SM_GEMM + 32768;
    const int key = (fr >> 1) & 7;
    const int c0 = ((fq ^ key) & 7) << 4, c1 = (((fq | 4) ^ key) & 7) << 4;
    const int a_frag = (wr * (MT * 16) + fr) * 128;
    const int b_frag = (wc * 64 + fr) * 128;

    f32x4 acc[MT][4];
#pragma unroll
    for (int m = 0; m < MT; ++m)
#pragma unroll
        for (int n = 0; n < 4; ++n) acc[m][n] = (f32x4){0.f, 0.f, 0.f, 0.f};

    f32x4 rb[8];
    __syncthreads();
#pragma unroll
    for (int i = 0; i < AR; ++i)
        __builtin_amdgcn_global_load_lds((const GAS unsigned*)(abase + aoff[i]), (__attribute__((address_space(3))) unsigned*)(sA + a_lds + i * 8192), 16, 0, 0);
    if constexpr (BMODE == 0) {
#pragma unroll
        for (int j = 0; j < 8; ++j) rb[j] = *(const GAS f32x4*)((const GAS float*)bbase + (size_t)j * ldb + boff);
        const float* f = (const float*)rb;
#pragma unroll
        for (int i = 0; i < 4; ++i) {
            uint4 w; w.x = pk2(f[0 * 4 + i], f[1 * 4 + i]); w.y = pk2(f[2 * 4 + i], f[3 * 4 + i]); w.z = pk2(f[4 * 4 + i], f[5 * 4 + i]); w.w = pk2(f[6 * 4 + i], f[7 * 4 + i]);
            *(uint4*)(sB + tile_off(b_n4 + i, b_kg)) = w;
        }
    } else {
#pragma unroll
        for (int i = 0; i < 4; ++i)
            __builtin_amdgcn_global_load_lds((const GAS unsigned*)((const GAS bf16_t*)bbase + boff16[i]), (__attribute__((address_space(3))) unsigned*)(sB + a_lds + i * 8192), 16, 0, 0);
    }
    __syncthreads();
    for (int kt = 0; kt < nkt; ++kt) {
        const int cur = (kt & 1) * 65536;
        const int nxt = cur ^ 65536;
        const bool more = (kt + 1 < nkt);
        if (more) {
#pragma unroll
            for (int i = 0; i < AR; ++i)
                __builtin_amdgcn_global_load_lds((const GAS unsigned*)(abase + (kt + 1) * 64 + aoff[i]), (__attribute__((address_space(3))) unsigned*)(sA + nxt + a_lds + i * 8192), 16, 0, 0);
            if constexpr (BMODE == 0) {
#pragma unroll
                for (int j = 0; j < 8; ++j) rb[j] = *(const GAS f32x4*)((const GAS float*)bbase + (size_t)((kt + 1) * 64 + j) * ldb + boff);
            } else {
#pragma unroll
                for (int i = 0; i < 4; ++i)
                    __builtin_amdgcn_global_load_lds((const GAS unsigned*)((const GAS bf16_t*)bbase + (kt + 1) * 64 + boff16[i]), (__attribute__((address_space(3))) unsigned*)(sB + nxt + a_lds + i * 8192), 16, 0, 0);
            }
        }
        mid(kt, acc, wr, fr, fq);
        constexpr int GQ = MT / 2, NG = 2 * GQ;
        bf16x8 bfr[4], af[2][2];
#pragma unroll
        for (int n = 0; n < 4; ++n) bfr[n] = *(const bf16x8*)(sB + cur + b_frag + n * 2048 + c0);
#pragma unroll
        for (int m = 0; m < 2; ++m) af[0][m] = *(const bf16x8*)(sA + cur + a_frag + m * 2048 + c0);
#pragma unroll
        for (int g = 0; g < NG; ++g) {
            const int ks = g / GQ, mq = g % GQ;
            if (g + 1 < NG) {
                const int ks1 = (g + 1) / GQ, mq1 = (g + 1) % GQ;
#pragma unroll
                for (int m = 0; m < 2; ++m) af[(g + 1) & 1][m] = *(const bf16x8*)(sA + cur + a_frag + (mq1 * 2 + m) * 2048 + (ks1 ? c1 : c0));
            }
#pragma unroll
            for (int m = 0; m < 2; ++m)
#pragma unroll
                for (int n = 0; n < 4; ++n)
                    acc[mq * 2 + m][n] = TR ? __builtin_amdgcn_mfma_f32_16x16x32_bf16(bfr[n], af[g & 1][m], acc[mq * 2 + m][n], 0, 0, 0)
                                            : __builtin_amdgcn_mfma_f32_16x16x32_bf16(af[g & 1][m], bfr[n], acc[mq * 2 + m][n], 0, 0, 0);
            if (g == GQ - 1) {
#pragma unroll
                for (int n = 0; n < 4; ++n) bfr[n] = *(const bf16x8*)(sB + cur + b_frag + n * 2048 + c1);
            }
            if (BMODE == 0 && g == NG - 2) {
                if (more) {
                    const float* f = (const float*)rb;
#pragma unroll
                    for (int i = 0; i < 4; ++i) {
                        uint4 w; w.x = pk2(f[0 * 4 + i], f[1 * 4 + i]); w.y = pk2(f[2 * 4 + i], f[3 * 4 + i]); w.z = pk2(f[4 * 4 + i], f[5 * 4 + i]); w.w = pk2(f[6 * 4 + i], f[7 * 4 + i]);
                        *(uint4*)(sB + nxt + tile_off(b_n4 + i, b_kg)) = w;
                    }
                }
            }
            __builtin_amdgcn_sched_barrier(0);
        }
        __syncthreads();
    }
    epi(acc, wr, wc, fr, fq);
}

struct NoMid { template <class ACC> __device__ __forceinline__ void operator()(int, ACC&, int, int, int) const {} };
struct ARows { const bf16_t* base; int lda; __device__ __forceinline__ const bf16_t* ubase() const { return base; } __device__ __forceinline__ unsigned row_off(int r) const { return (unsigned)r * (unsigned)lda; } };
struct BRows16 { const bf16_t* base; int ld; __device__ __forceinline__ const bf16_t* ubase(int) const { return base; } __device__ __forceinline__ unsigned row_off(int r) const { return (unsigned)r * (unsigned)ld; } };
struct BCols { const float* base; __device__ __forceinline__ const float* ubase(int) const { return base; } __device__ __forceinline__ unsigned col_off(int n4) const { return (unsigned)n4; } };

#define G8_HT 16384
__device__ __forceinline__ void g8_stage_rc(int b, int& R, int& C) { const int st = b / 1024, sb = b % 1024, swz = sb ^ (((sb >> 9) & 1) << 5); R = (st >> 1) * 16 + swz / 64; C = (st & 1) * 32 + (swz % 64) / 2; }
#define G8_WAIT_V(n) asm volatile("s_waitcnt vmcnt(" #n ")" ::: "memory")
#define G8_WAIT_L(n) asm volatile("s_waitcnt lgkmcnt(" #n ")" ::: "memory")
#define G8_BAR __builtin_amdgcn_s_barrier()
#define G8_SCHED __builtin_amdgcn_sched_barrier(0)

template <bool TR, class ALoad, class BLoad, class Mid, class Epi>
__device__ __forceinline__ void gemm8_tile(unsigned char* smem, const ALoad& al, const BLoad& bl, int nt, const Mid& mid, const Epi& epi) {
    int tid_ = threadIdx.x; asm volatile("" : "+v"(tid_));
    const int tid = tid_, lane = tid & 63, wid = tid >> 6, wr = wid >> 2, wc = wid & 3, fr = lane & 15, fq = lane >> 4;
    unsigned char* const shm = smem + SM_GEMM;
    const GAS bf16_t* const abase = uniform_ptr(al.ubase());
    const GAS bf16_t* const bbase0 = uniform_ptr(bl.half_base(0));
    const GAS bf16_t* const bbase1 = uniform_ptr(bl.half_base(1));
    unsigned aoff[2][2], boff[2];
#pragma unroll
    for (int i = 0; i < 2; ++i) {
        int R, C; g8_stage_rc(tid * 16 + i * 8192, R, C);
        aoff[0][i] = al.row_off(R) + (unsigned)C; aoff[1][i] = al.row_off(128 + R) + (unsigned)C; boff[i] = bl.row_off(R) + (unsigned)C;
    }
    const int wlds = __builtin_amdgcn_readfirstlane(wid * 1024);
    const int lane_off = fr * 64 + ((fq * 16) ^ ((fr >> 3) << 5));
#define G8_SA(b, h) (shm + ((b) * 2 + (h)) * G8_HT)
#define G8_SB(b, h) (shm + (4 + (b) * 2 + (h)) * G8_HT)
#define G8_STAGE_A(b, h, kt) do { _Pragma("unroll") for (int _i = 0; _i < 2; ++_i) \
        __builtin_amdgcn_global_load_lds((const GAS unsigned*)(abase + (size_t)(kt) * 64 + aoff[h][_i]), (LAS unsigned*)(G8_SA(b, h) + wlds + _i * 8192), 16, 0, 0); } while (0)
#define G8_STAGE_B(b, h, kt) do { _Pragma("unroll") for (int _i = 0; _i < 2; ++_i) \
        __builtin_amdgcn_global_load_lds((const GAS unsigned*)(((h) ? bbase1 : bbase0) + (size_t)(kt) * 64 + boff[_i]), (LAS unsigned*)(G8_SB(b, h) + wlds + _i * 8192), 16, 0, 0); } while (0)
#define G8_LDA(dst, b, h) do { _Pragma("unroll") for (int _m = 0; _m < 4; ++_m) _Pragma("unroll") for (int _k = 0; _k < 2; ++_k) \
        dst[_m][_k] = *(const bf16x8*)(G8_SA(b, h) + ((wr * 4 + _m) * 2 + _k) * 1024 + lane_off); } while (0)
#define G8_LDB(dst, b, h) do { _Pragma("unroll") for (int _n = 0; _n < 2; ++_n) _Pragma("unroll") for (int _k = 0; _k < 2; ++_k) \
        dst[_n][_k] = *(const bf16x8*)(G8_SB(b, h) + ((wc * 2 + _n) * 2 + _k) * 1024 + lane_off); } while (0)
#define G8_MMA(ai, bj, AT, BT) do { __builtin_amdgcn_s_setprio(1); \
        _Pragma("unroll") for (int _m = 0; _m < 4; ++_m) _Pragma("unroll") for (int _n = 0; _n < 2; ++_n) _Pragma("unroll") for (int _k = 0; _k < 2; ++_k) \
            acc[ai][bj][_m][_n] = TR ? __builtin_amdgcn_mfma_f32_16x16x32_bf16(BT[_n][_k], AT[_m][_k], acc[ai][bj][_m][_n], 0, 0, 0) \
                                     : __builtin_amdgcn_mfma_f32_16x16x32_bf16(AT[_m][_k], BT[_n][_k], acc[ai][bj][_m][_n], 0, 0, 0); \
        __builtin_amdgcn_s_setprio(0); } while (0)

    f32x4 acc[2][2][4][2];
#pragma unroll
    for (int a = 0; a < 2; ++a)
#pragma unroll
        for (int b = 0; b < 2; ++b)
#pragma unroll
            for (int m = 0; m < 4; ++m)
#pragma unroll
                for (int n = 0; n < 2; ++n) acc[a][b][m][n] = (f32x4){0.f, 0.f, 0.f, 0.f};
    bf16x8 At[4][2], B0[2][2], B1[2][2];
    __syncthreads();
    G8_STAGE_B(0, 0, 0); G8_STAGE_A(0, 0, 0); G8_STAGE_B(0, 1, 0); G8_STAGE_A(0, 1, 0);
    if (wr == 1) G8_BAR;
    G8_WAIT_V(4); G8_BAR;
    G8_STAGE_B(1, 0, 1); G8_STAGE_A(1, 0, 1); G8_STAGE_B(1, 1, 1);
    G8_WAIT_V(6); G8_BAR;
    for (int t = 0; t < nt - 2; t += 2) {
        mid(t, acc, wr, fr, fq);
        G8_LDB(B0, 0, 0); G8_SCHED; G8_LDA(At, 0, 0); G8_STAGE_A(1, 1, t + 1);
        G8_WAIT_L(8); G8_BAR; G8_WAIT_L(0); G8_MMA(0, 0, At, B0); G8_BAR; G8_SCHED;
        G8_LDB(B1, 0, 1); G8_STAGE_B(0, 0, t + 2);
        G8_BAR; G8_WAIT_L(0); G8_MMA(0, 1, At, B1); G8_BAR;
        G8_LDA(At, 0, 1); G8_STAGE_A(0, 0, t + 2);
        G8_BAR; G8_WAIT_L(0); G8_MMA(1, 0, At, B0); G8_BAR; G8_SCHED;
        G8_STAGE_B(0, 1, t + 2);
        G8_WAIT_V(6); G8_BAR; G8_MMA(1, 1, At, B1); G8_BAR;
        G8_LDB(B0, 1, 0); G8_SCHED; G8_LDA(At, 1, 0); G8_STAGE_A(0, 1, t + 2);
        G8_WAIT_L(8); G8_BAR; G8_WAIT_L(0); G8_MMA(0, 0, At, B0); G8_BAR; G8_SCHED;
        G8_LDB(B1, 1, 1); G8_STAGE_B(1, 0, t + 3);
        G8_BAR; G8_WAIT_L(0); G8_MMA(0, 1, At, B1); G8_BAR;
        G8_LDA(At, 1, 1); G8_STAGE_A(1, 0, t + 3);
        G8_BAR; G8_WAIT_L(0); G8_MMA(1, 0, At, B0); G8_BAR; G8_SCHED;
        G8_STAGE_B(1, 1, t + 3);
        G8_WAIT_V(6); G8_BAR; G8_MMA(1, 1, At, B1); G8_BAR;
    }
    { G8_LDB(B0, 0, 0); G8_LDA(At, 0, 0); G8_STAGE_A(1, 1, nt - 1);
      G8_BAR; G8_WAIT_L(0); G8_MMA(0, 0, At, B0); G8_BAR;
      G8_LDB(B1, 0, 1); G8_BAR; G8_WAIT_L(0); G8_MMA(0, 1, At, B1); G8_BAR;
      G8_LDA(At, 0, 1); G8_WAIT_V(4); G8_BAR; G8_WAIT_L(0); G8_MMA(1, 0, At, B0); G8_MMA(1, 1, At, B1); G8_BAR; }
    { G8_LDB(B0, 1, 0); G8_LDA(At, 1, 0); G8_WAIT_V(2); G8_BAR; G8_WAIT_L(0); G8_MMA(0, 0, At, B0); G8_BAR;
      G8_LDB(B1, 1, 1); G8_WAIT_V(0); G8_BAR; G8_WAIT_L(0); G8_MMA(0, 1, At, B1); G8_BAR;
      G8_LDA(At, 1, 1); G8_BAR; G8_WAIT_L(0); G8_MMA(1, 0, At, B0); G8_MMA(1, 1, At, B1); G8_BAR; }
    if (wr == 0) G8_BAR;
    epi(acc, wr, wc, fr, fq);
}
struct NoMid8 { template <class ACC> __device__ __forceinline__ void operator()(int, ACC&, int, int, int) const {} };
struct BHalves { const bf16_t* h0; const bf16_t* h1; int ld;
    __device__ __forceinline__ const bf16_t* half_base(int h) const { return h ? h1 : h0; }
    __device__ __forceinline__ unsigned row_off(int r) const { return (unsigned)r * (unsigned)ld; } };

struct ConvItem { const float* s; bf16_t* d; int N, ldd; };
__device__ __forceinline__ ConvItem conv_decode(const MKParams& p, int it, int lane) {
    const int kg = lane & 7, n4 = (lane >> 3) << 2;
    const float* src; bf16_t* dst; int N, ldd, r;
    if (it < 4096) { src = p.w_in; dst = p.w_in_t; N = DIN_; ldd = XN_LD; r = it; }
    else if (it < 6144) { src = p.w_out; dst = p.w_out_t; N = D_; ldd = D_; r = it - 4096; }
    else if (it < 6656) { src = p.w_glu; dst = p.w_glu_t; N = DS_; ldd = DS_; r = it - 6144; }
    else {
        const int j = it - 6656, mat = j >> 11, which = mat >> 4, e = mat & 15;
        r = j & 2047; N = 2048; ldd = 2048;
        const size_t eo = (size_t)e * D_ * FF_;
        src = (which == 0 ? p.w_gate : (which == 1 ? p.w_up : p.w_down)) + eo;
        dst = (which == 0 ? p.w_gate_t : (which == 1 ? p.w_up_t : p.w_down_t)) + eo;
    }
    const int nn32 = N >> 5, kt = r / nn32, nt = r % nn32;
    ConvItem c;
    c.s = src + (size_t)(kt * 64 + kg * 8) * N + nt * 32 + n4;
    c.d = dst + (size_t)(nt * 32 + n4) * ldd + kt * 64 + kg * 8;
    c.N = N; c.ldd = ldd;
    return c;
}
__device__ __forceinline__ void conv_load(const ConvItem& c, f32x4 (&r)[8]) {
#pragma unroll
    for (int j = 0; j < 8; ++j) r[j] = *(const f32x4*)(c.s + (size_t)j * c.N);
}
__device__ __forceinline__ void conv_store(const ConvItem& c, const f32x4 (&r)[8]) {
#pragma unroll
    for (int i = 0; i < 4; ++i) {
        uint4 w; w.x = pk2(r[0][i], r[1][i]); w.y = pk2(r[2][i], r[3][i]); w.z = pk2(r[4][i], r[5][i]); w.w = pk2(r[6][i], r[7][i]);
        *(uint4*)(c.d + (size_t)i * c.ldd) = w;
    }
}
#define CONV_ITEMS (4096 + 2048 + 512 + 48 * 2048)
__device__ __forceinline__ void conv_all(const MKParams& p, int gw, int NGW, int lane) {
    int it = gw;
    if (it >= CONV_ITEMS) return;
    f32x4 ra[8], rb[8];
    ConvItem ca = conv_decode(p, it, lane), cb = ca;
    conv_load(ca, ra);
    for (;;) {
        const int it2 = it + NGW;
        const bool has2 = it2 < CONV_ITEMS;
        if (has2) { cb = conv_decode(p, it2, lane); conv_load(cb, rb); }
        conv_store(ca, ra);
        if (!has2) break;
        const int it3 = it2 + NGW;
        const bool has3 = it3 < CONV_ITEMS;
        if (has3) { ca = conv_decode(p, it3, lane); conv_load(ca, ra); }
        conv_store(cb, rb);
        if (!has3) break;
        it = it3;
    }
}

template <bool TR>
struct EpiInProj8 {
    const MKParams& p; int m0, n0;
    __device__ __forceinline__ void operator()(f32x4 (&acc)[2][2][4][2], int wr, int wc, int fr, int fq) const {
#pragma unroll
        for (int ai = 0; ai < 2; ++ai)
#pragma unroll
            for (int m = 0; m < 4; ++m) {
                if (TR) {
                    const int token = m0 + ai * 128 + wr * 64 + m * 16 + fr;
                    const float rs = p.rstd_x[token];
#pragma unroll
                    for (int bj = 0; bj < 2; ++bj)
#pragma unroll
                        for (int n = 0; n < 2; ++n) {
                            const int col = n0 + bj * 128 + wc * 32 + n * 16 + fq * 4;
                            const f32x4 a = acc[ai][bj][m][n];
                            uint2 w;
                            if (n0 < 1024) {
                                w.x = pk2(a[0] * rs, a[1] * rs); w.y = pk2(a[2] * rs, a[3] * rs);
                                *(uint2*)(p.ua + ((size_t)(col >> 4) * 256 + (token >> 5)) * 768 + (token & 31) * 16 + (col & 15)) = w;
                            } else if (n0 < 2048) {
                                const float r8 = rs * 0.125f;
                                w.x = pk2(a[0] * r8, a[1] * r8); w.y = pk2(a[2] * r8, a[3] * r8);
                                *(uint2*)(p.qb + (size_t)token * 1024 + (col - 1024)) = w;
                            } else {
                                w.x = pk2(a[0] * rs, a[1] * rs); w.y = pk2(a[2] * rs, a[3] * rs);
                                *(uint2*)(p.kb + (size_t)token * 1024 + (col - 2048)) = w;
                            }
                        }
                } else {
                    const int token = m0 + ai * 128 + wr * 64 + m * 16 + fq * 4;
                    const float4 rs = *(const float4*)(p.rstd_x + token);
#pragma unroll
                    for (int bj = 0; bj < 2; ++bj)
#pragma unroll
                        for (int n = 0; n < 2; ++n) {
                            const int f = n0 - 3072 + bj * 128 + wc * 32 + n * 16 + fr;
                            const f32x4 a = acc[ai][bj][m][n];
                            uint2 w; w.x = pk2(a[0] * rs.x, a[1] * rs.y); w.y = pk2(a[2] * rs.z, a[3] * rs.w);
                            *(uint2*)(p.vT + (size_t)f * L_ + token) = w;
                        }
                }
            }
    }
};
struct MidOut8 {
    const float* rows;
    __device__ __forceinline__ void operator()(int t, f32x4 (&acc)[2][2][4][2], int wr, int fr, int fq) const {
        if (t == 16) {
#pragma unroll
            for (int ai = 0; ai < 2; ++ai)
#pragma unroll
                for (int m = 0; m < 4; ++m) {
                    const float ratio = rows[ai * 128 + wr * 64 + m * 16 + fr];
#pragma unroll
                    for (int bj = 0; bj < 2; ++bj)
#pragma unroll
                        for (int n = 0; n < 2; ++n) acc[ai][bj][m][n] *= ratio;
                }
        }
    }
};
struct EpiOut8 {
    const MKParams& p; const float* rows; int m0, n0, pn;
    __device__ __forceinline__ void operator()(f32x4 (&acc)[2][2][4][2], int wr, int wc, int fr, int fq) const {
#pragma unroll
        for (int ai = 0; ai < 2; ++ai)
#pragma unroll
            for (int m = 0; m < 4; ++m) {
                const int rt = ai * 128 + wr * 64 + m * 16 + fr, token = m0 + rt;
                const float rn = rows[256 + rt];
                float ss = 0.f;
#pragma unroll
                for (int bj = 0; bj < 2; ++bj)
#pragma unroll
                    for (int n = 0; n < 2; ++n) {
                        const int col = n0 + bj * 128 + wc * 32 + n * 16 + fq * 4;
                        const float4 xv = *(const float4*)(p.x + (size_t)token * D_ + col);
                        const float4 g = *(const float4*)(p.g_ffn + col);
                        const f32x4 a = acc[ai][bj][m][n];
                        const float v0 = xv.x + a[0] * rn, v1 = xv.y + a[1] * rn, v2 = xv.z + a[2] * rn, v3 = xv.w + a[3] * rn;
                        ss += v0 * v0 + v1 * v1 + v2 * v2 + v3 * v3;
                        uint2 w; w.x = pk2(v0 * g.x, v1 * g.y); w.y = pk2(v2 * g.z, v3 * g.w);
                        *(uint2*)(p.x1g + (size_t)token * D_ + col) = w;
                    }
                ss += __shfl_xor(ss, 16); ss += __shfl_xor(ss, 32);
                if (fq == 0) p.ssq_x1[token * 32 + pn * 4 + wc] = ss;
            }
    }
};
struct EpiMoe1_8 {
    const MKParams& p; int e, mt, nt;
    __device__ __forceinline__ void operator()(f32x4 (&acc)[2][2][4][2], int wr, int wc, int fr, int fq) const {
#pragma unroll
        for (int ai = 0; ai < 2; ++ai)
#pragma unroll
            for (int m = 0; m < 4; ++m) {
                const int slot = mt * 256 + ai * 128 + wr * 64 + m * 16 + fr;
                const float rs = p.rstd_x1[p.idx[e * CAP_ + slot]];
#pragma unroll
                for (int n = 0; n < 2; ++n) {
                    const f32x4 g = acc[ai][0][m][n] * rs, u = acc[ai][1][m][n] * rs;
                    float a[4];
#pragma unroll
                    for (int i = 0; i < 4; ++i) a[i] = g[i] / (1.f + __expf(-g[i])) * u[i];
                    uint2 w; w.x = pk2(a[0], a[1]); w.y = pk2(a[2], a[3]);
                    *(uint2*)(p.act + (size_t)(e * CAP_ + slot) * FF_ + nt * 128 + wc * 32 + n * 16 + fq * 4) = w;
                }
            }
    }
};
struct EpiMoe2_8 {
    const MKParams& p; int e, mt, nt;
    __device__ __forceinline__ void operator()(f32x4 (&acc)[2][2][4][2], int wr, int wc, int fr, int fq) const {
#pragma unroll
        for (int ai = 0; ai < 2; ++ai)
#pragma unroll
            for (int m = 0; m < 4; ++m) {
                const int slot = mt * 256 + ai * 128 + wr * 64 + m * 16 + fr;
                const float gt = p.gate[e * CAP_ + slot];
#pragma unroll
                for (int bj = 0; bj < 2; ++bj)
#pragma unroll
                    for (int n = 0; n < 2; ++n) {
                        const f32x4 a = acc[ai][bj][m][n] * gt;
                        uint2 w; w.x = pk2(a[0], a[1]); w.y = pk2(a[2], a[3]);
                        *(uint2*)(p.ye + (size_t)(e * CAP_ + slot) * D_ + nt * 256 + bj * 128 + wc * 32 + n * 16 + fq * 4) = w;
                    }
            }
    }
};

__device__ __forceinline__ void phase_prep(const MKParams& p, int gw, int NGW, int lane) {
    for (int row = gw; row < L_; row += NGW) {
        const float4* xr = (const float4*)(p.x + (size_t)row * D_);
        const float4* gr = (const float4*)p.g_mix;
        float s = 0.f;
        uint2* o = (uint2*)(p.xn + (size_t)row * XN_LD);
#pragma unroll
        for (int j = 0; j < 8; ++j) {
            const float4 v = xr[lane + 64 * j]; const float4 g = gr[lane + 64 * j];
            s += v.x * v.x + v.y * v.y + v.z * v.z + v.w * v.w;
            uint2 w; w.x = pk2(v.x * g.x, v.y * g.y); w.y = pk2(v.z * g.z, v.w * g.w);
            o[lane + 64 * j] = w;
        }
        s = wave_sum(s);
        if (lane == 0) p.rstd_x[row] = 1.0f / sqrtf(s * (1.0f / D_) + 1e-6f);
    }
    for (int i = gw * 64 + lane; i < NE_ * D_; i += NGW * 64) {
        const int e = i >> 11, n = i & (D_ - 1);
        const float w = p.w_router[n * NE_ + e];
        const unsigned hi = pk2(w, 0.f) & 0xffffu;
        const float rem = w - __uint_as_float(hi << 16);
        p.wrT[i] = (bf16_t)hi; p.wrT[NE_ * D_ + i] = (bf16_t)(pk2(rem, 0.f) & 0xffffu);
    }
}

__device__ __forceinline__ void phase_inproj(const MKParams& p, unsigned char* smem, int b) {
    for (int it = b; it < 512; it += gridDim.x) {
        const int xcd = it & 7, q = it >> 3;
        const int pn = (q & 1) * 8 + xcd;
        const int pm = q >> 1;
        const int m0 = pm * 256, n0 = pn * 256;
        ARows al{p.xn + (size_t)m0 * XN_LD, XN_LD};
        BHalves bl{p.w_in_t + (size_t)n0 * XN_LD, p.w_in_t + (size_t)(n0 + 128) * XN_LD, XN_LD};
        if (n0 < 3072) gemm8_tile<true>(smem, al, bl, D_ / 64, NoMid8{}, EpiInProj8<true>{p, m0, n0});
        else           gemm8_tile<false>(smem, al, bl, D_ / 64, NoMid8{}, EpiInProj8<false>{p, m0, n0});
    }
}

#define UA_LD 768
#define WSYNC() asm volatile("s_waitcnt lgkmcnt(0)" ::: "memory")
__device__ __forceinline__ void ssm_tables(const MKParams& p, unsigned char* smem, int g, int part, int lane) {
    float2* apow = (float2*)(smem + SM_GEMM);
    float2* bbar = apow + 2 * 33 * 64;
    float2* cc = bbar + 2 * 64 * 16;
    float* taps = (float*)(cc + 2 * 16 * 64);
#pragma unroll 1
    for (int d = 0; d < 2; ++d) {
        const int pp = lane;
        const float lr = (d ? p.a_re_b : p.a_re_f)[g * 64 + pp], li = (d ? p.a_im_b : p.a_im_f)[g * 64 + pp];
        const float dt = expf((d ? p.ldt_b : p.ldt_f)[g]);
        const float x = lr * dt, y = li * dt;
        const float ex = expf(x), cy = cosf(y), sy = sinf(y), sh = sinf(0.5f * y);
        const float ar = ex * cy, ai = ex * sy;
        float sr = 1.f, si = 0.f;
        for (int t = 0; t <= 32; ++t) {
            apow[(d * 33 + t) * 64 + pp] = make_float2(sr, si);
            const float nr = sr * ar - si * ai, ni = sr * ai + si * ar; sr = nr; si = ni;
        }
        if (part == 0) *(float2*)(p.A32 + ((size_t)(g * 2 + d) * 64 + pp) * 2) = apow[(d * 33 + 32) * 64 + pp];
        const float nr = expm1f(x) * cy - 2.f * sh * sh, ni = ex * sy;
        const float den = lr * lr + li * li;
        const float fr_ = (nr * lr + ni * li) / den, fi_ = (ni * lr - nr * li) / den;
        const float* brp = (d ? p.b_re_b : p.b_re_f) + (g * 64 + pp) * 16;
        const float* bip = (d ? p.b_im_b : p.b_im_f) + (g * 64 + pp) * 16;
#pragma unroll
        for (int q4 = 0; q4 < 4; ++q4) {
            const float4 br = *(const float4*)(brp + q4 * 4), bi = *(const float4*)(bip + q4 * 4);
            float2* o = bbar + (d * 64 + pp) * 16 + q4 * 4;
            o[0] = make_float2(fr_ * br.x - fi_ * bi.x, fr_ * bi.x + fi_ * br.x);
            o[1] = make_float2(fr_ * br.y - fi_ * bi.y, fr_ * bi.y + fi_ * br.y);
            o[2] = make_float2(fr_ * br.z - fi_ * bi.z, fr_ * bi.z + fi_ * br.z);
            o[3] = make_float2(fr_ * br.w - fi_ * bi.w, fr_ * bi.w + fi_ * br.w);
        }
        const float* crp = (d ? p.c_re_b : p.c_re_f) + (g * 16) * 64 + pp;
        const float* cip = (d ? p.c_im_b : p.c_im_f) + (g * 16) * 64 + pp;
#pragma unroll
        for (int co = 0; co < 16; ++co) cc[(d * 16 + co) * 64 + pp] = make_float2(crp[co * 64], cip[co * 64]);
    }
    WSYNC();
    {
        const int li_ = lane & 15, lk = lane >> 4;
#pragma unroll 1
        for (int co = 0; co < 16; ++co) {
#pragma unroll 1
            for (int d = 0; d < 2; ++d) {
                f32x4 acc0 = (f32x4){0.f, 0.f, 0.f, 0.f}, acc1 = acc0;
#pragma unroll 4
                for (int s = 0; s < 32; ++s) {
                    const int q = 2 * s + (lk >> 1), ri = lk & 1;
                    const float2 c = cc[(d * 16 + co) * 64 + q], bb = bbar[(d * 64 + q) * 16 + li_];
                    const float gb = ri ? -(c.x * bb.y + c.y * bb.x) : (c.x * bb.x - c.y * bb.y);
                    const float2 a0 = apow[(d * 33 + li_) * 64 + q], a1 = apow[(d * 33 + 16 + li_) * 64 + q];
                    acc0 = __builtin_amdgcn_mfma_f32_16x16x4f32(ri ? a0.y : a0.x, gb, acc0, 0, 0, 0);
                    acc1 = __builtin_amdgcn_mfma_f32_16x16x4f32(ri ? a1.y : a1.x, gb, acc1, 0, 0, 0);
                }
#pragma unroll
                for (int r = 0; r < 4; ++r) {
                    const int t0 = 4 * lk + r, t1 = 16 + 4 * lk + r;
                    float* p0 = taps + ((d ? 31 - t0 : 31 + t0) * 16 + co) * 16 + li_;
                    float* p1 = taps + ((d ? 31 - t1 : 31 + t1) * 16 + co) * 16 + li_;
                    if (d == 1 && t0 == 0) *p0 += acc0[r]; else *p0 = acc0[r];
                    *p1 = acc1[r];
                }
            }
        }
    }
    WSYNC();
#pragma unroll 1
    for (int it = lane; it < 128 * 96; it += 64) {
        const int n = part * 128 + it / 96, k = (it % 96) * 8;
        const int l = n >> 4, co = n & 15;
        float v[8];
        if (k < 512) {
            const int j = k >> 4, ci0 = ((k >> 3) & 1) * 8;
            const float* tp = taps + ((l - j + 31) * 16 + co) * 16 + ci0;
#pragma unroll
            for (int q = 0; q < 8; ++q) v[q] = tp[q];
        } else {
            const int k2 = k - 512, d = k2 >> 7, pp0 = (k2 >> 1) & 63;
            const int t = d ? (32 - l) : (l + 1);
#pragma unroll
            for (int q = 0; q < 4; ++q) {
                const float2 a = apow[(d * 33 + t) * 64 + pp0 + q], c = cc[(d * 16 + co) * 64 + pp0 + q];
                v[2 * q] = c.x * a.x - c.y * a.y; v[2 * q + 1] = -(c.x * a.y + c.y * a.x);
            }
        }
        uint4 w; w.x = pk2(v[0], v[1]); w.y = pk2(v[2], v[3]); w.z = pk2(v[4], v[5]); w.w = pk2(v[6], v[7]);
        *(uint4*)(p.WyT + ((size_t)g * 512 + n) * UA_LD + k) = w;
    }
#pragma unroll 1
    for (int it = lane; it < 64 * 64; it += 64) {
        const int n2 = part * 64 + (it >> 6), kc = it & 63;
        const int d = n2 >> 7, pp = (n2 >> 1) & 63, ri = n2 & 1, j = kc >> 1, half = kc & 1;
        const int t = d ? j : 31 - j;
        const float2 a = apow[(d * 33 + t) * 64 + pp];
        const float2* bp = bbar + (d * 64 + pp) * 16 + half * 8;
        float v[8];
#pragma unroll
        for (int q = 0; q < 8; ++q) { const float2 b = bp[q]; v[q] = ri ? (a.x * b.y + a.y * b.x) : (a.x * b.x - a.y * b.y); }
        uint4 w; w.x = pk2(v[0], v[1]); w.y = pk2(v[2], v[3]); w.z = pk2(v[4], v[5]); w.w = pk2(v[6], v[7]);
        *(uint4*)(p.PBt + ((size_t)g * 256 + n2) * 512 + kc * 8) = w;
    }
    WSYNC();
}

#define SE_PITCH 132
struct EpiSsmE {
    const MKParams& p; unsigned char* smem; int g;
    __device__ __forceinline__ void operator()(f32x4 (&acc)[2][2][4][2], int wr, int wc, int fr, int fq) const {
        float* E = (float*)(smem + SM_GEMM);
        const int tid = opaque_tid();
#pragma unroll
        for (int d = 0; d < 2; ++d) {
            __syncthreads();
#pragma unroll
            for (int ai = 0; ai < 2; ++ai)
#pragma unroll
                for (int m = 0; m < 4; ++m)
#pragma unroll
                    for (int n = 0; n < 2; ++n)
                        *(f32x4*)(E + (ai * 128 + wr * 64 + m * 16 + fr) * SE_PITCH + wc * 32 + n * 16 + fq * 4) = acc[ai][d][m][n];
            __syncthreads();
            if (tid < 64) {
                const int pp = tid;
                const float2 A = *(const float2*)(p.A32 + ((size_t)(g * 2 + d) * 64 + pp) * 2);
                bf16_t* sdst = p.ua + (size_t)g * 256 * UA_LD + 512 + d * 128 + pp * 2;
                float sr = 0.f, si = 0.f;
#pragma unroll 8
                for (int s = 0; s < 256; ++s) {
                    const int c = d ? (255 - s) : s;
                    const float2 e = *(const float2*)(E + c * SE_PITCH + pp * 2);
                    *(unsigned*)(sdst + (size_t)c * UA_LD) = pk2(sr, si);
                    const float nr = A.x * sr - A.y * si + e.x, ni = A.x * si + A.y * sr + e.y;
                    sr = nr; si = ni;
                }
            }
        }
    }
};
__device__ __forceinline__ void ssm_e_item(const MKParams& p, unsigned char* smem, int g) {
    ARows al{p.ua + (size_t)g * 256 * UA_LD, UA_LD};
    BHalves bl{p.PBt + (size_t)g * 256 * 512, p.PBt + ((size_t)g * 256 + 128) * 512, 512};
    gemm8_tile<true>(smem, al, bl, 8, NoMid8{}, EpiSsmE{p, smem, g});
}

__device__ __forceinline__ float gelu_tanh_f(float x) {
    const float k0 = 0.7978845608028654f, k1 = 0.044715f;
    const float z = k0 * (x + k1 * x * x * x);
    const float e = __expf(2.f * z);
    return 0.5f * x * (2.f - 2.f / (1.f + e));
}
struct EpiSsmY {
    const MKParams& p; int g, nh;
    __device__ __forceinline__ void operator()(f32x4 (&acc)[2][2][4][2], int wr, int wc, int fr, int fq) const {
        const float4 dsk = *(const float4*)(p.ssm_d + g * 16 + fq * 4);
#pragma unroll
        for (int ai = 0; ai < 2; ++ai)
#pragma unroll
            for (int m = 0; m < 4; ++m) {
                const int c = ai * 128 + wr * 64 + m * 16 + fr;
                const bf16_t* urow = p.ua + ((size_t)g * 256 + c) * UA_LD + fq * 4;
#pragma unroll
                for (int bj = 0; bj < 2; ++bj)
#pragma unroll
                    for (int n = 0; n < 2; ++n) {
                        const int l = nh * 16 + bj * 8 + wc * 2 + n;
                        const uint2 uu = *(const uint2*)(urow + l * 16);
                        const f32x4 a = acc[ai][bj][m][n];
                        const float y0 = gelu_tanh_f(a[0] + dsk.x * bflo(uu.x)), y1 = gelu_tanh_f(a[1] + dsk.y * bfhi(uu.x));
                        const float y2 = gelu_tanh_f(a[2] + dsk.z * bflo(uu.y)), y3 = gelu_tanh_f(a[3] + dsk.w * bfhi(uu.y));
                        uint2 w; w.x = pk2(y0, y1); w.y = pk2(y2, y3);
                        *(uint2*)(p.ypre + (size_t)(c * 32 + l) * DS_ + g * 16 + fq * 4) = w;
                    }
            }
    }
};
__device__ __forceinline__ void ssm_y_item(const MKParams& p, unsigned char* smem, int g, int nh) {
    ARows al{p.ua + (size_t)g * 256 * UA_LD, UA_LD};
    BHalves bl{p.WyT + ((size_t)g * 512 + nh * 256) * UA_LD, p.WyT + ((size_t)g * 512 + nh * 256 + 128) * UA_LD, UA_LD};
    gemm8_tile<true>(smem, al, bl, 12, NoMid8{}, EpiSsmY{p, g, nh});
}

#define NA_RPB (SM_GEMM + 1024)
__device__ __forceinline__ void na_item(const MKParams& p, unsigned char* smem, int r, int hq) {
    int tid_ = threadIdx.x; asm volatile("" : "+v"(tid_));
    const int tid = tid_, lane = tid & 63, wave = tid >> 6, fr = lane & 15, fq = lane >> 4;
    const int h = hq * 4 + (wave >> 1), qh = wave & 1;
    int rs = r - 4; rs = rs < 0 ? 0 : (rs > 120 ? 120 : rs);
    bf16x8 qf[2][2];
#pragma unroll
    for (int qb = 0; qb < 2; ++qb)
#pragma unroll
        for (int ks = 0; ks < 2; ++ks) qf[qb][ks] = *(const bf16x8*)(p.qb + (size_t)(r * 64 + (2 * qh + qb) * 16 + fr) * 1024 + h * 64 + ks * 32 + fq * 8);
    int kbq[2], dxq[2];
#pragma unroll
    for (int qb = 0; qb < 2; ++qb) {
        const int c = (2 * qh + qb) * 16 + fr;
        int cs = c - 8; cs = cs < 0 ? 0 : (cs > 48 ? 48 : cs);
        kbq[qb] = 8 * fq - cs;
        dxq[qb] = (8 * fq - c + 15) * 4;
    }
    f32x4 o[2][4];
    float mrow[2], lrow[2];
#pragma unroll
    for (int qb = 0; qb < 2; ++qb) {
        mrow[qb] = -1e30f; lrow[qb] = 0.f;
#pragma unroll
        for (int mt = 0; mt < 4; ++mt) o[qb][mt] = (f32x4){0.f, 0.f, 0.f, 0.f};
    }
    const int krow_lane = (8 * (fr >> 2) + (fr & 3)) * 1024 + h * 64 + fq * 8;
    const size_t v_lane = (size_t)(h * 64 + fr) * L_ + 8 * fq;
    bf16x8 kf[2][2][2], vf[2][4];
    {
        const bf16_t* kbase = p.kb + (size_t)(rs * 64) * 1024 + krow_lane;
#pragma unroll
        for (int P = 0; P < 2; ++P)
#pragma unroll
            for (int sx = 0; sx < 2; ++sx)
#pragma unroll
                for (int ks = 0; ks < 2; ++ks) kf[P][sx][ks] = *(const bf16x8*)(kbase + (32 * P + 4 * sx) * 1024 + ks * 32);
#pragma unroll
        for (int P = 0; P < 2; ++P)
#pragma unroll
            for (int mt = 0; mt < 4; ++mt) vf[P][mt] = *(const bf16x8*)(p.vT + v_lane + (size_t)mt * 16 * L_ + rs * 64 + 32 * P);
    }
#pragma unroll 1
    for (int i = 0; i < 8; ++i) {
        const int inx = i < 7 ? i + 1 : 7;
        const int tokn = (rs + inx) * 64;
        const unsigned char* brow = smem + NA_RPB + ((h * 15 + (rs + i - r + 7)) * 31) * 4;
        f32x4 s[2][2][2];
#pragma unroll
        for (int P = 0; P < 2; ++P)
#pragma unroll
            for (int sx = 0; sx < 2; ++sx)
#pragma unroll
                for (int qb = 0; qb < 2; ++qb) {
                    f32x4 a = (f32x4){0.f, 0.f, 0.f, 0.f};
                    a = __builtin_amdgcn_mfma_f32_16x16x32_bf16(kf[P][sx][0], qf[qb][0], a, 0, 0, 0);
                    a = __builtin_amdgcn_mfma_f32_16x16x32_bf16(kf[P][sx][1], qf[qb][1], a, 0, 0, 0);
                    s[P][sx][qb] = a;
                }
        {
            const bf16_t* kbase = p.kb + (size_t)tokn * 1024 + krow_lane;
#pragma unroll
            for (int P = 0; P < 2; ++P)
#pragma unroll
                for (int sx = 0; sx < 2; ++sx)
#pragma unroll
                    for (int ks = 0; ks < 2; ++ks) kf[P][sx][ks] = *(const bf16x8*)(kbase + (32 * P + 4 * sx) * 1024 + ks * 32);
        }
        unsigned pp[2][2][4];
#pragma unroll
        for (int qb = 0; qb < 2; ++qb) {
            const unsigned char* bq = brow + dxq[qb];
            float bv[16];
#pragma unroll
            for (int c16 = 0; c16 < 16; ++c16) bv[c16] = *(const float*)(bq + (32 * (c16 >> 3) + 4 * ((c16 >> 2) & 1) + (c16 & 3)) * 4);
            asm volatile("" : "+v"(bv[0]), "+v"(bv[1]), "+v"(bv[2]), "+v"(bv[3]), "+v"(bv[4]), "+v"(bv[5]), "+v"(bv[6]), "+v"(bv[7]),
                              "+v"(bv[8]), "+v"(bv[9]), "+v"(bv[10]), "+v"(bv[11]), "+v"(bv[12]), "+v"(bv[13]), "+v"(bv[14]), "+v"(bv[15]));
            float mx = -1e30f;
#pragma unroll
            for (int P = 0; P < 2; ++P)
#pragma unroll
                for (int sx = 0; sx < 2; ++sx)
#pragma unroll
                    for (int rg = 0; rg < 4; ++rg) {
                        const int cst = 32 * P + 4 * sx + rg;
                        const bool valid = (unsigned)(cst + kbq[qb]) < 16u;
                        const float v = valid ? (s[P][sx][qb][rg] + bv[P * 8 + sx * 4 + rg]) : -1e30f;
                        s[P][sx][qb][rg] = v;
                        mx = fmaxf(mx, v);
                    }
            mx = fmaxf(mx, __shfl_xor(mx, 16));
            mx = fmaxf(mx, __shfl_xor(mx, 32));
            const float mn = fmaxf(mrow[qb], mx);
            const float alpha = __expf(mrow[qb] - mn);
            mrow[qb] = mn;
            float ls = 0.f;
#pragma unroll
            for (int P = 0; P < 2; ++P)
#pragma unroll
                for (int sx = 0; sx < 2; ++sx) {
                    float e[4];
#pragma unroll
                    for (int rg = 0; rg < 4; ++rg) { e[rg] = __expf(s[P][sx][qb][rg] - mn); ls += e[rg]; }
                    pp[qb][P][sx * 2 + 0] = pk2(e[0], e[1]);
                    pp[qb][P][sx * 2 + 1] = pk2(e[2], e[3]);
                }
            lrow[qb] = lrow[qb] * alpha + ls;
#pragma unroll
            for (int mt = 0; mt < 4; ++mt) o[qb][mt] *= alpha;
        }
#pragma unroll
        for (int P = 0; P < 2; ++P)
#pragma unroll
            for (int mt = 0; mt < 4; ++mt)
#pragma unroll
                for (int qb = 0; qb < 2; ++qb) {
                    uint4 w; w.x = pp[qb][P][0]; w.y = pp[qb][P][1]; w.z = pp[qb][P][2]; w.w = pp[qb][P][3];
                    o[qb][mt] = __builtin_amdgcn_mfma_f32_16x16x32_bf16(vf[P][mt], __builtin_bit_cast(bf16x8, w), o[qb][mt], 0, 0, 0);
                }
#pragma unroll
        for (int P = 0; P < 2; ++P)
#pragma unroll
            for (int mt = 0; mt < 4; ++mt) vf[P][mt] = *(const bf16x8*)(p.vT + v_lane + (size_t)mt * 16 * L_ + tokn + 32 * P);
    }
#pragma unroll
    for (int qb = 0; qb < 2; ++qb) {
        float l = lrow[qb];
        l += __shfl_xor(l, 16); l += __shfl_xor(l, 32);
        const float inv = 1.f / l;
        const int token = r * 64 + (2 * qh + qb) * 16 + fr;
        float ss = 0.f;
#pragma unroll
        for (int mt = 0; mt < 4; ++mt) {
            const float4 g = *(const float4*)(p.g_na + h * 64 + mt * 16 + 4 * fq);
            const f32x4 v = o[qb][mt] * inv;
            ss += v[0] * v[0] + v[1] * v[1] + v[2] * v[2] + v[3] * v[3];
            uint2 w; w.x = pk2(v[0] * g.x, v[1] * g.y); w.y = pk2(v[2] * g.z, v[3] * g.w);
            *(uint2*)(p.ymix + (size_t)token * D_ + DS_ + h * 64 + mt * 16 + 4 * fq) = w;
        }
        ss += __shfl_xor(ss, 16); ss += __shfl_xor(ss, 32);
        if (fq == 0) p.ssq_na[token * 16 + h] = ss;
    }
}
#define NA_ITEMS 512
__device__ __forceinline__ void phase2(const MKParams& p, unsigned char* smem, int b, int G, unsigned* counter) {
    for (int it = b; it < 64; it += G) ssm_e_item(p, smem, it);
    __syncthreads();
    const int tq = opaque_tid();
    { float* dst = (float*)(smem + NA_RPB); for (int i = tq; i < 16 * 15 * 31; i += NT_) dst[i] = p.rpb[i]; }
    volatile LAS int* slot = (volatile LAS int*)(smem + 32);
    for (;;) {
        __syncthreads();
        if (tq == 0) *slot = (int)__hip_atomic_fetch_add(counter, 1u, __ATOMIC_RELAXED, __HIP_MEMORY_SCOPE_AGENT);
        __syncthreads();
        const int j = *slot;
        if (j >= NA_ITEMS) break;
        na_item(p, smem, j >> 2, j & 3);
    }
}

struct EpiGlu8 {
    const MKParams& p; int m0, n0, pn;
    __device__ __forceinline__ void operator()(f32x4 (&acc)[2][2][4][2], int wr, int wc, int fr, int fq) const {
#pragma unroll
        for (int ai = 0; ai < 2; ++ai)
#pragma unroll
            for (int m = 0; m < 4; ++m) {
                const int token = m0 + ai * 128 + wr * 64 + m * 16 + fr;
                float ss = 0.f;
#pragma unroll
                for (int bj = 0; bj < 2; ++bj)
#pragma unroll
                    for (int n = 0; n < 2; ++n) {
                        const int col = n0 + bj * 128 + wc * 32 + n * 16 + fq * 4;
                        const float4 b = *(const float4*)(p.b_glu + col);
                        const float4 g = *(const float4*)(p.g_ssm + col);
                        const uint2 yy = *(const uint2*)(p.ypre + (size_t)token * DS_ + col);
                        const f32x4 a = acc[ai][bj][m][n];
                        const float y0 = bflo(yy.x) / (1.f + __expf(-(a[0] + b.x))), y1 = bfhi(yy.x) / (1.f + __expf(-(a[1] + b.y)));
                        const float y2 = bflo(yy.y) / (1.f + __expf(-(a[2] + b.z))), y3 = bfhi(yy.y) / (1.f + __expf(-(a[3] + b.w)));
                        ss += y0 * y0 + y1 * y1 + y2 * y2 + y3 * y3;
                        uint2 w; w.x = pk2(y0 * g.x, y1 * g.y); w.y = pk2(y2 * g.z, y3 * g.w);
                        *(uint2*)(p.ymix + (size_t)token * D_ + col) = w;
                    }
                ss += __shfl_xor(ss, 16); ss += __shfl_xor(ss, 32);
                if (fq == 0) p.ssq_ssm[token * 16 + pn * 4 + wc] = ss;
            }
    }
};
__device__ __forceinline__ void glu_item(const MKParams& p, unsigned char* smem, int it) {
    const int pn = it & 3, pm = it >> 2;
    const int m0 = pm * 256, n0 = pn * 256;
    ARows al{p.ypre + (size_t)m0 * DS_, DS_};
    BHalves bl{p.w_glu_t + (size_t)n0 * DS_, p.w_glu_t + (size_t)(n0 + 128) * DS_, DS_};
    gemm8_tile<true>(smem, al, bl, DS_ / 64, NoMid8{}, EpiGlu8{p, m0, n0, pn});
}

__device__ __forceinline__ float rstd16(const float* part) {
    const float4 a = ((const float4*)part)[0], b = ((const float4*)part)[1], c = ((const float4*)part)[2], d = ((const float4*)part)[3];
    const float s = ((a.x + a.y) + (a.z + a.w)) + ((b.x + b.y) + (b.z + b.w)) + ((c.x + c.y) + (c.z + c.w)) + ((d.x + d.y) + (d.z + d.w));
    return 1.0f / sqrtf(s * (1.0f / DS_) + 1e-6f);
}
struct MidOut {
    const float* rows;
    __device__ __forceinline__ void operator()(int kt, f32x4 (&acc)[8][4], int wr, int fr, int fq) const {
        if (kt == 16) {
#pragma unroll
            for (int m = 0; m < 8; ++m) {
                const float ratio = rows[wr * 128 + m * 16 + fr];
#pragma unroll
                for (int nn = 0; nn < 4; ++nn) acc[m][nn] *= ratio;
            }
        }
    }
};
struct EpiOut {
    const MKParams& p; const float* rows; int m0, n0, pn;
    __device__ __forceinline__ void operator()(f32x4 (&acc)[8][4], int wr, int wc, int fr, int fq) const {
#pragma unroll
        for (int m = 0; m < 8; ++m) {
            const int token = m0 + wr * 128 + m * 16 + fr;
            const float rn = rows[256 + wr * 128 + m * 16 + fr];
            float ss = 0.f;
#pragma unroll
            for (int nn = 0; nn < 4; ++nn) {
                const int col = n0 + wc * 64 + nn * 16 + fq * 4;
                const float4 xv = *(const float4*)(p.x + (size_t)token * D_ + col);
                const float4 g = *(const float4*)(p.g_ffn + col);
                const f32x4 a = acc[m][nn];
                const float v0 = xv.x + a[0] * rn, v1 = xv.y + a[1] * rn, v2 = xv.z + a[2] * rn, v3 = xv.w + a[3] * rn;
                ss += v0 * v0 + v1 * v1 + v2 * v2 + v3 * v3;
                uint2 w; w.x = pk2(v0 * g.x, v1 * g.y); w.y = pk2(v2 * g.z, v3 * g.w);
                *(uint2*)(p.x1g + (size_t)token * D_ + col) = w;
            }
            ss += __shfl_xor(ss, 16); ss += __shfl_xor(ss, 32);
            if (fq == 0) p.ssq_x1[token * 32 + pn * 4 + wc] = ss;
        }
    }
};
__device__ __forceinline__ void outproj_item(const MKParams& p, unsigned char* smem, int it) {
    const int pn = it & 7, pm = it >> 3;
    const int m0 = pm * 256, n0 = pn * 256;
    float* rows = (float*)(smem + SM_ROWS);
    __syncthreads();
    const int tq = opaque_tid();
    if (tq < 256) {
        const int token = m0 + tq;
        const float rs = rstd16(p.ssq_ssm + token * 16), rn = rstd16(p.ssq_na + token * 16);
        rows[tq] = rs / rn; rows[256 + tq] = rn;
    }
    ARows al{p.ymix + (size_t)m0 * D_, D_};
    BHalves bl{p.w_out_t + (size_t)n0 * D_, p.w_out_t + (size_t)(n0 + 128) * D_, D_};
    gemm8_tile<true>(smem, al, bl, D_ / 64, MidOut8{rows}, EpiOut8{p, rows, m0, n0, pn});
}

#define RT_PART (SM_GEMM)
__device__ __forceinline__ void router_item(const MKParams& p, unsigned char* smem, int item) {
    const int tid = opaque_tid(), lane = tid & 63, wave = tid >> 6, fr = lane & 15, fq = lane >> 4;
    const int tile = item * 2 + (wave >> 2), kq = wave & 3;
    const int token = tile * 16 + fr;
    const bf16_t* xr = p.x1g + (size_t)token * D_ + kq * 512 + fq * 8;
    const bf16_t* wh = p.wrT + (size_t)fr * D_ + kq * 512 + fq * 8;
    const bf16_t* wl = wh + 16 * D_;
    f32x4 ah = (f32x4){0.f, 0.f, 0.f, 0.f}, alo = (f32x4){0.f, 0.f, 0.f, 0.f};
#pragma unroll 8
    for (int k = 0; k < 512; k += 32) {
        const bf16x8 xb = *(const bf16x8*)(xr + k);
        ah = __builtin_amdgcn_mfma_f32_16x16x32_bf16(*(const bf16x8*)(wh + k), xb, ah, 0, 0, 0);
        alo = __builtin_amdgcn_mfma_f32_16x16x32_bf16(*(const bf16x8*)(wl + k), xb, alo, 0, 0, 0);
    }
    f32x4* part = (f32x4*)(smem + RT_PART);
    __syncthreads();
    part[wave * 64 + lane] = ah + alo;
    __syncthreads();
    if (kq == 0) {
        const f32x4 t = part[wave * 64 + lane] + part[(wave + 1) * 64 + lane] + part[(wave + 2) * 64 + lane] + part[(wave + 3) * 64 + lane];
        const float4 s0 = *(const float4*)(p.ssq_x1 + token * 32 + fq * 8), s1 = *(const float4*)(p.ssq_x1 + token * 32 + fq * 8 + 4);
        float ss = ((s0.x + s0.y) + (s0.z + s0.w)) + ((s1.x + s1.y) + (s1.z + s1.w));
        ss += __shfl_xor(ss, 16); ss += __shfl_xor(ss, 32);
        const float rs = 1.0f / sqrtf(ss * (1.0f / D_) + 1e-6f);
        float l[4];
#pragma unroll
        for (int i = 0; i < 4; ++i) l[i] = t[i] * rs;
        float mx = fmaxf(fmaxf(l[0], l[1]), fmaxf(l[2], l[3]));
        mx = fmaxf(mx, __shfl_xor(mx, 16)); mx = fmaxf(mx, __shfl_xor(mx, 32));
        float e[4], sum = 0.f;
#pragma unroll
        for (int i = 0; i < 4; ++i) { e[i] = expf(l[i] - mx); sum += e[i]; }
        sum += __shfl_xor(sum, 16); sum += __shfl_xor(sum, 32);
        const float inv = 1.f / sum;
#pragma unroll
        for (int i = 0; i < 4; ++i) {
            const float a = e[i] * inv;
            p.aff_t[(size_t)(4 * fq + i) * L_ + token] = a;
            atomicAdd(p.ahist + (4 * fq + i) * 4096 + (__float_as_uint(a) >> 19), 1u);
        }
        if (fq == 0) p.rstd_x1[token] = rs;
    }
}

#define TK_MISC (SM_GEMM)
#define TK_SUF  (SM_GEMM + 64)
#define TK_LIST (SM_GEMM + 1024)
__device__ __forceinline__ void topk_item(const MKParams& p, unsigned char* smem, int e) {
    const int tid = opaque_tid(), lane = tid & 63, wave = tid >> 6;
    unsigned* misc = (unsigned*)(smem + TK_MISC);
    unsigned* wsum = (unsigned*)(smem + TK_SUF);
    uint2* list = (uint2*)(smem + TK_LIST);
    const float* a = p.aff_t + (size_t)e * L_;
    unsigned key[16];
#pragma unroll
    for (int i = 0; i < 16; ++i) key[i] = __float_as_uint(a[tid + NT_ * i]);
    const uint4 h0 = *(const uint4*)(p.ahist + e * 4096 + tid * 8), h1 = *(const uint4*)(p.ahist + e * 4096 + tid * 8 + 4);
    const unsigned hb[8] = {h0.x, h0.y, h0.z, h0.w, h1.x, h1.y, h1.z, h1.w};
    unsigned own = 0;
#pragma unroll
    for (int i = 0; i < 8; ++i) own += hb[i];
    unsigned suf = own;
#pragma unroll
    for (int o = 1; o < 64; o <<= 1) { const unsigned t = __shfl_down(suf, o); if (lane + o < 64) suf += t; }
    __syncthreads();
    if (lane == 0) wsum[wave] = suf;
    if (tid == 0) { misc[2] = 0u; misc[3] = 0u; }
    __syncthreads();
    unsigned above = suf - own;
#pragma unroll
    for (int w = 0; w < 8; ++w) if (w > wave) above += wsum[w];
    if (above < (unsigned)CAP_ && (unsigned)CAP_ <= above + own) {
        unsigned cnt = above;
#pragma unroll
        for (int i = 7; i >= 0; --i) {
            if (cnt < (unsigned)CAP_ && (unsigned)CAP_ <= cnt + hb[i]) { misc[0] = (unsigned)(tid * 8 + i); misc[1] = (unsigned)CAP_ - cnt; }
            cnt += hb[i];
        }
    }
    __syncthreads();
    const unsigned T = misc[0], need = misc[1];
#pragma unroll
    for (int i = 0; i < 16; ++i)
        if ((key[i] >> 19) == T) { const unsigned s = atomicAdd(&misc[3], 1u); list[s] = make_uint2(key[i], (unsigned)(tid + NT_ * i)); }
    __syncthreads();
    const unsigned nc = misc[3];
#pragma unroll
    for (int i = 0; i < 16; ++i) {
        const int token = tid + NT_ * i;
        const unsigned bin = key[i] >> 19;
        if (bin != T) {
            int slot = -1;
            if (bin > T) {
                slot = (int)atomicAdd(&misc[2], 1u);
                p.idx[e * CAP_ + slot] = token;
                p.gate[e * CAP_ + slot] = __uint_as_float(key[i]);
            }
            p.slot_of[token * NE_ + e] = slot;
        }
    }
    for (unsigned c0 = tid; c0 < nc; c0 += NT_) {
        const uint2 me = list[c0];
        unsigned rank = 0;
        unsigned j = 0;
        for (; j + 4 <= nc; j += 4) {
            const uint2 a0 = list[j], a1 = list[j + 1], a2 = list[j + 2], a3 = list[j + 3];
            rank += (a0.x > me.x || (a0.x == me.x && a0.y < me.y)) ? 1u : 0u;
            rank += (a1.x > me.x || (a1.x == me.x && a1.y < me.y)) ? 1u : 0u;
            rank += (a2.x > me.x || (a2.x == me.x && a2.y < me.y)) ? 1u : 0u;
            rank += (a3.x > me.x || (a3.x == me.x && a3.y < me.y)) ? 1u : 0u;
        }
        for (; j < nc; ++j) { const uint2 a0 = list[j]; rank += (a0.x > me.x || (a0.x == me.x && a0.y < me.y)) ? 1u : 0u; }
        int slot = -1;
        if (rank < need) {
            slot = (int)atomicAdd(&misc[2], 1u);
            p.idx[e * CAP_ + slot] = (int)me.y;
            p.gate[e * CAP_ + slot] = __uint_as_float(me.x);
        }
        p.slot_of[me.y * NE_ + e] = slot;
    }
    __syncthreads();
}

struct AGather { const bf16_t* base; const int* rows; __device__ __forceinline__ const bf16_t* ubase() const { return base; } __device__ __forceinline__ unsigned row_off(int r) const { return (unsigned)rows[r] * (unsigned)D_; } };
struct BMoe1 {
    const float* wg; long up_minus_gate; int col0;
    __device__ __forceinline__ const float* ubase(int wave) const { return wg + (long)(wave & 1) * up_minus_gate; }
    __device__ __forceinline__ unsigned col_off(int n4) const {
        const int wc = n4 >> 6, nn = (n4 >> 4) & 3, i = n4 & 15;
        return (unsigned)(col0 + wc * 32 + (nn & 1) * 16 + i);
    }
};
struct EpiMoe1 {
    const MKParams& p; int e, mt, nt;
    __device__ __forceinline__ void operator()(f32x4 (&acc)[8][4], int wr, int wc, int fr, int fq) const {
#pragma unroll
        for (int m = 0; m < 8; ++m) {
            const int slot = mt * 256 + wr * 128 + m * 16 + fr;
            const float rs = p.rstd_x1[p.idx[e * CAP_ + slot]];
#pragma unroll
            for (int nn = 0; nn < 2; ++nn) {
                const f32x4 g = acc[m][nn] * rs, u = acc[m][nn + 2] * rs;
                float a[4];
#pragma unroll
                for (int i = 0; i < 4; ++i) a[i] = g[i] / (1.f + __expf(-g[i])) * u[i];
                uint2 w; w.x = pk2(a[0], a[1]); w.y = pk2(a[2], a[3]);
                *(uint2*)(p.act + (size_t)(e * CAP_ + slot) * FF_ + nt * 128 + wc * 32 + nn * 16 + fq * 4) = w;
            }
        }
    }
};
__device__ __forceinline__ void moe1_item(const MKParams& p, unsigned char* smem, int it) {
    const int rnd = it >> 8, b = it & 255, xcd = b & 7, s = b >> 3;
    const int mt = s & 3, wt = rnd * 64 + xcd * 8 + (s >> 2);
    const int e = wt >> 4, nt = wt & 15;
    AGather al{p.x1g, p.idx + e * CAP_ + mt * 256};
    BHalves bl{p.w_gate_t + ((size_t)e * FF_ + nt * 128) * D_, p.w_up_t + ((size_t)e * FF_ + nt * 128) * D_, D_};
    gemm8_tile<true>(smem, al, bl, D_ / 64, NoMid8{}, EpiMoe1_8{p, e, mt, nt});
}

struct EpiMoe2 {
    const MKParams& p; int e, mt, nt;
    __device__ __forceinline__ void operator()(f32x4 (&acc)[8][4], int wr, int wc, int fr, int fq) const {
#pragma unroll
        for (int m = 0; m < 8; ++m) {
            const int slot = mt * 256 + wr * 128 + m * 16 + fr;
            const float gt = p.gate[e * CAP_ + slot];
#pragma unroll
            for (int nn = 0; nn < 4; ++nn) {
                const f32x4 a = acc[m][nn] * gt;
                uint2 w; w.x = pk2(a[0], a[1]); w.y = pk2(a[2], a[3]);
                *(uint2*)(p.ye + (size_t)(e * CAP_ + slot) * D_ + nt * 256 + wc * 64 + nn * 16 + fq * 4) = w;
            }
        }
    }
};
__device__ __forceinline__ void moe2_item(const MKParams& p, unsigned char* smem, int it) {
    const int rnd = it >> 8, b = it & 255, xcd = b & 7, s = b >> 3;
    const int mt = s & 3, wt = rnd * 64 + xcd * 8 + (s >> 2);
    const int e = wt >> 3, nt = wt & 7;
    ARows al{p.act + (size_t)(e * CAP_ + mt * 256) * FF_, FF_};
    BHalves bl{p.w_down_t + ((size_t)e * D_ + nt * 256) * FF_, p.w_down_t + ((size_t)e * D_ + nt * 256 + 128) * FF_, FF_};
    gemm8_tile<true>(smem, al, bl, FF_ / 64, NoMid8{}, EpiMoe2_8{p, e, mt, nt});
}

__device__ __forceinline__ void final_token(const MKParams& p, int token, int lane) {
    float v[4][8];
#pragma unroll
    for (int j = 0; j < 4; ++j) {
        const int n = j * 512 + lane * 8;
        const uint4 w = *(const uint4*)(p.x1g + (size_t)token * D_ + n);
        const float4 g0 = *(const float4*)(p.g_ffn + n), g1 = *(const float4*)(p.g_ffn + n + 4);
        v[j][0] = bflo(w.x) / g0.x; v[j][1] = bfhi(w.x) / g0.y; v[j][2] = bflo(w.y) / g0.z; v[j][3] = bfhi(w.y) / g0.w;
        v[j][4] = bflo(w.z) / g1.x; v[j][5] = bfhi(w.z) / g1.y; v[j][6] = bflo(w.w) / g1.z; v[j][7] = bfhi(w.w) / g1.w;
    }
#pragma unroll 1
    for (int e = 0; e < NE_; ++e) {
        const int slot = p.slot_of[token * NE_ + e];
        if (slot >= 0) {
            const bf16_t* yr = p.ye + (size_t)(e * CAP_ + slot) * D_;
#pragma unroll
            for (int j = 0; j < 4; ++j) {
                const uint4 w = *(const uint4*)(yr + j * 512 + lane * 8);
                v[j][0] += bflo(w.x); v[j][1] += bfhi(w.x); v[j][2] += bflo(w.y); v[j][3] += bfhi(w.y);
                v[j][4] += bflo(w.z); v[j][5] += bfhi(w.z); v[j][6] += bflo(w.w); v[j][7] += bfhi(w.w);
            }
        }
    }
    float ss = 0.f;
#pragma unroll
    for (int j = 0; j < 4; ++j)
#pragma unroll
        for (int i = 0; i < 8; ++i) ss += v[j][i] * v[j][i];
    ss = wave_sum(ss);
    const float rs = 1.0f / sqrtf(ss * (1.0f / D_) + 1e-6f);
#pragma unroll
    for (int j = 0; j < 4; ++j) {
        const int n = j * 512 + lane * 8;
        const float4 g0 = *(const float4*)(p.g_final + n), g1 = *(const float4*)(p.g_final + n + 4);
        float4 o0, o1;
        o0.x = v[j][0] * rs * g0.x; o0.y = v[j][1] * rs * g0.y; o0.z = v[j][2] * rs * g0.z; o0.w = v[j][3] * rs * g0.w;
        o1.x = v[j][4] * rs * g1.x; o1.y = v[j][5] * rs * g1.y; o1.z = v[j][6] * rs * g1.z; o1.w = v[j][7] * rs * g1.w;
        *(float4*)(p.out + (size_t)token * D_ + n) = o0;
        *(float4*)(p.out + (size_t)token * D_ + n + 4) = o1;
    }
}


#ifndef REP0
#define REP0 1
#endif
#ifndef REP1
#define REP1 1
#endif
#ifndef REP2
#define REP2 1
#endif
#ifndef REP3
#define REP3 1
#endif
#ifndef REP4
#define REP4 1
#endif
#ifndef REP5
#define REP5 1
#endif
#ifndef REP6
#define REP6 1
#endif
#ifndef REP7
#define REP7 1
#endif
#ifndef REP8
#define REP8 1
#endif
#ifndef REP9
#define REP9 1
#endif
#ifndef REP10
#define REP10 1
#endif
__global__ __launch_bounds__(NT_, 2) void k_mega(MKParams p) {
    extern __shared__ __attribute__((aligned(16))) unsigned char smem[];
    volatile LAS unsigned* st = (volatile LAS unsigned*)smem;
    if (threadIdx.x < 4) st[threadIdx.x] = 0u;
    __syncthreads();
    xcd_barrier_post(p.bar, st);
    if (p.never) cg::this_grid().sync();
    const int G = gridDim.x, b0 = blockIdx.x;
    {
        const int tq = opaque_tid(), lane = tq & 63, wave = __builtin_amdgcn_readfirstlane(tq >> 6);
        if (wave == 0) {
            for (int rep = 0; rep < p.rep[10]; ++rep)
                for (int it = b0; it < 256; it += G) ssm_tables(p, smem, it >> 2, it & 3, lane);
        } else {
            const int gw = b0 * 7 + (wave - 1), NGW = G * 7;
            for (int rep = 0; rep < p.rep[0]; ++rep) conv_all(p, gw, NGW, lane);
            phase_prep(p, gw, NGW, lane);
            for (int i = gw * 64 + lane; i < NE_ * 4096; i += NGW * 64) p.ahist[i] = 0u;
        }
    }
    xcd_barrier(p.bar, st);
    if (threadIdx.x == 0) {
        bool even = (G % 8) == 0;
        for (int j = 0; j < 8; ++j) even = even && (xb_ld(&p.bar[XB_XCNT(j)]) == (unsigned)(G / 8));
        st[2] = even ? (st[2] + 8u * st[3]) : (unsigned)blockIdx.x;
    }
    __syncthreads();
    const int b = (int)st[2];
    for (int rep = 0; rep < p.rep[1]; ++rep) {
    phase_inproj(p, smem, b);
    xcd_barrier(p.bar, st);
    }
    for (int rep = 0; rep < p.rep[2]; ++rep) {
    phase2(p, smem, b, G, p.bar + 64 + rep);
    xcd_barrier(p.bar, st);
    }
    for (int rep = 0; rep < p.rep[3]; ++rep) {
    for (int it = b; it < 128; it += G) { const int q = it >> 3; ssm_y_item(p, smem, (it & 7) + 8 * (q >> 1), q & 1); }
    xcd_barrier(p.bar, st);
    }
    for (int rep = 0; rep < p.rep[4]; ++rep) {
    for (int it = b; it < 128; it += G) glu_item(p, smem, it);
    xcd_barrier(p.bar, st);
    }
    for (int rep = 0; rep < p.rep[5]; ++rep) {
    for (int it = b; it < 256; it += G) outproj_item(p, smem, it);
    xcd_barrier(p.bar, st);
    }
    for (int rep = 0; rep < p.rep[6]; ++rep) {
    for (int it = b; it < L_ / 32; it += G) router_item(p, smem, it);
    xcd_barrier(p.bar, st);
    }
    for (int rep = 0; rep < p.rep[7]; ++rep) {
    for (int it = b; it < NE_; it += G) topk_item(p, smem, it);
    xcd_barrier(p.bar, st);
    }
    for (int rep = 0; rep < p.rep[8]; ++rep) {
    for (int it = b; it < 1024; it += G) moe1_item(p, smem, it);
    xcd_barrier(p.bar, st);
    }
    for (int rep = 0; rep < p.rep[9]; ++rep) {
    for (int it = b; it < 512; it += G) moe2_item(p, smem, it);
    xcd_barrier(p.bar, st);
    }
    { int tq = threadIdx.x; asm volatile("" : "+v"(tq));
      for (int t = b * 8 + (tq >> 6); t < L_; t += G * 8) final_token(p, t, tq & 63); }
}

extern "C" void kernel_launch(void* const* d_in, const int* in_sizes, int n_in, void* d_out, int out_size, void* d_ws, size_t ws_size,
                              hipStream_t stream) {
    (void)in_sizes; (void)n_in; (void)out_size; (void)ws_size;
    static int grid = 0;
    if (!grid) {
        int dev = 0, cus = 0, per_cu = 0;
        (void)hipGetDevice(&dev);
        (void)hipDeviceGetAttribute(&cus, hipDeviceAttributeMultiprocessorCount, dev);
        (void)hipFuncSetAttribute((const void*)k_mega, hipFuncAttributeMaxDynamicSharedMemorySize, MK_LDS);
        (void)hipOccupancyMaxActiveBlocksPerMultiprocessor(&per_cu, (const void*)k_mega, NT_, MK_LDS);
        if (per_cu < 1) per_cu = 1;
        grid = cus;
    }
    MKParams mp{};
    const float* const* in = (const float* const*)d_in;
    mp.x = in[0]; mp.g_mix = in[1]; mp.w_in = in[2];
    mp.a_re_f = in[3]; mp.a_im_f = in[4]; mp.ldt_f = in[5]; mp.b_re_f = in[6]; mp.b_im_f = in[7]; mp.c_re_f = in[8]; mp.c_im_f = in[9];
    mp.a_re_b = in[10]; mp.a_im_b = in[11]; mp.ldt_b = in[12]; mp.b_re_b = in[13]; mp.b_im_b = in[14]; mp.c_re_b = in[15]; mp.c_im_b = in[16];
    mp.ssm_d = in[17]; mp.w_glu = in[18]; mp.b_glu = in[19]; mp.rpb = in[20]; mp.g_ssm = in[21]; mp.g_na = in[22]; mp.w_out = in[23];
    mp.g_ffn = in[24]; mp.w_router = in[25]; mp.w_gate = in[26]; mp.w_up = in[27]; mp.w_down = in[28]; mp.g_final = in[29];
    mp.out = (float*)d_out;
    unsigned char* ws = (unsigned char*)d_ws;
    size_t off = 0;
    auto take = [&](size_t bytes) { unsigned char* q = ws + off; off += (bytes + 255) & ~(size_t)255; return q; };
    mp.bar = (unsigned*)take(XCD_BAR_WORDS * 4);
    mp.xn = (bf16_t*)take((size_t)L_ * XN_LD * 2);
    mp.rstd_x = (float*)take(L_ * 4);
    mp.ua = (bf16_t*)take((size_t)64 * 256 * 768 * 2);
    mp.qb = (bf16_t*)take((size_t)L_ * DS_ * 2);
    mp.kb = (bf16_t*)take((size_t)L_ * DS_ * 2);
    mp.vT = (bf16_t*)take((size_t)L_ * DS_ * 2);
    mp.PBt = (bf16_t*)take((size_t)64 * 256 * 512 * 2);
    mp.WyT = (bf16_t*)take((size_t)64 * 512 * 768 * 2);
    mp.A32 = (float*)take(64 * 2 * 64 * 2 * 4);
    mp.ypre = (bf16_t*)take((size_t)L_ * DS_ * 2);
    mp.ymix = (bf16_t*)take((size_t)L_ * D_ * 2);
    mp.ssq_na = (float*)take((size_t)L_ * 16 * 4);
    mp.ssq_ssm = (float*)take((size_t)L_ * 16 * 4);
    mp.x1g = (bf16_t*)take((size_t)L_ * D_ * 2);
    mp.ssq_x1 = (float*)take((size_t)L_ * 32 * 4);
    mp.wrT = (bf16_t*)take((size_t)2 * NE_ * D_ * 2);
    mp.aff_t = (float*)take((size_t)NE_ * L_ * 4);
    mp.rstd_x1 = (float*)take(L_ * 4);
    mp.idx = (int*)take(NE_ * CAP_ * 4);
    mp.gate = (float*)take(NE_ * CAP_ * 4);
    mp.slot_of = (int*)take((size_t)L_ * NE_ * 4);
    mp.ahist = (unsigned*)take((size_t)NE_ * 4096 * 4);
    mp.act = (bf16_t*)take((size_t)NE_ * CAP_ * FF_ * 2);
    mp.ye = (bf16_t*)take((size_t)NE_ * CAP_ * D_ * 2);
    mp.w_in_t = (bf16_t*)take((size_t)DIN_ * XN_LD * 2);
    mp.w_out_t = (bf16_t*)take((size_t)D_ * D_ * 2);
    mp.w_glu_t = (bf16_t*)take((size_t)DS_ * DS_ * 2);
    mp.w_gate_t = (bf16_t*)take((size_t)NE_ * D_ * FF_ * 2);
    mp.w_up_t = (bf16_t*)take((size_t)NE_ * D_ * FF_ * 2);
    mp.w_down_t = (bf16_t*)take((size_t)NE_ * D_ * FF_ * 2);
    { const int reps[12] = {REP0, REP1, REP2, REP3, REP4, REP5, REP6, REP7, REP8, REP9, REP10, 1}; for (int i = 0; i < 12; ++i) mp.rep[i] = reps[i]; }
    mp.never = 0; mp.pad = 0;
    (void)hipMemsetAsync(mp.bar, 0, XCD_BAR_WORDS * sizeof(unsigned), stream);
    void* args[] = {&mp};
    (void)hipLaunchCooperativeKernel((const void*)k_mega, dim3(grid), dim3(NT_), args, MK_LDS, stream);
}
```

```cpp
#include <hip/hip_runtime.h>
#include <math.h>
#include <stdint.h>

#define L_   8192
#define D_   2048
#define DIN_ 4096
#define DS_  1024
#define NG_  64
#define NP_  64
#define NE_  16
#define CAP_ 1024
#define FF_  2048

__device__ __forceinline__ float wave_sum(float v) {
#pragma unroll
    for (int o = 32; o >= 1; o >>= 1) v += __shfl_xor(v, o);
    return v;
}

#include <hip/hip_cooperative_groups.h>
namespace cg = cooperative_groups;
#define XB_TMO      128
#define XB_XCNT(j)  (256  + 64 * (j))
#define XB_XSUB(j)  (1280 + 64 * (j))
#define XB_XGEN(j)  (2304 + 64 * (j))
#define XB_TOP      3328
#define XB_TOPGEN   3392
#define XCD_BAR_WORDS 3456
#define XB_SPIN_CAP (1u << 18)
#define LAS __attribute__((address_space(3)))
__device__ __forceinline__ unsigned xb_ld(unsigned* p)              { return __hip_atomic_load(p, __ATOMIC_RELAXED, __HIP_MEMORY_SCOPE_AGENT); }
__device__ __forceinline__ unsigned xb_add(unsigned* p, unsigned v) { return __hip_atomic_fetch_add(p, v, __ATOMIC_RELAXED, __HIP_MEMORY_SCOPE_AGENT); }
__device__ __forceinline__ unsigned xb_xcc_id() { return (unsigned)__builtin_amdgcn_s_getreg((3 << 11) | 20) & 0xFu; }
#define XB_SPIN(cond, bar) do { unsigned _sp = 0; while (cond) { __builtin_amdgcn_s_sleep(1); \
    if ((++_sp & 255u) == 0u) { if (xb_ld(&(bar)[XB_TMO])) break; if (_sp > XB_SPIN_CAP) { atomicAdd(&(bar)[XB_TMO], 1u); break; } } } } while (0)
__device__ __forceinline__ void xcd_barrier_post(unsigned* bar, volatile LAS unsigned* st) {
    if (threadIdx.x == 0) { const unsigned x = xb_xcc_id(); const unsigned r = xb_add(&bar[XB_XCNT(x)], 1u); st[2] = x; st[3] = r; }
}
__device__ __forceinline__ void xcd_barrier_complete(unsigned* bar, unsigned x, unsigned& nloc, unsigned& nx) {
    const unsigned G = gridDim.x * gridDim.y * gridDim.z;
    unsigned sum, cnt, mine, sp = 0u;
    for (;;) {
        sum = 0u; cnt = 0u; mine = 0u;
#pragma unroll
        for (unsigned j = 0; j < 16; ++j) { const unsigned c = xb_ld(&bar[XB_XCNT(j)]); sum += c; cnt += (c > 0u) ? 1u : 0u; mine = (j == x) ? c : mine; }
        if (sum == G) break;
        __builtin_amdgcn_s_sleep(1);
        if ((++sp & 255u) == 0u) { if (xb_ld(&bar[XB_TMO])) break; if (sp > XB_SPIN_CAP) { atomicAdd(&bar[XB_TMO], 1u); break; } }
    }
    nloc = mine > 0u ? mine : 1u; nx = cnt > 0u ? cnt : 1u;
}
__device__ __forceinline__ void xcd_barrier(unsigned* bar, volatile LAS unsigned* st) {
    asm volatile("s_waitcnt vmcnt(0)" ::: "memory");
    __syncthreads();
    if (threadIdx.x == 0) {
        __builtin_amdgcn_s_waitcnt(0);
        const unsigned x = xb_xcc_id();
        unsigned nloc = st[0], nx = st[1];
        if (nloc == 0u) { xcd_barrier_complete(bar, x, nloc, nx); st[0] = nloc; st[1] = nx; }
        const unsigned old = xb_add(&bar[XB_XSUB(x)], 1u);
        const unsigned gen = old / nloc;
        if (old + 1u == (gen + 1u) * nloc) {
            __builtin_amdgcn_fence(__ATOMIC_RELEASE, "agent");
            asm volatile("s_waitcnt vmcnt(0)" ::: "memory");
            const unsigned og = xb_add(&bar[XB_TOP], 1u);
            const unsigned tg = og / nx;
            if (og + 1u == (tg + 1u) * nx) xb_add(&bar[XB_TOPGEN], 1u);
            else XB_SPIN(xb_ld(&bar[XB_TOPGEN]) == tg, bar);
            __builtin_amdgcn_fence(__ATOMIC_ACQUIRE, "agent");
            xb_add(&bar[XB_XGEN(x)], 1u);
            asm volatile("s_waitcnt vmcnt(0)" ::: "memory");
        } else {
            XB_SPIN(xb_ld(&bar[XB_XGEN(x)]) == gen, bar);
            __builtin_amdgcn_fence(__ATOMIC_ACQUIRE, "agent");
            asm volatile("s_waitcnt vmcnt(0)" ::: "memory");
        }
    }
    __syncthreads();
}

typedef short bf16x8 __attribute__((ext_vector_type(8)));
typedef float f32x4 __attribute__((ext_vector_type(4)));
typedef float f32x2 __attribute__((ext_vector_type(2)));
typedef __bf16 bf16x2v __attribute__((ext_vector_type(2)));
typedef unsigned short bf16_t;
typedef unsigned u32x4 __attribute__((ext_vector_type(4)));
#define NT_ 512
#define XN_LD (D_ + 64)
#define SM_MISC 0
#define SM_ROWS 1024
#define SM_GEMM 4096
#define SM_CV (SM_GEMM + 131072)
#define MK_LDS (152 * 1024)

__device__ __forceinline__ unsigned pk2(float lo, float hi) {
    f32x2 v = {lo, hi};
    return __builtin_bit_cast(unsigned, __builtin_convertvector(v, bf16x2v));
}
__device__ __forceinline__ float bf2f(bf16_t h) { return __uint_as_float(((unsigned)h) << 16); }
__device__ __forceinline__ float bflo(unsigned w) { return __uint_as_float(w << 16); }
__device__ __forceinline__ float bfhi(unsigned w) { return __uint_as_float(w & 0xffff0000u); }

struct MKParams {
    const float *x, *g_mix, *w_in;
    const float *a_re_f, *a_im_f, *ldt_f, *b_re_f, *b_im_f, *c_re_f, *c_im_f;
    const float *a_re_b, *a_im_b, *ldt_b, *b_re_b, *b_im_b, *c_re_b, *c_im_b;
    const float *ssm_d, *w_glu, *b_glu, *rpb, *g_ssm, *g_na, *w_out, *g_ffn, *w_router, *w_gate, *w_up, *w_down, *g_final;
    float* out;
    bf16_t* xn;
    float* rstd_x;
    bf16_t* ua;
    bf16_t* qb;
    bf16_t* kb;
    bf16_t* vT;
    bf16_t* PBt;
    bf16_t* WyT;
    float* A32;
    bf16_t* ypre;
    bf16_t* ymix;
    float* ssq_na;
    float* ssq_ssm;
    bf16_t* x1g;
    float* ssq_x1;
    bf16_t* wrT;
    float* aff_t;
    float* rstd_x1;
    int* idx;
    float* gate;
    int* slot_of;
    unsigned* ahist;
    bf16_t* act;
    bf16_t* ye;
    bf16_t* w_in_t;
    bf16_t* w_out_t;
    bf16_t* w_glu_t;
    bf16_t *w_gate_t, *w_up_t, *w_down_t;
    unsigned* bar;
    int bg;
    int rep[14];
    int never; int pad;
};

#define GAS __attribute__((address_space(1)))
__device__ __forceinline__ int opaque_tid() { int t = threadIdx.x; asm volatile("" : "+v"(t)); return t; }
template <class T> __device__ __forceinline__ const GAS T* uniform_ptr(const T* p) {
    const unsigned long long v = (unsigned long long)p;
    const unsigned lo = __builtin_amdgcn_readfirstlane((unsigned)v), hi = __builtin_amdgcn_readfirstlane((unsigned)(v >> 32));
    return (const GAS T*)(((unsigned long long)hi << 32) | lo);
}
__device__ __forceinline__ int tile_off(int row, int chunk) { return row * 128 + (((chunk ^ (row >> 1)) & 7) << 4); }

template <int MT, bool TR, int BMODE, class ALoad, class BLoad, class Mid, class Epi>
__device__ __forceinline__ void gemm_tile(unsigned char* smem, const ALoad& al, const BLoad& bl, int ldb, int nkt, const Mid& mid, const Epi& epi) {
    int tid_ = threadIdx.x; asm volatile("" : "+v"(tid_));
    const int tid = tid_, lane = tid & 63, wave = tid >> 6;
    const int wr = wave >> 2, wc = wave & 3, fr = lane & 15, fq = lane >> 4;
    constexpr int AR = MT / 2;
    const GAS bf16_t* const abase = uniform_ptr(al.ubase());
    unsigned aoff[AR];
#pragma unroll
    for (int i = 0; i < AR; ++i) {
        const int row = i * 64 + (tid >> 3);
        aoff[i] = al.row_off(row) + (unsigned)((((lane & 7) ^ (row >> 1)) & 7) << 3);
    }
    const int a_lds = __builtin_amdgcn_readfirstlane(wave * 1024);
    const int b_kg = lane & 7, b_n4 = ((wave << 3) | (lane >> 3)) << 2;
    const auto* const bbase = uniform_ptr(bl.ubase(__builtin_amdgcn_readfirstlane(wave)));
    unsigned boff = 0, boff16[4];
    if constexpr (BMODE == 0) { boff = bl.col_off(b_n4) + (unsigned)(b_kg * 8) * (unsigned)ldb; }
    else {
#pragma unroll
        for (int i = 0; i < 4; ++i) { const int row = i * 64 + (tid >> 3); boff16[i] = bl.row_off(row) + (unsigned)((((lane & 7) ^ (row >> 1)) & 7) << 3); }
    }
    unsigned char* const sA = smem + SM_GEMM;
    unsigned char* const sB = smem + SM_GEMM + 32768;
    const int key = (fr >> 1) & 7;
    const int c0 = ((fq ^ key) & 7) << 4, c1 = (((fq | 4) ^ key) & 7) << 4;
    const int a_frag = (wr * (MT * 16) + fr) * 128;
    const int b_frag = (wc * 64 + fr) * 128;

    f32x4 acc[MT][4];
#pragma unroll
    for (int m = 0; m < MT; ++m)
#pragma unroll
        for (int n = 0; n < 4; ++n) acc[m][n] = (f32x4){0.f, 0.f, 0.f, 0.f};

    f32x4 rb[8];
    __syncthreads();
#pragma unroll
    for (int i = 0; i < AR; ++i)
        __builtin_amdgcn_global_load_lds((const GAS unsigned*)(abase + aoff[i]), (__attribute__((address_space(3))) unsigned*)(sA + a_lds + i * 8192), 16, 0, 0);
    if constexpr (BMODE == 0) {
#pragma unroll
        for (int j = 0; j < 8; ++j) rb[j] = *(const GAS f32x4*)((const GAS float*)bbase + (size_t)j * ldb + boff);
        const float* f = (const float*)rb;
#pragma unroll
        for (int i = 0; i < 4; ++i) {
            uint4 w; w.x = pk2(f[0 * 4 + i], f[1 * 4 + i]); w.y = pk2(f[2 * 4 + i], f[3 * 4 + i]); w.z = pk2(f[4 * 4 + i], f[5 * 4 + i]); w.w = pk2(f[6 * 4 + i], f[7 * 4 + i]);
            *(uint4*)(sB + tile_off(b_n4 + i, b_kg)) = w;
        }
    } else {
#pragma unroll
        for (int i = 0; i < 4; ++i)
            __builtin_amdgcn_global_load_lds((const GAS unsigned*)((const GAS bf16_t*)bbase + boff16[i]), (__attribute__((address_space(3))) unsigned*)(sB + a_lds + i * 8192), 16, 0, 0);
    }
    __syncthreads();
    for (int kt = 0; kt < nkt; ++kt) {
        const int cur = (kt & 1) * 65536;
        const int nxt = cur ^ 65536;
        const bool more = (kt + 1 < nkt);
        if (more) {
#pragma unroll
            for (int i = 0; i < AR; ++i)
                __builtin_amdgcn_global_load_lds((const GAS unsigned*)(abase + (kt + 1) * 64 + aoff[i]), (__attribute__((address_space(3))) unsigned*)(sA + nxt + a_lds + i * 8192), 16, 0, 0);
            if constexpr (BMODE == 0) {
#pragma unroll
                for (int j = 0; j < 8; ++j) rb[j] = *(const GAS f32x4*)((const GAS float*)bbase + (size_t)((kt + 1) * 64 + j) * ldb + boff);
            } else {
#pragma unroll
                for (int i = 0; i < 4; ++i)
                    __builtin_amdgcn_global_load_lds((const GAS unsigned*)((const GAS bf16_t*)bbase + (kt + 1) * 64 + boff16[i]), (__attribute__((address_space(3))) unsigned*)(sB + nxt + a_lds + i * 8192), 16, 0, 0);
            }
        }
        mid(kt, acc, wr, fr, fq);
        constexpr int GQ = MT / 2, NG = 2 * GQ;
        bf16x8 bfr[4], af[2][2];
#pragma unroll
        for (int n = 0; n < 4; ++n) bfr[n] = *(const bf16x8*)(sB + cur + b_frag + n * 2048 + c0);
#pragma unroll
        for (int m = 0; m < 2; ++m) af[0][m] = *(const bf16x8*)(sA + cur + a_frag + m * 2048 + c0);
#pragma unroll
        for (int g = 0; g < NG; ++g) {
            const int ks = g / GQ, mq = g % GQ;
            if (g + 1 < NG) {
                const int ks1 = (g + 1) / GQ, mq1 = (g + 1) % GQ;
#pragma unroll
                for (int m = 0; m < 2; ++m) af[(g + 1) & 1][m] = *(const bf16x8*)(sA + cur + a_frag + (mq1 * 2 + m) * 2048 + (ks1 ? c1 : c0));
            }
#pragma unroll
            for (int m = 0; m < 2; ++m)
#pragma unroll
                for (int n = 0; n < 4; ++n)
                    acc[mq * 2 + m][n] = TR ? __builtin_amdgcn_mfma_f32_16x16x32_bf16(bfr[n], af[g & 1][m], acc[mq * 2 + m][n], 0, 0, 0)
                                            : __builtin_amdgcn_mfma_f32_16x16x32_bf16(af[g & 1][m], bfr[n], acc[mq * 2 + m][n], 0, 0, 0);
            if (g == GQ - 1) {
#pragma unroll
                for (int n = 0; n < 4; ++n) bfr[n] = *(const bf16x8*)(sB + cur + b_frag + n * 2048 + c1);
            }
            if (BMODE == 0 && g == NG - 2) {
                if (more) {
                    const float* f = (const float*)rb;
#pragma unroll
                    for (int i = 0; i < 4; ++i) {
                        uint4 w; w.x = pk2(f[0 * 4 + i], f[1 * 4 + i]); w.y = pk2(f[2 * 4 + i], f[3 * 4 + i]); w.z = pk2(f[4 * 4 + i], f[5 * 4 + i]); w.w = pk2(f[6 * 4 + i], f[7 * 4 + i]);
                        *(uint4*)(sB + nxt + tile_off(b_n4 + i, b_kg)) = w;
                    }
                }
            }
            __builtin_amdgcn_sched_barrier(0);
        }
        __syncthreads();
    }
    epi(acc, wr, wc, fr, fq);
}

struct NoMid { template <class ACC> __device__ __forceinline__ void operator()(int, ACC&, int, int, int) const {} };
struct ARows { const bf16_t* base; int lda; __device__ __forceinline__ const bf16_t* ubase() const { return base; } __device__ __forceinline__ unsigned row_off(int r) const { return (unsigned)r * (unsigned)lda; } };
struct BRows16 { const bf16_t* base; int ld; __device__ __forceinline__ const bf16_t* ubase(int) const { return base; } __device__ __forceinline__ unsigned row_off(int r) const { return (unsigned)r * (unsigned)ld; } };
struct BCols { const float* base; __device__ __forceinline__ const float* ubase(int) const { return base; } __device__ __forceinline__ unsigned col_off(int n4) const { return (unsigned)n4; } };

#define G8_HT 16384
__device__ __forceinline__ void g8_stage_rc(int b, int& R, int& C) { const int st = b / 1024, sb = b % 1024, swz = sb ^ (((sb >> 9) & 1) << 5); R = (st >> 1) * 16 + swz / 64; C = (st & 1) * 32 + (swz % 64) / 2; }
#define G8_WAIT_V(n) asm volatile("s_waitcnt vmcnt(" #n ")" ::: "memory")
#define G8_WAIT_L(n) asm volatile("s_waitcnt lgkmcnt(" #n ")" ::: "memory")
#define G8_BAR __builtin_amdgcn_s_barrier()
#define G8_SCHED __builtin_amdgcn_sched_barrier(0)

template <bool TR, class ALoad, class BLoad, class Mid, class Epi, class BG>
__device__ __forceinline__ void gemm8_tile(unsigned char* smem, const ALoad& al, const BLoad& bl, int nt, const Mid& mid, const Epi& epi, const BG& bg) {
    int tid_ = threadIdx.x; asm volatile("" : "+v"(tid_));
    const int tid = tid_, lane = tid & 63, wid = tid >> 6, wr = wid >> 2, wc = wid & 3, fr = lane & 15, fq = lane >> 4;
    unsigned char* const shm = smem + SM_GEMM;
    const GAS bf16_t* const abase = uniform_ptr(al.ubase());
    const GAS bf16_t* const bbase0 = uniform_ptr(bl.half_base(0));
    const GAS bf16_t* const bbase1 = uniform_ptr(bl.half_base(1));
    unsigned aoff[2][2], boff[2];
#pragma unroll
    for (int i = 0; i < 2; ++i) {
        int R, C; g8_stage_rc(tid * 16 + i * 8192, R, C);
        aoff[0][i] = al.row_off(R) + (unsigned)C; aoff[1][i] = al.row_off(128 + R) + (unsigned)C; boff[i] = bl.row_off(R) + (unsigned)C;
    }
    const int wlds = __builtin_amdgcn_readfirstlane(wid * 1024);
    const int lane_off = fr * 64 + ((fq * 16) ^ ((fr >> 3) << 5));
#define G8_SA(b, h) (shm + ((b) * 2 + (h)) * G8_HT)
#define G8_SB(b, h) (shm + (4 + (b) * 2 + (h)) * G8_HT)
#define G8_STAGE_A(b, h, kt) do { _Pragma("unroll") for (int _i = 0; _i < 2; ++_i) \
        __builtin_amdgcn_global_load_lds((const GAS unsigned*)(abase + (size_t)(kt) * 64 + aoff[h][_i]), (LAS unsigned*)(G8_SA(b, h) + wlds + _i * 8192), 16, 0, 0); } while (0)
#define G8_STAGE_B(b, h, kt) do { _Pragma("unroll") for (int _i = 0; _i < 2; ++_i) \
        __builtin_amdgcn_global_load_lds((const GAS unsigned*)(((h) ? bbase1 : bbase0) + (size_t)(kt) * 64 + boff[_i]), (LAS unsigned*)(G8_SB(b, h) + wlds + _i * 8192), 16, 0, 0); } while (0)
#define G8_LDA(dst, b, h) do { _Pragma("unroll") for (int _m = 0; _m < 4; ++_m) _Pragma("unroll") for (int _k = 0; _k < 2; ++_k) \
        dst[_m][_k] = *(const bf16x8*)(G8_SA(b, h) + ((wr * 4 + _m) * 2 + _k) * 1024 + lane_off); } while (0)
#define G8_LDB(dst, b, h) do { _Pragma("unroll") for (int _n = 0; _n < 2; ++_n) _Pragma("unroll") for (int _k = 0; _k < 2; ++_k) \
        dst[_n][_k] = *(const bf16x8*)(G8_SB(b, h) + ((wc * 2 + _n) * 2 + _k) * 1024 + lane_off); } while (0)
#define G8_MMA(ai, bj, AT, BT) do { __builtin_amdgcn_s_setprio(1); \
        _Pragma("unroll") for (int _m = 0; _m < 4; ++_m) _Pragma("unroll") for (int _n = 0; _n < 2; ++_n) _Pragma("unroll") for (int _k = 0; _k < 2; ++_k) \
            acc[ai][bj][_m][_n] = TR ? __builtin_amdgcn_mfma_f32_16x16x32_bf16(BT[_n][_k], AT[_m][_k], acc[ai][bj][_m][_n], 0, 0, 0) \
                                     : __builtin_amdgcn_mfma_f32_16x16x32_bf16(AT[_m][_k], BT[_n][_k], acc[ai][bj][_m][_n], 0, 0, 0); \
        __builtin_amdgcn_s_setprio(0); } while (0)

    f32x4 acc[2][2][4][2];
#pragma unroll
    for (int a = 0; a < 2; ++a)
#pragma unroll
        for (int b = 0; b < 2; ++b)
#pragma unroll
            for (int m = 0; m < 4; ++m)
#pragma unroll
                for (int n = 0; n < 2; ++n) acc[a][b][m][n] = (f32x4){0.f, 0.f, 0.f, 0.f};
    bf16x8 At[4][2], B0[2][2], B1[2][2];
    __syncthreads();
    if constexpr (BG::ON) bg.issue(0, smem, wid, lane);
    G8_STAGE_B(0, 0, 0); G8_STAGE_A(0, 0, 0); G8_STAGE_B(0, 1, 0); G8_STAGE_A(0, 1, 0);
    if (wr == 1) G8_BAR;
    G8_WAIT_V(4); G8_BAR;
    G8_STAGE_B(1, 0, 1); G8_STAGE_A(1, 0, 1); G8_STAGE_B(1, 1, 1);
    G8_WAIT_V(6); G8_BAR;
    for (int t = 0; t < nt - 2; t += 2) {
        mid(t, acc, wr, fr, fq);
        G8_LDB(B0, 0, 0); G8_SCHED; G8_LDA(At, 0, 0); G8_STAGE_A(1, 1, t + 1);
        G8_WAIT_L(8); G8_BAR; G8_WAIT_L(0); G8_MMA(0, 0, At, B0); G8_BAR; G8_SCHED;
        G8_LDB(B1, 0, 1); G8_STAGE_B(0, 0, t + 2);
        G8_BAR; G8_WAIT_L(0); G8_MMA(0, 1, At, B1); G8_BAR;
        G8_LDA(At, 0, 1); G8_STAGE_A(0, 0, t + 2);
        G8_BAR; G8_WAIT_L(0); G8_MMA(1, 0, At, B0); G8_BAR; G8_SCHED;
        G8_STAGE_B(0, 1, t + 2);
        G8_WAIT_V(6); G8_BAR;
        float bgv[8];
        if constexpr (BG::ON) bg.read(smem, wid, lane, bgv);
        G8_MMA(1, 1, At, B1);
        if constexpr (BG::ON) bg.store(t >> 1, wid, lane, bgv);
        G8_BAR;
        G8_LDB(B0, 1, 0); G8_SCHED; G8_LDA(At, 1, 0); G8_STAGE_A(0, 1, t + 2);
        G8_WAIT_L(8); G8_BAR; G8_WAIT_L(0); G8_MMA(0, 0, At, B0); G8_BAR; G8_SCHED;
        G8_LDB(B1, 1, 1); G8_STAGE_B(1, 0, t + 3);
        if constexpr (BG::ON) { const int nx = (t >> 1) + 1; bg.issue(nx < ((nt - 2) >> 1) ? nx : ((nt - 2) >> 1) - 1, smem, wid, lane); }
        G8_BAR; G8_WAIT_L(0); G8_MMA(0, 1, At, B1); G8_BAR;
        G8_LDA(At, 1, 1); G8_STAGE_A(1, 0, t + 3);
        G8_BAR; G8_WAIT_L(0); G8_MMA(1, 0, At, B0); G8_BAR; G8_SCHED;
        G8_STAGE_B(1, 1, t + 3);
        if constexpr (BG::ON) { G8_WAIT_V(8); } else { G8_WAIT_V(6); }
        G8_BAR; G8_MMA(1, 1, At, B1); G8_BAR;
    }
    { G8_LDB(B0, 0, 0); G8_LDA(At, 0, 0); G8_STAGE_A(1, 1, nt - 1);
      G8_BAR; G8_WAIT_L(0); G8_MMA(0, 0, At, B0); G8_BAR;
      G8_LDB(B1, 0, 1); G8_BAR; G8_WAIT_L(0); G8_MMA(0, 1, At, B1); G8_BAR;
      G8_LDA(At, 0, 1); G8_WAIT_V(4); G8_BAR; G8_WAIT_L(0);
      G8_MMA(1, 0, At, B0); G8_MMA(1, 1, At, B1); G8_BAR; }
    { G8_LDB(B0, 1, 0); G8_LDA(At, 1, 0); G8_WAIT_V(2); G8_BAR; G8_WAIT_L(0); G8_MMA(0, 0, At, B0); G8_BAR;
      G8_LDB(B1, 1, 1); G8_WAIT_V(0); G8_BAR; G8_WAIT_L(0); G8_MMA(0, 1, At, B1); G8_BAR;
      G8_LDA(At, 1, 1); G8_BAR; G8_WAIT_L(0); G8_MMA(1, 0, At, B0); G8_MMA(1, 1, At, B1); G8_BAR; }
    if (wr == 0) G8_BAR;
    epi(acc, wr, wc, fr, fq);
}
struct NoMid8 { template <class ACC> __device__ __forceinline__ void operator()(int, ACC&, int, int, int) const {} };
struct NoBg { static constexpr bool ON = false; };
struct BgConv {
    static constexpr bool ON = true;
    const float* src0; long src_step;
    bf16_t* dst0; long dst_step;
    int chunk0;
    __device__ __forceinline__ void issue(int i, unsigned char* smem, int wave, int lane) const {
        const int c = __builtin_amdgcn_readfirstlane(chunk0 + 256 * i), m = c >> 10, kt = (c >> 5) & 31, n64 = c & 31;
        const GAS float* s = uniform_ptr(src0 + (long)(m >> 4) * src_step + (size_t)(m & 15) * 2048 * 2048 + (size_t)(kt * 64) * 2048 + n64 * 64);
        const int wv = __builtin_amdgcn_readfirstlane(wave);
        const unsigned voff = (unsigned)((lane >> 4) * 2048 + (((lane & 15) ^ wv) & 15) * 4);
        const GAS float* s0 = s + (size_t)(wv * 8) * 2048;
        const GAS float* s1 = s + (size_t)(wv * 8 + 4) * 2048;
        __builtin_amdgcn_global_load_lds((const GAS unsigned*)(s0 + voff), (LAS unsigned*)(smem + SM_CV + wv * 2048), 16, 0, 0);
        __builtin_amdgcn_global_load_lds((const GAS unsigned*)(s1 + voff), (LAS unsigned*)(smem + SM_CV + wv * 2048 + 1024), 16, 0, 0);
    }
    __device__ __forceinline__ void read(unsigned char* smem, int wave, int lane, float (&v)[8]) const {
        asm volatile("" ::: "memory");
        const int kg = lane & 7, n = wave * 8 + (lane >> 3);
        const float* cv = (const float*)(smem + SM_CV + kg * 2048 + ((((n >> 2) ^ kg) & 15) * 4 + (n & 3)) * 4);
#pragma unroll
        for (int j = 0; j < 8; ++j) v[j] = cv[j * 64];
    }
    __device__ __forceinline__ void store(int i, int wave, int lane, const float (&v)[8]) const {
        const int c = __builtin_amdgcn_readfirstlane(chunk0 + 256 * i), m = c >> 10, kt = (c >> 5) & 31, n64 = c & 31;
        const int wv = __builtin_amdgcn_readfirstlane(wave);
        GAS bf16_t* d = (GAS bf16_t*)uniform_ptr(dst0 + (long)(m >> 4) * dst_step + (size_t)(m & 15) * 2048 * 2048 + (size_t)(n64 * 64 + wv * 8) * 2048 + kt * 64);
        u32x4 w; w[0] = pk2(v[0], v[1]); w[1] = pk2(v[2], v[3]); w[2] = pk2(v[4], v[5]); w[3] = pk2(v[6], v[7]);
        *(GAS u32x4*)(d + (unsigned)((lane >> 3) * 2048 + (lane & 7) * 8)) = w;
    }
};
struct BHalves { const bf16_t* h0; const bf16_t* h1; int ld;
    __device__ __forceinline__ const bf16_t* half_base(int h) const { return h ? h1 : h0; }
    __device__ __forceinline__ unsigned row_off(int r) const { return (unsigned)r * (unsigned)ld; } };

#define BG_GU0 (32768 - 45 * 256)
#define BG_DN1 (60 * 256)
#define CONV_ITEMS_FULL (4096 + 2048 + 512 + 48 * 2048)
#define CONV_ITEMS_BG (4096 + 2048 + 512 + 2 * (BG_GU0 + (16384 - BG_DN1)))
struct ConvItem { const float* s; bf16_t* d; int N, ldd; };
__device__ __forceinline__ ConvItem conv_decode(const MKParams& p, int it, int lane) {
    const int kg = lane & 7, n4 = (lane >> 3) << 2;
    const float* src; bf16_t* dst; int N, ldd, r;
    if (it < 4096) { src = p.w_in; dst = p.w_in_t; N = DIN_; ldd = XN_LD; r = it; }
    else if (it < 6144) { src = p.w_out; dst = p.w_out_t; N = D_; ldd = D_; r = it - 4096; }
    else if (it < 6656) { src = p.w_glu; dst = p.w_glu_t; N = DS_; ldd = DS_; r = it - 6144; }
    else {
        const int j = it - 6656, ch = j >> 1, sub = j & 1;
        const int ngu = p.bg ? BG_GU0 : 32768;
        int which, e, rc;
        if (ch < ngu) { which = ch >> 14; e = (ch >> 10) & 15; rc = ch & 1023; }
        else { const int d = (p.bg ? BG_DN1 : 0) + (ch - ngu); which = 2; e = d >> 10; rc = d & 1023; }
        r = (rc >> 5) * 64 + (rc & 31) * 2 + sub; N = 2048; ldd = 2048;
        const size_t eo = (size_t)e * D_ * FF_;
        src = (which == 0 ? p.w_gate : (which == 1 ? p.w_up : p.w_down)) + eo;
        dst = (which == 0 ? p.w_gate_t : (which == 1 ? p.w_up_t : p.w_down_t)) + eo;
    }
    const int nn32 = N >> 5, kt = r / nn32, nt = r % nn32;
    ConvItem c;
    c.s = src + (size_t)(kt * 64 + kg * 8) * N + nt * 32 + n4;
    c.d = dst + (size_t)(nt * 32 + n4) * ldd + kt * 64 + kg * 8;
    c.N = N; c.ldd = ldd;
    return c;
}
__device__ __forceinline__ void conv_load(const ConvItem& c, f32x4 (&r)[8]) {
#pragma unroll
    for (int j = 0; j < 8; ++j) r[j] = *(const f32x4*)(c.s + (size_t)j * c.N);
}
__device__ __forceinline__ void conv_store(const ConvItem& c, const f32x4 (&r)[8]) {
#pragma unroll
    for (int i = 0; i < 4; ++i) {
        uint4 w; w.x = pk2(r[0][i], r[1][i]); w.y = pk2(r[2][i], r[3][i]); w.z = pk2(r[4][i], r[5][i]); w.w = pk2(r[6][i], r[7][i]);
        *(uint4*)(c.d + (size_t)i * c.ldd) = w;
    }
}
__device__ __forceinline__ void conv_all(const MKParams& p, int gw, int NGW, int lane) {
    const int CONV_ITEMS = p.bg ? CONV_ITEMS_BG : CONV_ITEMS_FULL;
    int it = gw;
    if (it >= CONV_ITEMS) return;
    f32x4 ra[8], rb[8];
    ConvItem ca = conv_decode(p, it, lane), cb = ca;
    conv_load(ca, ra);
    for (;;) {
        const int it2 = it + NGW;
        const bool has2 = it2 < CONV_ITEMS;
        if (has2) { cb = conv_decode(p, it2, lane); conv_load(cb, rb); }
        conv_store(ca, ra);
        if (!has2) break;
        const int it3 = it2 + NGW;
        const bool has3 = it3 < CONV_ITEMS;
        if (has3) { ca = conv_decode(p, it3, lane); conv_load(ca, ra); }
        conv_store(cb, rb);
        if (!has3) break;
        it = it3;
    }
}

template <bool TR>
struct EpiInProj8 {
    const MKParams& p; int m0, n0;
    __device__ __forceinline__ void operator()(f32x4 (&acc)[2][2][4][2], int wr, int wc, int fr, int fq) const {
#pragma unroll
        for (int ai = 0; ai < 2; ++ai)
#pragma unroll
            for (int m = 0; m < 4; ++m) {
                if (TR) {
                    const int token = m0 + ai * 128 + wr * 64 + m * 16 + fr;
                    const float rs = p.rstd_x[token];
#pragma unroll
                    for (int bj = 0; bj < 2; ++bj)
#pragma unroll
                        for (int n = 0; n < 2; ++n) {
                            const int col = n0 + bj * 128 + wc * 32 + n * 16 + fq * 4;
                            const f32x4 a = acc[ai][bj][m][n];
                            uint2 w;
                            if (n0 < 1024) {
                                w.x = pk2(a[0] * rs, a[1] * rs); w.y = pk2(a[2] * rs, a[3] * rs);
                                *(uint2*)(p.ua + ((size_t)(col >> 4) * 256 + (token >> 5)) * 768 + (token & 31) * 16 + (col & 15)) = w;
                            } else if (n0 < 2048) {
                                const float r8 = rs * 0.125f;
                                w.x = pk2(a[0] * r8, a[1] * r8); w.y = pk2(a[2] * r8, a[3] * r8);
                                *(uint2*)(p.qb + (size_t)token * 1024 + (col - 1024)) = w;
                            } else {
                                w.x = pk2(a[0] * rs, a[1] * rs); w.y = pk2(a[2] * rs, a[3] * rs);
                                *(uint2*)(p.kb + (size_t)token * 1024 + (col - 2048)) = w;
                            }
                        }
                } else {
                    const int token = m0 + ai * 128 + wr * 64 + m * 16 + fq * 4;
                    const float4 rs = *(const float4*)(p.rstd_x + token);
#pragma unroll
                    for (int bj = 0; bj < 2; ++bj)
#pragma unroll
                        for (int n = 0; n < 2; ++n) {
                            const int f = n0 - 3072 + bj * 128 + wc * 32 + n * 16 + fr;
                            const f32x4 a = acc[ai][bj][m][n];
                            uint2 w; w.x = pk2(a[0] * rs.x, a[1] * rs.y); w.y = pk2(a[2] * rs.z, a[3] * rs.w);
                            *(uint2*)(p.vT + (size_t)f * L_ + token) = w;
                        }
                }
            }
    }
};
struct MidOut8 {
    const float* rows;
    __device__ __forceinline__ void operator()(int t, f32x4 (&acc)[2][2][4][2], int wr, int fr, int fq) const {
        if (t == 16) {
#pragma unroll
            for (int ai = 0; ai < 2; ++ai)
#pragma unroll
                for (int m = 0; m < 4; ++m) {
                    const float ratio = rows[ai * 128 + wr * 64 + m * 16 + fr];
#pragma unroll
                    for (int bj = 0; bj < 2; ++bj)
#pragma unroll
                        for (int n = 0; n < 2; ++n) acc[ai][bj][m][n] *= ratio;
                }
        }
    }
};
struct EpiOut8 {
    const MKParams& p; const float* rows; int m0, n0, pn;
    __device__ __forceinline__ void operator()(f32x4 (&acc)[2][2][4][2], int wr, int wc, int fr, int fq) const {
#pragma unroll
        for (int ai = 0; ai < 2; ++ai)
#pragma unroll
            for (int m = 0; m < 4; ++m) {
                const int rt = ai * 128 + wr * 64 + m * 16 + fr, token = m0 + rt;
                const float rn = rows[256 + rt];
                float ss = 0.f;
#pragma unroll
                for (int bj = 0; bj < 2; ++bj)
#pragma unroll
                    for (int n = 0; n < 2; ++n) {
                        const int col = n0 + bj * 128 + wc * 32 + n * 16 + fq * 4;
                        const float4 xv = *(const float4*)(p.x + (size_t)token * D_ + col);
                        const float4 g = *(const float4*)(p.g_ffn + col);
                        const f32x4 a = acc[ai][bj][m][n];
                        const float v0 = xv.x + a[0] * rn, v1 = xv.y + a[1] * rn, v2 = xv.z + a[2] * rn, v3 = xv.w + a[3] * rn;
                        ss += v0 * v0 + v1 * v1 + v2 * v2 + v3 * v3;
                        uint2 w; w.x = pk2(v0 * g.x, v1 * g.y); w.y = pk2(v2 * g.z, v3 * g.w);
                        *(uint2*)(p.x1g + (size_t)token * D_ + col) = w;
                    }
                ss += __shfl_xor(ss, 16); ss += __shfl_xor(ss, 32);
                if (fq == 0) p.ssq_x1[token * 32 + pn * 4 + wc] = ss;
            }
    }
};
struct EpiMoe1_8 {
    const MKParams& p; int e, mt, nt;
    __device__ __forceinline__ void operator()(f32x4 (&acc)[2][2][4][2], int wr, int wc, int fr, int fq) const {
#pragma unroll
        for (int ai = 0; ai < 2; ++ai)
#pragma unroll
            for (int m = 0; m < 4; ++m) {
                const int slot = mt * 256 + ai * 128 + wr * 64 + m * 16 + fr;
                const float rs = p.rstd_x1[p.idx[e * CAP_ + slot]];
#pragma unroll
                for (int n = 0; n < 2; ++n) {
                    const f32x4 g = acc[ai][0][m][n] * rs, u = acc[ai][1][m][n] * rs;
                    float a[4];
#pragma unroll
                    for (int i = 0; i < 4; ++i) a[i] = g[i] / (1.f + __expf(-g[i])) * u[i];
                    uint2 w; w.x = pk2(a[0], a[1]); w.y = pk2(a[2], a[3]);
                    *(uint2*)(p.act + (size_t)(e * CAP_ + slot) * FF_ + nt * 128 + wc * 32 + n * 16 + fq * 4) = w;
                }
            }
    }
};
struct EpiMoe2_8 {
    const MKParams& p; int e, mt, nt;
    __device__ __forceinline__ void operator()(f32x4 (&acc)[2][2][4][2], int wr, int wc, int fr, int fq) const {
#pragma unroll
        for (int ai = 0; ai < 2; ++ai)
#pragma unroll
            for (int m = 0; m < 4; ++m) {
                const int slot = mt * 256 + ai * 128 + wr * 64 + m * 16 + fr;
                const float gt = p.gate[e * CAP_ + slot];
#pragma unroll
                for (int bj = 0; bj < 2; ++bj)
#pragma unroll
                    for (int n = 0; n < 2; ++n) {
                        const f32x4 a = acc[ai][bj][m][n] * gt;
                        uint2 w; w.x = pk2(a[0], a[1]); w.y = pk2(a[2], a[3]);
                        *(uint2*)(p.ye + (size_t)(e * CAP_ + slot) * D_ + nt * 256 + bj * 128 + wc * 32 + n * 16 + fq * 4) = w;
                    }
            }
    }
};

__device__ __forceinline__ void phase_prep(const MKParams& p, int gw, int NGW, int lane) {
    for (int row = gw; row < L_; row += NGW) {
        const float4* xr = (const float4*)(p.x + (size_t)row * D_);
        const float4* gr = (const float4*)p.g_mix;
        float s = 0.f;
        uint2* o = (uint2*)(p.xn + (size_t)row * XN_LD);
#pragma unroll
        for (int j = 0; j < 8; ++j) {
            const float4 v = xr[lane + 64 * j]; const float4 g = gr[lane + 64 * j];
            s += v.x * v.x + v.y * v.y + v.z * v.z + v.w * v.w;
            uint2 w; w.x = pk2(v.x * g.x, v.y * g.y); w.y = pk2(v.z * g.z, v.w * g.w);
            o[lane + 64 * j] = w;
        }
        s = wave_sum(s);
        if (lane == 0) p.rstd_x[row] = 1.0f / sqrtf(s * (1.0f / D_) + 1e-6f);
    }
    for (int i = gw * 64 + lane; i < NE_ * D_; i += NGW * 64) {
        const int e = i >> 11, n = i & (D_ - 1);
        const float w = p.w_router[n * NE_ + e];
        const unsigned hi = pk2(w, 0.f) & 0xffffu;
        const float rem = w - __uint_as_float(hi << 16);
        p.wrT[i] = (bf16_t)hi; p.wrT[NE_ * D_ + i] = (bf16_t)(pk2(rem, 0.f) & 0xffffu);
    }
}

__device__ __forceinline__ void phase_inproj(const MKParams& p, unsigned char* smem, int b) {
    for (int it = b; it < 512; it += gridDim.x) {
        const int xcd = it & 7, q = it >> 3;
        const int pn = (q & 1) * 8 + xcd;
        const int pm = q >> 1;
        const int m0 = pm * 256, n0 = pn * 256;
        ARows al{p.xn + (size_t)m0 * XN_LD, XN_LD};
        BHalves bl{p.w_in_t + (size_t)n0 * XN_LD, p.w_in_t + (size_t)(n0 + 128) * XN_LD, XN_LD};
        BgConv bg{p.w_gate, (long)(p.w_up - p.w_gate), p.w_gate_t, (long)(p.w_up_t - p.w_gate_t), BG_GU0 + (it >> 8) * 15 * 256 + (it & 255)};
        if (n0 < 3072) gemm8_tile<true>(smem, al, bl, D_ / 64, NoMid8{}, EpiInProj8<true>{p, m0, n0}, bg);
        else           gemm8_tile<false>(smem, al, bl, D_ / 64, NoMid8{}, EpiInProj8<false>{p, m0, n0}, bg);
    }
}

#define UA_LD 768
#define WSYNC() asm volatile("s_waitcnt lgkmcnt(0)" ::: "memory")
__device__ __forceinline__ void tw_sync(volatile LAS unsigned* cnt, unsigned& epoch, int lane) {
    WSYNC();
    if (lane == 0) __hip_atomic_fetch_add((LAS unsigned*)cnt, 1u, __ATOMIC_RELEASE, __HIP_MEMORY_SCOPE_WORKGROUP);
    ++epoch;
    while (__hip_atomic_load((LAS unsigned*)cnt, __ATOMIC_ACQUIRE, __HIP_MEMORY_SCOPE_WORKGROUP) < 2u * epoch) __builtin_amdgcn_s_sleep(1);
    asm volatile("" ::: "memory");
}
__device__ __forceinline__ void ssm_tables(const MKParams& p, unsigned char* smem, int g, int part, int tw, int lane, volatile LAS unsigned* cnt, unsigned& epoch) {
    float2* apow = (float2*)(smem + SM_GEMM);
    float2* bbar = apow + 2 * 33 * 64;
    float2* cc = bbar + 2 * 64 * 16;
    float* taps = (float*)(cc + 2 * 16 * 64);
    {
        const int d = tw;
        const int pp = lane;
        const float lr = (d ? p.a_re_b : p.a_re_f)[g * 64 + pp], li = (d ? p.a_im_b : p.a_im_f)[g * 64 + pp];
        const float dt = expf((d ? p.ldt_b : p.ldt_f)[g]);
        const float x = lr * dt, y = li * dt;
        const float ex = expf(x), cy = cosf(y), sy = sinf(y), sh = sinf(0.5f * y);
        const float ar = ex * cy, ai = ex * sy;
        float sr = 1.f, si = 0.f;
        for (int t = 0; t <= 32; ++t) {
            apow[(d * 33 + t) * 64 + pp] = make_float2(sr, si);
            const float nr = sr * ar - si * ai, ni = sr * ai + si * ar; sr = nr; si = ni;
        }
        if (part == 0) *(float2*)(p.A32 + ((size_t)(g * 2 + d) * 64 + pp) * 2) = apow[(d * 33 + 32) * 64 + pp];
        const float nr = expm1f(x) * cy - 2.f * sh * sh, ni = ex * sy;
        const float den = lr * lr + li * li;
        const float fr_ = (nr * lr + ni * li) / den, fi_ = (ni * lr - nr * li) / den;
        const float* brp = (d ? p.b_re_b : p.b_re_f) + (g * 64 + pp) * 16;
        const float* bip = (d ? p.b_im_b : p.b_im_f) + (g * 64 + pp) * 16;
#pragma unroll
        for (int q4 = 0; q4 < 4; ++q4) {
            const float4 br = *(const float4*)(brp + q4 * 4), bi = *(const float4*)(bip + q4 * 4);
            float2* o = bbar + (d * 64 + pp) * 16 + q4 * 4;
            o[0] = make_float2(fr_ * br.x - fi_ * bi.x, fr_ * bi.x + fi_ * br.x);
            o[1] = make_float2(fr_ * br.y - fi_ * bi.y, fr_ * bi.y + fi_ * br.y);
            o[2] = make_float2(fr_ * br.z - fi_ * bi.z, fr_ * bi.z + fi_ * br.z);
            o[3] = make_float2(fr_ * br.w - fi_ * bi.w, fr_ * bi.w + fi_ * br.w);
        }
        const float* crp = (d ? p.c_re_b : p.c_re_f) + (g * 16) * 64 + pp;
        const float* cip = (d ? p.c_im_b : p.c_im_f) + (g * 16) * 64 + pp;
#pragma unroll
        for (int co = 0; co < 16; ++co) cc[(d * 16 + co) * 64 + pp] = make_float2(crp[co * 64], cip[co * 64]);
    }
    tw_sync(cnt, epoch, lane);
    {
        const int li_ = lane & 15, lk = lane >> 4;
#pragma unroll 1
        for (int co = tw * 8; co < tw * 8 + 8; ++co) {
#pragma unroll 1
            for (int d = 0; d < 2; ++d) {
                f32x4 acc0 = (f32x4){0.f, 0.f, 0.f, 0.f}, acc1 = acc0;
#pragma unroll 4
                for (int s = 0; s < 32; ++s) {
                    const int q = 2 * s + (lk >> 1), ri = lk & 1;
                    const float2 c = cc[(d * 16 + co) * 64 + q], bb = bbar[(d * 64 + q) * 16 + li_];
                    const float gb = ri ? -(c.x * bb.y + c.y * bb.x) : (c.x * bb.x - c.y * bb.y);
                    const float2 a0 = apow[(d * 33 + li_) * 64 + q], a1 = apow[(d * 33 + 16 + li_) * 64 + q];
                    acc0 = __builtin_amdgcn_mfma_f32_16x16x4f32(ri ? a0.y : a0.x, gb, acc0, 0, 0, 0);
                    acc1 = __builtin_amdgcn_mfma_f32_16x16x4f32(ri ? a1.y : a1.x, gb, acc1, 0, 0, 0);
                }
#pragma unroll
                for (int r = 0; r < 4; ++r) {
                    const int t0 = 4 * lk + r, t1 = 16 + 4 * lk + r;
                    float* p0 = taps + ((d ? 31 - t0 : 31 + t0) * 16 + co) * 16 + li_;
                    float* p1 = taps + ((d ? 31 - t1 : 31 + t1) * 16 + co) * 16 + li_;
                    if (d == 1 && t0 == 0) *p0 += acc0[r]; else *p0 = acc0[r];
                    *p1 = acc1[r];
                }
            }
        }
    }
    tw_sync(cnt, epoch, lane);
#pragma unroll 1
    for (int it = lane; it < 64 * 96; it += 64) {
        const int n = part * 128 + tw * 64 + it / 96, k = (it % 96) * 8;
        const int l = n >> 4, co = n & 15;
        float v[8];
        if (k < 512) {
            const int j = k >> 4, ci0 = ((k >> 3) & 1) * 8;
            const float* tp = taps + ((l - j + 31) * 16 + co) * 16 + ci0;
#pragma unroll
            for (int q = 0; q < 8; ++q) v[q] = tp[q];
        } else {
            const int k2 = k - 512, d = k2 >> 7, pp0 = (k2 >> 1) & 63;
            const int t = d ? (32 - l) : (l + 1);
#pragma unroll
            for (int q = 0; q < 4; ++q) {
                const float2 a = apow[(d * 33 + t) * 64 + pp0 + q], c = cc[(d * 16 + co) * 64 + pp0 + q];
                v[2 * q] = c.x * a.x - c.y * a.y; v[2 * q + 1] = -(c.x * a.y + c.y * a.x);
            }
        }
        uint4 w; w.x = pk2(v[0], v[1]); w.y = pk2(v[2], v[3]); w.z = pk2(v[4], v[5]); w.w = pk2(v[6], v[7]);
        *(uint4*)(p.WyT + ((size_t)g * 512 + n) * UA_LD + k) = w;
    }
#pragma unroll 1
    for (int it = lane; it < 32 * 64; it += 64) {
        const int n2 = part * 64 + tw * 32 + (it >> 6), kc = it & 63;
        const int d = n2 >> 7, pp = (n2 >> 1) & 63, ri = n2 & 1, j = kc >> 1, half = kc & 1;
        const int t = d ? j : 31 - j;
        const float2 a = apow[(d * 33 + t) * 64 + pp];
        const float2* bp = bbar + (d * 64 + pp) * 16 + half * 8;
        float v[8];
#pragma unroll
        for (int q = 0; q < 8; ++q) { const float2 b = bp[q]; v[q] = ri ? (a.x * b.y + a.y * b.x) : (a.x * b.x - a.y * b.y); }
        uint4 w; w.x = pk2(v[0], v[1]); w.y = pk2(v[2], v[3]); w.z = pk2(v[4], v[5]); w.w = pk2(v[6], v[7]);
        *(uint4*)(p.PBt + ((size_t)g * 256 + n2) * 512 + kc * 8) = w;
    }
    tw_sync(cnt, epoch, lane);
}

#define SE_PITCH 132
struct EpiSsmE {
    const MKParams& p; unsigned char* smem; int g;
    __device__ __forceinline__ void operator()(f32x4 (&acc)[2][2][4][2], int wr, int wc, int fr, int fq) const {
        float* E = (float*)(smem + SM_GEMM);
        const int tid = opaque_tid();
#pragma unroll
        for (int d = 0; d < 2; ++d) {
            __syncthreads();
#pragma unroll
            for (int ai = 0; ai < 2; ++ai)
#pragma unroll
                for (int m = 0; m < 4; ++m)
#pragma unroll
                    for (int n = 0; n < 2; ++n)
                        *(f32x4*)(E + (ai * 128 + wr * 64 + m * 16 + fr) * SE_PITCH + wc * 32 + n * 16 + fq * 4) = acc[ai][d][m][n];
            __syncthreads();
            if (tid < 64) {
                const int pp = tid;
                const float2 A = *(const float2*)(p.A32 + ((size_t)(g * 2 + d) * 64 + pp) * 2);
                bf16_t* sdst = p.ua + (size_t)g * 256 * UA_LD + 512 + d * 128 + pp * 2;
                float sr = 0.f, si = 0.f;
#pragma unroll 8
                for (int s = 0; s < 256; ++s) {
                    const int c = d ? (255 - s) : s;
                    const float2 e = *(const float2*)(E + c * SE_PITCH + pp * 2);
                    *(unsigned*)(sdst + (size_t)c * UA_LD) = pk2(sr, si);
                    const float nr = A.x * sr - A.y * si + e.x, ni = A.x * si + A.y * sr + e.y;
                    sr = nr; si = ni;
                }
            }
        }
    }
};
__device__ __forceinline__ void ssm_e_item(const MKParams& p, unsigned char* smem, int g) {
    ARows al{p.ua + (size_t)g * 256 * UA_LD, UA_LD};
    BHalves bl{p.PBt + (size_t)g * 256 * 512, p.PBt + ((size_t)g * 256 + 128) * 512, 512};
    gemm8_tile<true>(smem, al, bl, 8, NoMid8{}, EpiSsmE{p, smem, g}, NoBg{});
}

__device__ __forceinline__ float gelu_tanh_f(float x) {
    const float k0 = 0.7978845608028654f, k1 = 0.044715f;
    const float z = k0 * (x + k1 * x * x * x);
    const float e = __expf(2.f * z);
    return 0.5f * x * (2.f - 2.f / (1.f + e));
}
struct EpiSsmY {
    const MKParams& p; int g, nh;
    __device__ __forceinline__ void operator()(f32x4 (&acc)[2][2][4][2], int wr, int wc, int fr, int fq) const {
        const float4 dsk = *(const float4*)(p.ssm_d + g * 16 + fq * 4);
#pragma unroll
        for (int ai = 0; ai < 2; ++ai)
#pragma unroll
            for (int m = 0; m < 4; ++m) {
                const int c = ai * 128 + wr * 64 + m * 16 + fr;
                const bf16_t* urow = p.ua + ((size_t)g * 256 + c) * UA_LD + fq * 4;
#pragma unroll
                for (int bj = 0; bj < 2; ++bj)
#pragma unroll
                    for (int n = 0; n < 2; ++n) {
                        const int l = nh * 16 + bj * 8 + wc * 2 + n;
                        const uint2 uu = *(const uint2*)(urow + l * 16);
                        const f32x4 a = acc[ai][bj][m][n];
                        const float y0 = gelu_tanh_f(a[0] + dsk.x * bflo(uu.x)), y1 = gelu_tanh_f(a[1] + dsk.y * bfhi(uu.x));
                        const float y2 = gelu_tanh_f(a[2] + dsk.z * bflo(uu.y)), y3 = gelu_tanh_f(a[3] + dsk.w * bfhi(uu.y));
                        uint2 w; w.x = pk2(y0, y1); w.y = pk2(y2, y3);
                        *(uint2*)(p.ypre + (size_t)(c * 32 + l) * DS_ + g * 16 + fq * 4) = w;
                    }
            }
    }
};
__device__ __forceinline__ void ssm_y_item(const MKParams& p, unsigned char* smem, int g, int nh) {
    ARows al{p.ua + (size_t)g * 256 * UA_LD, UA_LD};
    BHalves bl{p.WyT + ((size_t)g * 512 + nh * 256) * UA_LD, p.WyT + ((size_t)g * 512 + nh * 256 + 128) * UA_LD, UA_LD};
    gemm8_tile<true>(smem, al, bl, 12, NoMid8{}, EpiSsmY{p, g, nh}, NoBg{});
}

#define NA_RPB (SM_GEMM + 1024)
__device__ __forceinline__ void na_item(const MKParams& p, unsigned char* smem, int r, int hq) {
    int tid_ = threadIdx.x; asm volatile("" : "+v"(tid_));
    const int tid = tid_, lane = tid & 63, wave = tid >> 6, fr = lane & 15, fq = lane >> 4;
    const int h = hq * 4 + (wave >> 1), qh = wave & 1;
    int rs = r - 4; rs = rs < 0 ? 0 : (rs > 120 ? 120 : rs);
    bf16x8 qf[2][2];
#pragma unroll
    for (int qb = 0; qb < 2; ++qb)
#pragma unroll
        for (int ks = 0; ks < 2; ++ks) qf[qb][ks] = *(const bf16x8*)(p.qb + (size_t)(r * 64 + (2 * qh + qb) * 16 + fr) * 1024 + h * 64 + ks * 32 + fq * 8);
    int kbq[2], dxq[2];
#pragma unroll
    for (int qb = 0; qb < 2; ++qb) {
        const int c = (2 * qh + qb) * 16 + fr;
        int cs = c - 8; cs = cs < 0 ? 0 : (cs > 48 ? 48 : cs);
        kbq[qb] = 8 * fq - cs;
        dxq[qb] = (8 * fq - c + 15) * 4;
    }
    f32x4 o[2][4];
    float mrow[2], lrow[2];
#pragma unroll
    for (int qb = 0; qb < 2; ++qb) {
        mrow[qb] = -1e30f; lrow[qb] = 0.f;
#pragma unroll
        for (int mt = 0; mt < 4; ++mt) o[qb][mt] = (f32x4){0.f, 0.f, 0.f, 0.f};
    }
    const int krow_lane = (8 * (fr >> 2) + (fr & 3)) * 1024 + h * 64 + fq * 8;
    const size_t v_lane = (size_t)(h * 64 + fr) * L_ + 8 * fq;
    bf16x8 kf[2][2][2], vf[2][4];
    {
        const bf16_t* kbase = p.kb + (size_t)(rs * 64) * 1024 + krow_lane;
#pragma unroll
        for (int P = 0; P < 2; ++P)
#pragma unroll
            for (int sx = 0; sx < 2; ++sx)
#pragma unroll
                for (int ks = 0; ks < 2; ++ks) kf[P][sx][ks] = *(const bf16x8*)(kbase + (32 * P + 4 * sx) * 1024 + ks * 32);
#pragma unroll
        for (int P = 0; P < 2; ++P)
#pragma unroll
            for (int mt = 0; mt < 4; ++mt) vf[P][mt] = *(const bf16x8*)(p.vT + v_lane + (size_t)mt * 16 * L_ + rs * 64 + 32 * P);
    }
#pragma unroll 1
    for (int i = 0; i < 8; ++i) {
        const int inx = i < 7 ? i + 1 : 7;
        const int tokn = (rs + inx) * 64;
        const unsigned char* brow = smem + NA_RPB + ((h * 15 + (rs + i - r + 7)) * 31) * 4;
        f32x4 s[2][2][2];
#pragma unroll
        for (int P = 0; P < 2; ++P)
#pragma unroll
            for (int sx = 0; sx < 2; ++sx)
#pragma unroll
                for (int qb = 0; qb < 2; ++qb) {
                    f32x4 a = (f32x4){0.f, 0.f, 0.f, 0.f};
                    a = __builtin_amdgcn_mfma_f32_16x16x32_bf16(kf[P][sx][0], qf[qb][0], a, 0, 0, 0);
                    a = __builtin_amdgcn_mfma_f32_16x16x32_bf16(kf[P][sx][1], qf[qb][1], a, 0, 0, 0);
                    s[P][sx][qb] = a;
                }
        {
            const bf16_t* kbase = p.kb + (size_t)tokn * 1024 + krow_lane;
#pragma unroll
            for (int P = 0; P < 2; ++P)
#pragma unroll
                for (int sx = 0; sx < 2; ++sx)
#pragma unroll
                    for (int ks = 0; ks < 2; ++ks) kf[P][sx][ks] = *(const bf16x8*)(kbase + (32 * P + 4 * sx) * 1024 + ks * 32);
        }
        unsigned pp[2][2][4];
#pragma unroll
        for (int qb = 0; qb < 2; ++qb) {
            const unsigned char* bq = brow + dxq[qb];
            float bv[16];
#pragma unroll
            for (int c16 = 0; c16 < 16; ++c16) bv[c16] = *(const float*)(bq + (32 * (c16 >> 3) + 4 * ((c16 >> 2) & 1) + (c16 & 3)) * 4);
            asm volatile("" : "+v"(bv[0]), "+v"(bv[1]), "+v"(bv[2]), "+v"(bv[3]), "+v"(bv[4]), "+v"(bv[5]), "+v"(bv[6]), "+v"(bv[7]),
                              "+v"(bv[8]), "+v"(bv[9]), "+v"(bv[10]), "+v"(bv[11]), "+v"(bv[12]), "+v"(bv[13]), "+v"(bv[14]), "+v"(bv[15]));
            float mx = -1e30f;
#pragma unroll
            for (int P = 0; P < 2; ++P)
#pragma unroll
                for (int sx = 0; sx < 2; ++sx)
#pragma unroll
                    for (int rg = 0; rg < 4; ++rg) {
                        const int cst = 32 * P + 4 * sx + rg;
                        const bool valid = (unsigned)(cst + kbq[qb]) < 16u;
                        const float v = valid ? (s[P][sx][qb][rg] + bv[P * 8 + sx * 4 + rg]) : -1e30f;
                        s[P][sx][qb][rg] = v;
                        mx = fmaxf(mx, v);
                    }
            mx = fmaxf(mx, __shfl_xor(mx, 16));
            mx = fmaxf(mx, __shfl_xor(mx, 32));
            const float mn = fmaxf(mrow[qb], mx);
            const float alpha = __expf(mrow[qb] - mn);
            mrow[qb] = mn;
            float ls = 0.f;
#pragma unroll
            for (int P = 0; P < 2; ++P)
#pragma unroll
                for (int sx = 0; sx < 2; ++sx) {
                    float e[4];
#pragma unroll
                    for (int rg = 0; rg < 4; ++rg) { e[rg] = __expf(s[P][sx][qb][rg] - mn); ls += e[rg]; }
                    pp[qb][P][sx * 2 + 0] = pk2(e[0], e[1]);
                    pp[qb][P][sx * 2 + 1] = pk2(e[2], e[3]);
                }
            lrow[qb] = lrow[qb] * alpha + ls;
#pragma unroll
            for (int mt = 0; mt < 4; ++mt) o[qb][mt] *= alpha;
        }
#pragma unroll
        for (int P = 0; P < 2; ++P)
#pragma unroll
            for (int mt = 0; mt < 4; ++mt)
#pragma unroll
                for (int qb = 0; qb < 2; ++qb) {
                    uint4 w; w.x = pp[qb][P][0]; w.y = pp[qb][P][1]; w.z = pp[qb][P][2]; w.w = pp[qb][P][3];
                    o[qb][mt] = __builtin_amdgcn_mfma_f32_16x16x32_bf16(vf[P][mt], __builtin_bit_cast(bf16x8, w), o[qb][mt], 0, 0, 0);
                }
#pragma unroll
        for (int P = 0; P < 2; ++P)
#pragma unroll
            for (int mt = 0; mt < 4; ++mt) vf[P][mt] = *(const bf16x8*)(p.vT + v_lane + (size_t)mt * 16 * L_ + tokn + 32 * P);
    }
#pragma unroll
    for (int qb = 0; qb < 2; ++qb) {
        float l = lrow[qb];
        l += __shfl_xor(l, 16); l += __shfl_xor(l, 32);
        const float inv = 1.f / l;
        const int token = r * 64 + (2 * qh + qb) * 16 + fr;
        float ss = 0.f;
#pragma unroll
        for (int mt = 0; mt < 4; ++mt) {
            const float4 g = *(const float4*)(p.g_na + h * 64 + mt * 16 + 4 * fq);
            const f32x4 v = o[qb][mt] * inv;
            ss += v[0] * v[0] + v[1] * v[1] + v[2] * v[2] + v[3] * v[3];
            uint2 w; w.x = pk2(v[0] * g.x, v[1] * g.y); w.y = pk2(v[2] * g.z, v[3] * g.w);
            *(uint2*)(p.ymix + (size_t)token * D_ + DS_ + h * 64 + mt * 16 + 4 * fq) = w;
        }
        ss += __shfl_xor(ss, 16); ss += __shfl_xor(ss, 32);
        if (fq == 0) p.ssq_na[token * 16 + h] = ss;
    }
}
#define NA_ITEMS 512
__device__ __forceinline__ void phase2(const MKParams& p, unsigned char* smem, int b, int G, unsigned* counter) {
    for (int it = b; it < 64; it += G) ssm_e_item(p, smem, it);
    __syncthreads();
    const int tq = opaque_tid();
    { float* dst = (float*)(smem + NA_RPB); for (int i = tq; i < 16 * 15 * 31; i += NT_) dst[i] = p.rpb[i]; }
    volatile LAS int* slot = (volatile LAS int*)(smem + 32);
    for (;;) {
        __syncthreads();
        if (tq == 0) *slot = (int)__hip_atomic_fetch_add(counter, 1u, __ATOMIC_RELAXED, __HIP_MEMORY_SCOPE_AGENT);
        __syncthreads();
        const int j = *slot;
        if (j >= NA_ITEMS) break;
        na_item(p, smem, j >> 2, j & 3);
    }
}

struct EpiGlu8 {
    const MKParams& p; int m0, n0, pn;
    __device__ __forceinline__ void operator()(f32x4 (&acc)[2][2][4][2], int wr, int wc, int fr, int fq) const {
#pragma unroll
        for (int ai = 0; ai < 2; ++ai)
#pragma unroll
            for (int m = 0; m < 4; ++m) {
                const int token = m0 + ai * 128 + wr * 64 + m * 16 + fr;
                float ss = 0.f;
#pragma unroll
                for (int bj = 0; bj < 2; ++bj)
#pragma unroll
                    for (int n = 0; n < 2; ++n) {
                        const int col = n0 + bj * 128 + wc * 32 + n * 16 + fq * 4;
                        const float4 b = *(const float4*)(p.b_glu + col);
                        const float4 g = *(const float4*)(p.g_ssm + col);
                        const uint2 yy = *(const uint2*)(p.ypre + (size_t)token * DS_ + col);
                        const f32x4 a = acc[ai][bj][m][n];
                        const float y0 = bflo(yy.x) / (1.f + __expf(-(a[0] + b.x))), y1 = bfhi(yy.x) / (1.f + __expf(-(a[1] + b.y)));
                        const float y2 = bflo(yy.y) / (1.f + __expf(-(a[2] + b.z))), y3 = bfhi(yy.y) / (1.f + __expf(-(a[3] + b.w)));
                        ss += y0 * y0 + y1 * y1 + y2 * y2 + y3 * y3;
                        uint2 w; w.x = pk2(y0 * g.x, y1 * g.y); w.y = pk2(y2 * g.z, y3 * g.w);
                        *(uint2*)(p.ymix + (size_t)token * D_ + col) = w;
                    }
                ss += __shfl_xor(ss, 16); ss += __shfl_xor(ss, 32);
                if (fq == 0) p.ssq_ssm[token * 16 + pn * 4 + wc] = ss;
            }
    }
};
__device__ __forceinline__ void glu_item(const MKParams& p, unsigned char* smem, int it) {
    const int pn = it & 3, pm = it >> 2;
    const int m0 = pm * 256, n0 = pn * 256;
    ARows al{p.ypre + (size_t)m0 * DS_, DS_};
    BHalves bl{p.w_glu_t + (size_t)n0 * DS_, p.w_glu_t + (size_t)(n0 + 128) * DS_, DS_};
    gemm8_tile<true>(smem, al, bl, DS_ / 64, NoMid8{}, EpiGlu8{p, m0, n0, pn}, NoBg{});
}

__device__ __forceinline__ float rstd16(const float* part) {
    const float4 a = ((const float4*)part)[0], b = ((const float4*)part)[1], c = ((const float4*)part)[2], d = ((const float4*)part)[3];
    const float s = ((a.x + a.y) + (a.z + a.w)) + ((b.x + b.y) + (b.z + b.w)) + ((c.x + c.y) + (c.z + c.w)) + ((d.x + d.y) + (d.z + d.w));
    return 1.0f / sqrtf(s * (1.0f / DS_) + 1e-6f);
}
struct MidOut {
    const float* rows;
    __device__ __forceinline__ void operator()(int kt, f32x4 (&acc)[8][4], int wr, int fr, int fq) const {
        if (kt == 16) {
#pragma unroll
            for (int m = 0; m < 8; ++m) {
                const float ratio = rows[wr * 128 + m * 16 + fr];
#pragma unroll
                for (int nn = 0; nn < 4; ++nn) acc[m][nn] *= ratio;
            }
        }
    }
};
struct EpiOut {
    const MKParams& p; const float* rows; int m0, n0, pn;
    __device__ __forceinline__ void operator()(f32x4 (&acc)[8][4], int wr, int wc, int fr, int fq) const {
#pragma unroll
        for (int m = 0; m < 8; ++m) {
            const int token = m0 + wr * 128 + m * 16 + fr;
            const float rn = rows[256 + wr * 128 + m * 16 + fr];
            float ss = 0.f;
#pragma unroll
            for (int nn = 0; nn < 4; ++nn) {
                const int col = n0 + wc * 64 + nn * 16 + fq * 4;
                const float4 xv = *(const float4*)(p.x + (size_t)token * D_ + col);
                const float4 g = *(const float4*)(p.g_ffn + col);
                const f32x4 a = acc[m][nn];
                const float v0 = xv.x + a[0] * rn, v1 = xv.y + a[1] * rn, v2 = xv.z + a[2] * rn, v3 = xv.w + a[3] * rn;
                ss += v0 * v0 + v1 * v1 + v2 * v2 + v3 * v3;
                uint2 w; w.x = pk2(v0 * g.x, v1 * g.y); w.y = pk2(v2 * g.z, v3 * g.w);
                *(uint2*)(p.x1g + (size_t)token * D_ + col) = w;
            }
            ss += __shfl_xor(ss, 16); ss += __shfl_xor(ss, 32);
            if (fq == 0) p.ssq_x1[token * 32 + pn * 4 + wc] = ss;
        }
    }
};
__device__ __forceinline__ void outproj_item(const MKParams& p, unsigned char* smem, int it) {
    const int pn = it & 7, pm = it >> 3;
    const int m0 = pm * 256, n0 = pn * 256;
    float* rows = (float*)(smem + SM_ROWS);
    __syncthreads();
    const int tq = opaque_tid();
    if (tq < 256) {
        const int token = m0 + tq;
        const float rs = rstd16(p.ssq_ssm + token * 16), rn = rstd16(p.ssq_na + token * 16);
        rows[tq] = rs / rn; rows[256 + tq] = rn;
    }
    ARows al{p.ymix + (size_t)m0 * D_, D_};
    BHalves bl{p.w_out_t + (size_t)n0 * D_, p.w_out_t + (size_t)(n0 + 128) * D_, D_};
    BgConv bg{p.w_gate, (long)(p.w_up - p.w_gate), p.w_gate_t, (long)(p.w_up_t - p.w_gate_t), BG_GU0 + 30 * 256 + it};
    gemm8_tile<true>(smem, al, bl, D_ / 64, MidOut8{rows}, EpiOut8{p, rows, m0, n0, pn}, bg);
}

#define RT_PART (SM_GEMM)
__device__ __forceinline__ void router_item(const MKParams& p, unsigned char* smem, int item) {
    const int tid = opaque_tid(), lane = tid & 63, wave = tid >> 6, fr = lane & 15, fq = lane >> 4;
    const int tile = item * 2 + (wave >> 2), kq = wave & 3;
    const int token = tile * 16 + fr;
    const bf16_t* xr = p.x1g + (size_t)token * D_ + kq * 512 + fq * 8;
    const bf16_t* wh = p.wrT + (size_t)fr * D_ + kq * 512 + fq * 8;
    const bf16_t* wl = wh + 16 * D_;
    f32x4 ah = (f32x4){0.f, 0.f, 0.f, 0.f}, alo = (f32x4){0.f, 0.f, 0.f, 0.f};
#pragma unroll 8
    for (int k = 0; k < 512; k += 32) {
        const bf16x8 xb = *(const bf16x8*)(xr + k);
        ah = __builtin_amdgcn_mfma_f32_16x16x32_bf16(*(const bf16x8*)(wh + k), xb, ah, 0, 0, 0);
        alo = __builtin_amdgcn_mfma_f32_16x16x32_bf16(*(const bf16x8*)(wl + k), xb, alo, 0, 0, 0);
    }
    f32x4* part = (f32x4*)(smem + RT_PART);
    __syncthreads();
    part[wave * 64 + lane] = ah + alo;
    __syncthreads();
    if (kq == 0) {
        const f32x4 t = part[wave * 64 + lane] + part[(wave + 1) * 64 + lane] + part[(wave + 2) * 64 + lane] + part[(wave + 3) * 64 + lane];
        const float4 s0 = *(const float4*)(p.ssq_x1 + token * 32 + fq * 8), s1 = *(const float4*)(p.ssq_x1 + token * 32 + fq * 8 + 4);
        float ss = ((s0.x + s0.y) + (s0.z + s0.w)) + ((s1.x + s1.y) + (s1.z + s1.w));
        ss += __shfl_xor(ss, 16); ss += __shfl_xor(ss, 32);
        const float rs = 1.0f / sqrtf(ss * (1.0f / D_) + 1e-6f);
        float l[4];
#pragma unroll
        for (int i = 0; i < 4; ++i) l[i] = t[i] * rs;
        float mx = fmaxf(fmaxf(l[0], l[1]), fmaxf(l[2], l[3]));
        mx = fmaxf(mx, __shfl_xor(mx, 16)); mx = fmaxf(mx, __shfl_xor(mx, 32));
        float e[4], sum = 0.f;
#pragma unroll
        for (int i = 0; i < 4; ++i) { e[i] = expf(l[i] - mx); sum += e[i]; }
        sum += __shfl_xor(sum, 16); sum += __shfl_xor(sum, 32);
        const float inv = 1.f / sum;
#pragma unroll
        for (int i = 0; i < 4; ++i) {
            const float a = e[i] * inv;
            p.aff_t[(size_t)(4 * fq + i) * L_ + token] = a;
            atomicAdd(p.ahist + (4 * fq + i) * 4096 + (__float_as_uint(a) >> 19), 1u);
        }
        if (fq == 0) p.rstd_x1[token] = rs;
    }
}

#define TK_MISC (SM_GEMM)
#define TK_SUF  (SM_GEMM + 64)
#define TK_LIST (SM_GEMM + 1024)
__device__ __forceinline__ void topk_item(const MKParams& p, unsigned char* smem, int e) {
    const int tid = opaque_tid(), lane = tid & 63, wave = tid >> 6;
    unsigned* misc = (unsigned*)(smem + TK_MISC);
    unsigned* wsum = (unsigned*)(smem + TK_SUF);
    uint2* list = (uint2*)(smem + TK_LIST);
    const float* a = p.aff_t + (size_t)e * L_;
    unsigned key[16];
#pragma unroll
    for (int i = 0; i < 16; ++i) key[i] = __float_as_uint(a[tid + NT_ * i]);
    const uint4 h0 = *(const uint4*)(p.ahist + e * 4096 + tid * 8), h1 = *(const uint4*)(p.ahist + e * 4096 + tid * 8 + 4);
    const unsigned hb[8] = {h0.x, h0.y, h0.z, h0.w, h1.x, h1.y, h1.z, h1.w};
    unsigned own = 0;
#pragma unroll
    for (int i = 0; i < 8; ++i) own += hb[i];
    unsigned suf = own;
#pragma unroll
    for (int o = 1; o < 64; o <<= 1) { const unsigned t = __shfl_down(suf, o); if (lane + o < 64) suf += t; }
    __syncthreads();
    if (lane == 0) wsum[wave] = suf;
    if (tid == 0) { misc[2] = 0u; misc[3] = 0u; }
    __syncthreads();
    unsigned above = suf - own;
#pragma unroll
    for (int w = 0; w < 8; ++w) if (w > wave) above += wsum[w];
    if (above < (unsigned)CAP_ && (unsigned)CAP_ <= above + own) {
        unsigned cnt = above;
#pragma unroll
        for (int i = 7; i >= 0; --i) {
            if (cnt < (unsigned)CAP_ && (unsigned)CAP_ <= cnt + hb[i]) { misc[0] = (unsigned)(tid * 8 + i); misc[1] = (unsigned)CAP_ - cnt; }
            cnt += hb[i];
        }
    }
    __syncthreads();
    const unsigned T = misc[0], need = misc[1];
#pragma unroll
    for (int i = 0; i < 16; ++i)
        if ((key[i] >> 19) == T) { const unsigned s = atomicAdd(&misc[3], 1u); list[s] = make_uint2(key[i], (unsigned)(tid + NT_ * i)); }
    __syncthreads();
    const unsigned nc = misc[3];
#pragma unroll
    for (int i = 0; i < 16; ++i) {
        const int token = tid + NT_ * i;
        const unsigned bin = key[i] >> 19;
        if (bin != T) {
            int slot = -1;
            if (bin > T) {
                slot = (int)atomicAdd(&misc[2], 1u);
                p.idx[e * CAP_ + slot] = token;
                p.gate[e * CAP_ + slot] = __uint_as_float(key[i]);
            }
            p.slot_of[token * NE_ + e] = slot;
        }
    }
    for (unsigned c0 = tid; c0 < nc; c0 += NT_) {
        const uint2 me = list[c0];
        unsigned rank = 0;
        unsigned j = 0;
        for (; j + 4 <= nc; j += 4) {
            const uint2 a0 = list[j], a1 = list[j + 1], a2 = list[j + 2], a3 = list[j + 3];
            rank += (a0.x > me.x || (a0.x == me.x && a0.y < me.y)) ? 1u : 0u;
            rank += (a1.x > me.x || (a1.x == me.x && a1.y < me.y)) ? 1u : 0u;
            rank += (a2.x > me.x || (a2.x == me.x && a2.y < me.y)) ? 1u : 0u;
            rank += (a3.x > me.x || (a3.x == me.x && a3.y < me.y)) ? 1u : 0u;
        }
        for (; j < nc; ++j) { const uint2 a0 = list[j]; rank += (a0.x > me.x || (a0.x == me.x && a0.y < me.y)) ? 1u : 0u; }
        int slot = -1;
        if (rank < need) {
            slot = (int)atomicAdd(&misc[2], 1u);
            p.idx[e * CAP_ + slot] = (int)me.y;
            p.gate[e * CAP_ + slot] = __uint_as_float(me.x);
        }
        p.slot_of[me.y * NE_ + e] = slot;
    }
    __syncthreads();
}

struct AGather { const bf16_t* base; const int* rows; __device__ __forceinline__ const bf16_t* ubase() const { return base; } __device__ __forceinline__ unsigned row_off(int r) const { return (unsigned)rows[r] * (unsigned)D_; } };
struct BMoe1 {
    const float* wg; long up_minus_gate; int col0;
    __device__ __forceinline__ const float* ubase(int wave) const { return wg + (long)(wave & 1) * up_minus_gate; }
    __device__ __forceinline__ unsigned col_off(int n4) const {
        const int wc = n4 >> 6, nn = (n4 >> 4) & 3, i = n4 & 15;
        return (unsigned)(col0 + wc * 32 + (nn & 1) * 16 + i);
    }
};
struct EpiMoe1 {
    const MKParams& p; int e, mt, nt;
    __device__ __forceinline__ void operator()(f32x4 (&acc)[8][4], int wr, int wc, int fr, int fq) const {
#pragma unroll
        for (int m = 0; m < 8; ++m) {
            const int slot = mt * 256 + wr * 128 + m * 16 + fr;
            const float rs = p.rstd_x1[p.idx[e * CAP_ + slot]];
#pragma unroll
            for (int nn = 0; nn < 2; ++nn) {
                const f32x4 g = acc[m][nn] * rs, u = acc[m][nn + 2] * rs;
                float a[4];
#pragma unroll
                for (int i = 0; i < 4; ++i) a[i] = g[i] / (1.f + __expf(-g[i])) * u[i];
                uint2 w; w.x = pk2(a[0], a[1]); w.y = pk2(a[2], a[3]);
                *(uint2*)(p.act + (size_t)(e * CAP_ + slot) * FF_ + nt * 128 + wc * 32 + nn * 16 + fq * 4) = w;
            }
        }
    }
};
__device__ __forceinline__ void moe1_item(const MKParams& p, unsigned char* smem, int it) {
    const int rnd = it >> 8, b = it & 255, xcd = b & 7, s = b >> 3;
    const int mt = s & 3, wt = rnd * 64 + xcd * 8 + (s >> 2);
    const int e = wt >> 4, nt = wt & 15;
    AGather al{p.x1g, p.idx + e * CAP_ + mt * 256};
    BHalves bl{p.w_gate_t + ((size_t)e * FF_ + nt * 128) * D_, p.w_up_t + ((size_t)e * FF_ + nt * 128) * D_, D_};
    BgConv bg{p.w_down, 0L, p.w_down_t, 0L, rnd * 15 * 256 + b};
    gemm8_tile<true>(smem, al, bl, D_ / 64, NoMid8{}, EpiMoe1_8{p, e, mt, nt}, bg);
}

struct EpiMoe2 {
    const MKParams& p; int e, mt, nt;
    __device__ __forceinline__ void operator()(f32x4 (&acc)[8][4], int wr, int wc, int fr, int fq) const {
#pragma unroll
        for (int m = 0; m < 8; ++m) {
            const int slot = mt * 256 + wr * 128 + m * 16 + fr;
            const float gt = p.gate[e * CAP_ + slot];
#pragma unroll
            for (int nn = 0; nn < 4; ++nn) {
                const f32x4 a = acc[m][nn] * gt;
                uint2 w; w.x = pk2(a[0], a[1]); w.y = pk2(a[2], a[3]);
                *(uint2*)(p.ye + (size_t)(e * CAP_ + slot) * D_ + nt * 256 + wc * 64 + nn * 16 + fq * 4) = w;
            }
        }
    }
};
__device__ __forceinline__ void moe2_item(const MKParams& p, unsigned char* smem, int it) {
    const int rnd = it >> 8, b = it & 255, xcd = b & 7, s = b >> 3;
    const int mt = s & 3, wt = rnd * 64 + xcd * 8 + (s >> 2);
    const int e = wt >> 3, nt = wt & 7;
    ARows al{p.act + (size_t)(e * CAP_ + mt * 256) * FF_, FF_};
    BHalves bl{p.w_down_t + ((size_t)e * D_ + nt * 256) * FF_, p.w_down_t + ((size_t)e * D_ + nt * 256 + 128) * FF_, FF_};
    gemm8_tile<true>(smem, al, bl, FF_ / 64, NoMid8{}, EpiMoe2_8{p, e, mt, nt}, NoBg{});
}

__device__ __forceinline__ void final_token(const MKParams& p, int token, int lane) {
    float v[4][8];
#pragma unroll
    for (int j = 0; j < 4; ++j) {
        const int n = j * 512 + lane * 8;
        const uint4 w = *(const uint4*)(p.x1g + (size_t)token * D_ + n);
        const float4 g0 = *(const float4*)(p.g_ffn + n), g1 = *(const float4*)(p.g_ffn + n + 4);
        v[j][0] = bflo(w.x) / g0.x; v[j][1] = bfhi(w.x) / g0.y; v[j][2] = bflo(w.y) / g0.z; v[j][3] = bfhi(w.y) / g0.w;
        v[j][4] = bflo(w.z) / g1.x; v[j][5] = bfhi(w.z) / g1.y; v[j][6] = bflo(w.w) / g1.z; v[j][7] = bfhi(w.w) / g1.w;
    }
#pragma unroll 1
    for (int e = 0; e < NE_; ++e) {
        const int slot = p.slot_of[token * NE_ + e];
        if (slot >= 0) {
            const bf16_t* yr = p.ye + (size_t)(e * CAP_ + slot) * D_;
#pragma unroll
            for (int j = 0; j < 4; ++j) {
                const uint4 w = *(const uint4*)(yr + j * 512 + lane * 8);
                v[j][0] += bflo(w.x); v[j][1] += bfhi(w.x); v[j][2] += bflo(w.y); v[j][3] += bfhi(w.y);
                v[j][4] += bflo(w.z); v[j][5] += bfhi(w.z); v[j][6] += bflo(w.w); v[j][7] += bfhi(w.w);
            }
        }
    }
    float ss = 0.f;
#pragma unroll
    for (int j = 0; j < 4; ++j)
#pragma unroll
        for (int i = 0; i < 8; ++i) ss += v[j][i] * v[j][i];
    ss = wave_sum(ss);
    const float rs = 1.0f / sqrtf(ss * (1.0f / D_) + 1e-6f);
#pragma unroll
    for (int j = 0; j < 4; ++j) {
        const int n = j * 512 + lane * 8;
        const float4 g0 = *(const float4*)(p.g_final + n), g1 = *(const float4*)(p.g_final + n + 4);
        float4 o0, o1;
        o0.x = v[j][0] * rs * g0.x; o0.y = v[j][1] * rs * g0.y; o0.z = v[j][2] * rs * g0.z; o0.w = v[j][3] * rs * g0.w;
        o1.x = v[j][4] * rs * g1.x; o1.y = v[j][5] * rs * g1.y; o1.z = v[j][6] * rs * g1.z; o1.w = v[j][7] * rs * g1.w;
        *(float4*)(p.out + (size_t)token * D_ + n) = o0;
        *(float4*)(p.out + (size_t)token * D_ + n + 4) = o1;
    }
}


#ifndef REP0
#define REP0 1
#endif
#ifndef REP1
#define REP1 1
#endif
#ifndef REP2
#define REP2 1
#endif
#ifndef REP3
#define REP3 1
#endif
#ifndef REP4
#define REP4 1
#endif
#ifndef REP5
#define REP5 1
#endif
#ifndef REP6
#define REP6 1
#endif
#ifndef REP7
#define REP7 1
#endif
#ifndef REP8
#define REP8 1
#endif
#ifndef REP9
#define REP9 1
#endif
#ifndef REP10
#define REP10 1
#endif
#ifndef REP12
#define REP12 1
#endif
#ifndef REP13
#define REP13 0
#endif
__global__ __launch_bounds__(NT_, 2) void k_mega(MKParams p) {
    extern __shared__ __attribute__((aligned(16))) unsigned char smem[];
    volatile LAS unsigned* st = (volatile LAS unsigned*)smem;
    if (threadIdx.x < 4) st[threadIdx.x] = 0u;
    if (threadIdx.x == 4) *(volatile LAS unsigned*)(smem + 64) = 0u;
    __syncthreads();
    xcd_barrier_post(p.bar, st);
    if (p.never) cg::this_grid().sync();
    const int G = gridDim.x, b0 = blockIdx.x;
    {
        const int tq = opaque_tid(), lane = tq & 63, wave = __builtin_amdgcn_readfirstlane(tq >> 6);
        if (wave < 2) {
            unsigned epoch = 0;
            volatile LAS unsigned* cnt = (volatile LAS unsigned*)(smem + 64);
            for (int rep = 0; rep < p.rep[10]; ++rep)
                for (int it = b0; it < 256; it += G) ssm_tables(p, smem, it >> 2, it & 3, wave, lane, cnt, epoch);
        } else {
            const int gw = b0 * 6 + (wave - 2), NGW = G * 6;
            for (int rep = 0; rep < p.rep[0]; ++rep) conv_all(p, gw, NGW, lane);
            phase_prep(p, gw, NGW, lane);
            for (int i = gw * 64 + lane; i < NE_ * 4096; i += NGW * 64) p.ahist[i] = 0u;
        }
    }
    xcd_barrier(p.bar, st);
    if (threadIdx.x == 0) {
        bool even = (G % 8) == 0;
        for (int j = 0; j < 8; ++j) even = even && (xb_ld(&p.bar[XB_XCNT(j)]) == (unsigned)(G / 8));
        st[2] = even ? (st[2] + 8u * st[3]) : (unsigned)blockIdx.x;
    }
    __syncthreads();
    const int b = (int)st[2];
    for (int rep = 0; rep < p.rep[1]; ++rep) {
    phase_inproj(p, smem, b);
    xcd_barrier(p.bar, st);
    }
    for (int rep = 0; rep < p.rep[2]; ++rep) {
    phase2(p, smem, b, G, p.bar + 64 + rep);
    xcd_barrier(p.bar, st);
    }
    for (int rep = 0; rep < p.rep[3]; ++rep) {
    for (int it = b; it < 128; it += G) { const int q = it >> 3; ssm_y_item(p, smem, (it & 7) + 8 * (q >> 1), q & 1); }
    xcd_barrier(p.bar, st);
    }
    for (int rep = 0; rep < p.rep[4]; ++rep) {
    for (int it = b; it < 128; it += G) glu_item(p, smem, it);
    xcd_barrier(p.bar, st);
    }
    for (int rep = 0; rep < p.rep[5]; ++rep) {
    for (int it = b; it < 256; it += G) outproj_item(p, smem, it);
    xcd_barrier(p.bar, st);
    }
    for (int rep = 0; rep < p.rep[6]; ++rep) {
    for (int it = b; it < L_ / 32; it += G) router_item(p, smem, it);
    xcd_barrier(p.bar, st);
    }
    for (int rep = 0; rep < p.rep[7]; ++rep) {
    for (int it = b; it < NE_; it += G) topk_item(p, smem, it);
    xcd_barrier(p.bar, st);
    }
    for (int rep = 0; rep < p.rep[8]; ++rep) {
    for (int it = b; it < 1024; it += G) moe1_item(p, smem, it);
    xcd_barrier(p.bar, st);
    }
    for (int rep = 0; rep < p.rep[9]; ++rep) {
    for (int it = b; it < 512; it += G) moe2_item(p, smem, it);
    xcd_barrier(p.bar, st);
    }
    for (int i = 0; i < p.rep[13]; ++i) xcd_barrier(p.bar, st);
    for (int rep = 0; rep < p.rep[12]; ++rep)
    { int tq = threadIdx.x; asm volatile("" : "+v"(tq));
      for (int t = b * 8 + (tq >> 6); t < L_; t += G * 8) final_token(p, t, tq & 63); }
}

extern "C" void kernel_launch(void* const* d_in, const int* in_sizes, int n_in, void* d_out, int out_size, void* d_ws, size_t ws_size,
                              hipStream_t stream) {
    (void)in_sizes; (void)n_in; (void)out_size; (void)ws_size;
    static int grid = 0;
    if (!grid) {
        int dev = 0, cus = 0, per_cu = 0;
        (void)hipGetDevice(&dev);
        (void)hipDeviceGetAttribute(&cus, hipDeviceAttributeMultiprocessorCount, dev);
        (void)hipFuncSetAttribute((const void*)k_mega, hipFuncAttributeMaxDynamicSharedMemorySize, MK_LDS);
        (void)hipOccupancyMaxActiveBlocksPerMultiprocessor(&per_cu, (const void*)k_mega, NT_, MK_LDS);
        if (per_cu < 1) per_cu = 1;
        grid = cus;
    }
    MKParams mp{};
    const float* const* in = (const float* const*)d_in;
    mp.x = in[0]; mp.g_mix = in[1]; mp.w_in = in[2];
    mp.a_re_f = in[3]; mp.a_im_f = in[4]; mp.ldt_f = in[5]; mp.b_re_f = in[6]; mp.b_im_f = in[7]; mp.c_re_f = in[8]; mp.c_im_f = in[9];
    mp.a_re_b = in[10]; mp.a_im_b = in[11]; mp.ldt_b = in[12]; mp.b_re_b = in[13]; mp.b_im_b = in[14]; mp.c_re_b = in[15]; mp.c_im_b = in[16];
    mp.ssm_d = in[17]; mp.w_glu = in[18]; mp.b_glu = in[19]; mp.rpb = in[20]; mp.g_ssm = in[21]; mp.g_na = in[22]; mp.w_out = in[23];
    mp.g_ffn = in[24]; mp.w_router = in[25]; mp.w_gate = in[26]; mp.w_up = in[27]; mp.w_down = in[28]; mp.g_final = in[29];
    mp.out = (float*)d_out;
    unsigned char* ws = (unsigned char*)d_ws;
    size_t off = 0;
    auto take = [&](size_t bytes) { unsigned char* q = ws + off; off += (bytes + 255) & ~(size_t)255; return q; };
    mp.bar = (unsigned*)take(XCD_BAR_WORDS * 4);
    mp.xn = (bf16_t*)take((size_t)L_ * XN_LD * 2);
    mp.rstd_x = (float*)take(L_ * 4);
    mp.ua = (bf16_t*)take((size_t)64 * 256 * 768 * 2);
    mp.qb = (bf16_t*)take((size_t)L_ * DS_ * 2);
    mp.kb = (bf16_t*)take((size_t)L_ * DS_ * 2);
    mp.vT = (bf16_t*)take((size_t)L_ * DS_ * 2);
    mp.PBt = (bf16_t*)take((size_t)64 * 256 * 512 * 2);
    mp.WyT = (bf16_t*)take((size_t)64 * 512 * 768 * 2);
    mp.A32 = (float*)take(64 * 2 * 64 * 2 * 4);
    mp.ypre = (bf16_t*)take((size_t)L_ * DS_ * 2);
    mp.ymix = (bf16_t*)take((size_t)L_ * D_ * 2);
    mp.ssq_na = (float*)take((size_t)L_ * 16 * 4);
    mp.ssq_ssm = (float*)take((size_t)L_ * 16 * 4);
    mp.x1g = (bf16_t*)take((size_t)L_ * D_ * 2);
    mp.ssq_x1 = (float*)take((size_t)L_ * 32 * 4);
    mp.wrT = (bf16_t*)take((size_t)2 * NE_ * D_ * 2);
    mp.aff_t = (float*)take((size_t)NE_ * L_ * 4);
    mp.rstd_x1 = (float*)take(L_ * 4);
    mp.idx = (int*)take(NE_ * CAP_ * 4);
    mp.gate = (float*)take(NE_ * CAP_ * 4);
    mp.slot_of = (int*)take((size_t)L_ * NE_ * 4);
    mp.ahist = (unsigned*)take((size_t)NE_ * 4096 * 4);
    mp.act = (bf16_t*)take((size_t)NE_ * CAP_ * FF_ * 2);
    mp.ye = (bf16_t*)take((size_t)NE_ * CAP_ * D_ * 2);
    mp.w_in_t = (bf16_t*)take((size_t)DIN_ * XN_LD * 2);
    mp.w_out_t = (bf16_t*)take((size_t)D_ * D_ * 2);
    mp.w_glu_t = (bf16_t*)take((size_t)DS_ * DS_ * 2);
    mp.w_gate_t = (bf16_t*)take((size_t)NE_ * D_ * FF_ * 2);
    mp.w_up_t = (bf16_t*)take((size_t)NE_ * D_ * FF_ * 2);
    mp.w_down_t = (bf16_t*)take((size_t)NE_ * D_ * FF_ * 2);
    { const int reps[14] = {REP0, REP1, REP2, REP3, REP4, REP5, REP6, REP7, REP8, REP9, REP10, 1, REP12, REP13}; for (int i = 0; i < 14; ++i) mp.rep[i] = reps[i]; }
    mp.bg = (grid == 256) ? 1 : 0;
    mp.never = 0; mp.pad = 0;
    (void)hipMemsetAsync(mp.bar, 0, XCD_BAR_WORDS * sizeof(unsigned), stream);
    void* args[] = {&mp};
    (void)hipLaunchCooperativeKernel((const void*)k_mega, dim3(grid), dim3(NT_), args, MK_LDS, stream);
}
```

```cpp
#include <hip/hip_runtime.h>
#include <math.h>
#include <stdint.h>

#define L_   8192
#define D_   2048
#define DIN_ 4096
#define DS_  1024
#define NG_  64
#define NP_  64
#define NE_  16
#define CAP_ 1024
#define FF_  2048

__device__ __forceinline__ float wave_sum(float v) {
#pragma unroll
    for (int o = 32; o >= 1; o >>= 1) v += __shfl_xor(v, o);
    return v;
}

#include <hip/hip_cooperative_groups.h>
namespace cg = cooperative_groups;
#define XB_TMO      128
#define XB_XCNT(j)  (256  + 64 * (j))
#define XB_XSUB(j)  (1280 + 64 * (j))
#define XB_XGEN(j)  (2304 + 64 * (j))
#define XB_TOP      3328
#define XB_TOPGEN   3392
#define XCD_BAR_WORDS 3456
#define XB_SPIN_CAP (1u << 18)
#define LAS __attribute__((address_space(3)))
__device__ __forceinline__ unsigned xb_ld(unsigned* p)              { return __hip_atomic_load(p, __ATOMIC_RELAXED, __HIP_MEMORY_SCOPE_AGENT); }
__device__ __forceinline__ unsigned xb_add(unsigned* p, unsigned v) { return __hip_atomic_fetch_add(p, v, __ATOMIC_RELAXED, __HIP_MEMORY_SCOPE_AGENT); }
__device__ __forceinline__ unsigned xb_xcc_id() { return (unsigned)__builtin_amdgcn_s_getreg((3 << 11) | 20) & 0xFu; }
#define XB_SPIN(cond, bar) do { unsigned _sp = 0; while (cond) { __builtin_amdgcn_s_sleep(1); \
    if ((++_sp & 255u) == 0u) { if (xb_ld(&(bar)[XB_TMO])) break; if (_sp > XB_SPIN_CAP) { atomicAdd(&(bar)[XB_TMO], 1u); break; } } } } while (0)
__device__ __forceinline__ void xcd_barrier_post(unsigned* bar, volatile LAS unsigned* st) {
    if (threadIdx.x == 0) { const unsigned x = xb_xcc_id(); const unsigned r = xb_add(&bar[XB_XCNT(x)], 1u); st[2] = x; st[3] = r; }
}
__device__ __forceinline__ void xcd_barrier_complete(unsigned* bar, unsigned x, unsigned& nloc, unsigned& nx) {
    const unsigned G = gridDim.x * gridDim.y * gridDim.z;
    unsigned sum, cnt, mine, sp = 0u;
    for (;;) {
        sum = 0u; cnt = 0u; mine = 0u;
#pragma unroll
        for (unsigned j = 0; j < 16; ++j) { const unsigned c = xb_ld(&bar[XB_XCNT(j)]); sum += c; cnt += (c > 0u) ? 1u : 0u; mine = (j == x) ? c : mine; }
        if (sum == G) break;
        __builtin_amdgcn_s_sleep(1);
        if ((++sp & 255u) == 0u) { if (xb_ld(&bar[XB_TMO])) break; if (sp > XB_SPIN_CAP) { atomicAdd(&bar[XB_TMO], 1u); break; } }
    }
    nloc = mine > 0u ? mine : 1u; nx = cnt > 0u ? cnt : 1u;
}
__device__ __forceinline__ void xcd_barrier(unsigned* bar, volatile LAS unsigned* st) {
    asm volatile("s_waitcnt vmcnt(0)" ::: "memory");
    __syncthreads();
    if (threadIdx.x == 0) {
        __builtin_amdgcn_s_waitcnt(0);
        const unsigned x = xb_xcc_id();
        unsigned nloc = st[0], nx = st[1];
        if (nloc == 0u) { xcd_barrier_complete(bar, x, nloc, nx); st[0] = nloc; st[1] = nx; }
        const unsigned old = xb_add(&bar[XB_XSUB(x)], 1u);
        const unsigned gen = old / nloc;
        if (old + 1u == (gen + 1u) * nloc) {
            __builtin_amdgcn_fence(__ATOMIC_RELEASE, "agent");
            asm volatile("s_waitcnt vmcnt(0)" ::: "memory");
            const unsigned og = xb_add(&bar[XB_TOP], 1u);
            const unsigned tg = og / nx;
            if (og + 1u == (tg + 1u) * nx) xb_add(&bar[XB_TOPGEN], 1u);
            else XB_SPIN(xb_ld(&bar[XB_TOPGEN]) == tg, bar);
            __builtin_amdgcn_fence(__ATOMIC_ACQUIRE, "agent");
            xb_add(&bar[XB_XGEN(x)], 1u);
            asm volatile("s_waitcnt vmcnt(0)" ::: "memory");
        } else {
            XB_SPIN(xb_ld(&bar[XB_XGEN(x)]) == gen, bar);
            __builtin_amdgcn_fence(__ATOMIC_ACQUIRE, "agent");
            asm volatile("s_waitcnt vmcnt(0)" ::: "memory");
        }
    }
    __syncthreads();
}

typedef short bf16x8 __attribute__((ext_vector_type(8)));
typedef float f32x4 __attribute__((ext_vector_type(4)));
typedef float f32x2 __attribute__((ext_vector_type(2)));
typedef __bf16 bf16x2v __attribute__((ext_vector_type(2)));
typedef unsigned short bf16_t;
typedef unsigned u32x4 __attribute__((ext_vector_type(4)));
#define NT_ 512
#define XN_LD (D_ + 64)
#define SM_MISC 0
#define SM_ROWS 1024
#define SM_GEMM 4096
#define SM_CV (SM_GEMM + 131072)
#define MK_LDS (152 * 1024)

__device__ __forceinline__ unsigned pk2(float lo, float hi) {
    f32x2 v = {lo, hi};
    return __builtin_bit_cast(unsigned, __builtin_convertvector(v, bf16x2v));
}
__device__ __forceinline__ float bf2f(bf16_t h) { return __uint_as_float(((unsigned)h) << 16); }
__device__ __forceinline__ float bflo(unsigned w) { return __uint_as_float(w << 16); }
__device__ __forceinline__ float bfhi(unsigned w) { return __uint_as_float(w & 0xffff0000u); }

struct MKParams {
    const float *x, *g_mix, *w_in;
    const float *a_re_f, *a_im_f, *ldt_f, *b_re_f, *b_im_f, *c_re_f, *c_im_f;
    const float *a_re_b, *a_im_b, *ldt_b, *b_re_b, *b_im_b, *c_re_b, *c_im_b;
    const float *ssm_d, *w_glu, *b_glu, *rpb, *g_ssm, *g_na, *w_out, *g_ffn, *w_router, *w_gate, *w_up, *w_down, *g_final;
    float* out;
    bf16_t* xn;
    float* rstd_x;
    bf16_t* ua;
    bf16_t* qb;
    bf16_t* kb;
    bf16_t* vT;
    bf16_t* PBt;
    bf16_t* WyT;
    float* A32;
    bf16_t* ypre;
    bf16_t* ymix;
    float* ssq_na;
    float* ssq_ssm;
    bf16_t* x1g;
    float* ssq_x1;
    bf16_t* wrT;
    float* aff_t;
    float* rstd_x1;
    int* idx;
    float* gate;
    int* slot_of;
    unsigned* ahist;
    bf16_t* act;
    bf16_t* ye;
    bf16_t* w_in_t;
    bf16_t* w_out_t;
    bf16_t* w_glu_t;
    bf16_t *w_gate_t, *w_up_t, *w_down_t;
    unsigned* bar;
    int bg;
    int rep[14];
    int never; int pad;
};

#define GAS __attribute__((address_space(1)))
__device__ __forceinline__ int opaque_tid() { int t = threadIdx.x; asm volatile("" : "+v"(t)); return t; }
template <class T> __device__ __forceinline__ const GAS T* uniform_ptr(const T* p) {
    const unsigned long long v = (unsigned long long)p;
    const unsigned lo = __builtin_amdgcn_readfirstlane((unsigned)v), hi = __builtin_amdgcn_readfirstlane((unsigned)(v >> 32));
    return (const GAS T*)(((unsigned long long)hi << 32) | lo);
}
__device__ __forceinline__ int tile_off(int row, int chunk) { return row * 128 + (((chunk ^ (row >> 1)) & 7) << 4); }

template <int MT, bool TR, int BMODE, class ALoad, class BLoad, class Mid, class Epi>
__device__ __forceinline__ void gemm_tile(unsigned char* smem, const ALoad& al, const BLoad& bl, int ldb, int nkt, const Mid& mid, const Epi& epi) {
    int tid_ = threadIdx.x; asm volatile("" : "+v"(tid_));
    const int tid = tid_, lane = tid & 63, wave = tid >> 6;
    const int wr = wave >> 2, wc = wave & 3, fr = lane & 15, fq = lane >> 4;
    constexpr int AR = MT / 2;
    const GAS bf16_t* const abase = uniform_ptr(al.ubase());
    unsigned aoff[AR];
#pragma unroll
    for (int i = 0; i < AR; ++i) {
        const int row = i * 64 + (tid >> 3);
        aoff[i] = al.row_off(row) + (unsigned)((((lane & 7) ^ (row >> 1)) & 7) << 3);
    }
    const int a_lds = __builtin_amdgcn_readfirstlane(wave * 1024);
    const int b_kg = lane & 7, b_n4 = ((wave << 3) | (lane >> 3)) << 2;
    const auto* const bbase = uniform_ptr(bl.ubase(__builtin_amdgcn_readfirstlane(wave)));
    unsigned boff = 0, boff16[4];
    if constexpr (BMODE == 0) { boff = bl.col_off(b_n4) + (unsigned)(b_kg * 8) * (unsigned)ldb; }
    else {
#pragma unroll
        for (int i = 0; i < 4; ++i) { const int row = i * 64 + (tid >> 3); boff16[i] = bl.row_off(row) + (unsigned)((((lane & 7) ^ (row >> 1)) & 7) << 3); }
    }
    unsigned char* const sA = smem + SM_GEMM;
    unsigned char* const sB = smem + SM_GEMM + 32768;
    const int key = (fr >> 1) & 7;
    const int c0 = ((fq ^ key) & 7) << 4, c1 = (((fq | 4) ^ key) & 7) << 4;
    const int a_frag = (wr * (MT * 16) + fr) * 128;
    const int b_frag = (wc * 64 + fr) * 128;

    f32x4 acc[MT][4];
#pragma unroll
    for (int m = 0; m < MT; ++m)
#pragma unroll
        for (int n = 0; n < 4; ++n) acc[m][n] = (f32x4){0.f, 0.f, 0.f, 0.f};

    f32x4 rb[8];
    __syncthreads();
#pragma unroll
    for (int i = 0; i < AR; ++i)
        __builtin_amdgcn_global_load_lds((const GAS unsigned*)(abase + aoff[i]), (__attribute__((address_space(3))) unsigned*)(sA + a_lds + i * 8192), 16, 0, 0);
    if constexpr (BMODE == 0) {
#pragma unroll
        for (int j = 0; j < 8; ++j) rb[j] = *(const GAS f32x4*)((const GAS float*)bbase + (size_t)j * ldb + boff);
        const float* f = (const float*)rb;
#pragma unroll
        for (int i = 0; i < 4; ++i) {
            uint4 w; w.x = pk2(f[0 * 4 + i], f[1 * 4 + i]); w.y = pk2(f[2 * 4 + i], f[3 * 4 + i]); w.z = pk2(f[4 * 4 + i], f[5 * 4 + i]); w.w = pk2(f[6 * 4 + i], f[7 * 4 + i]);
            *(uint4*)(sB + tile_off(b_n4 + i, b_kg)) = w;
        }
    } else {
#pragma unroll
        for (int i = 0; i < 4; ++i)
            __builtin_amdgcn_global_load_lds((const GAS unsigned*)((const GAS bf16_t*)bbase + boff16[i]), (__attribute__((address_space(3))) unsigned*)(sB + a_lds + i * 8192), 16, 0, 0);
    }
    __syncthreads();
    for (int kt = 0; kt < nkt; ++kt) {
        const int cur = (kt & 1) * 65536;
        const int nxt = cur ^ 65536;
        const bool more = (kt + 1 < nkt);
        if (more) {
#pragma unroll
            for (int i = 0; i < AR; ++i)
                __builtin_amdgcn_global_load_lds((const GAS unsigned*)(abase + (kt + 1) * 64 + aoff[i]), (__attribute__((address_space(3))) unsigned*)(sA + nxt + a_lds + i * 8192), 16, 0, 0);
            if constexpr (BMODE == 0) {
#pragma unroll
                for (int j = 0; j < 8; ++j) rb[j] = *(const GAS f32x4*)((const GAS float*)bbase + (size_t)((kt + 1) * 64 + j) * ldb + boff);
            } else {
#pragma unroll
                for (int i = 0; i < 4; ++i)
                    __builtin_amdgcn_global_load_lds((const GAS unsigned*)((const GAS bf16_t*)bbase + (kt + 1) * 64 + boff16[i]), (__attribute__((address_space(3))) unsigned*)(sB + nxt + a_lds + i * 8192), 16, 0, 0);
            }
        }
        mid(kt, acc, wr, fr, fq);
        constexpr int GQ = MT / 2, NG = 2 * GQ;
        bf16x8 bfr[4], af[2][2];
#pragma unroll
        for (int n = 0; n < 4; ++n) bfr[n] = *(const bf16x8*)(sB + cur + b_frag + n * 2048 + c0);
#pragma unroll
        for (int m = 0; m < 2; ++m) af[0][m] = *(const bf16x8*)(sA + cur + a_frag + m * 2048 + c0);
#pragma unroll
        for (int g = 0; g < NG; ++g) {
            const int ks = g / GQ, mq = g % GQ;
            if (g + 1 < NG) {
                const int ks1 = (g + 1) / GQ, mq1 = (g + 1) % GQ;
#pragma unroll
                for (int m = 0; m < 2; ++m) af[(g + 1) & 1][m] = *(const bf16x8*)(sA + cur + a_frag + (mq1 * 2 + m) * 2048 + (ks1 ? c1 : c0));
            }
#pragma unroll
            for (int m = 0; m < 2; ++m)
#pragma unroll
                for (int n = 0; n < 4; ++n)
                    acc[mq * 2 + m][n] = TR ? __builtin_amdgcn_mfma_f32_16x16x32_bf16(bfr[n], af[g & 1][m], acc[mq * 2 + m][n], 0, 0, 0)
                                            : __builtin_amdgcn_mfma_f32_16x16x32_bf16(af[g & 1][m], bfr[n], acc[mq * 2 + m][n], 0, 0, 0);
            if (g == GQ - 1) {
#pragma unroll
                for (int n = 0; n < 4; ++n) bfr[n] = *(const bf16x8*)(sB + cur + b_frag + n * 2048 + c1);
            }
            if (BMODE == 0 && g == NG - 2) {
                if (more) {
                    const float* f = (const float*)rb;
#pragma unroll
                    for (int i = 0; i < 4; ++i) {
                        uint4 w; w.x = pk2(f[0 * 4 + i], f[1 * 4 + i]); w.y = pk2(f[2 * 4 + i], f[3 * 4 + i]); w.z = pk2(f[4 * 4 + i], f[5 * 4 + i]); w.w = pk2(f[6 * 4 + i], f[7 * 4 + i]);
                        *(uint4*)(sB + nxt + tile_off(b_n4 + i, b_kg)) = w;
                    }
                }
            }
            __builtin_amdgcn_sched_barrier(0);
        }
        __syncthreads();
    }
    epi(acc, wr, wc, fr, fq);
}

struct NoMid { template <class ACC> __device__ __forceinline__ void operator()(int, ACC&, int, int, int) const {} };
struct ARows { const bf16_t* base; int lda; __device__ __forceinline__ const bf16_t* ubase() const { return base; } __device__ __forceinline__ unsigned row_off(int r) const { return (unsigned)r * (unsigned)lda; } };
struct BRows16 { const bf16_t* base; int ld; __device__ __forceinline__ const bf16_t* ubase(int) const { return base; } __device__ __forceinline__ unsigned row_off(int r) const { return (unsigned)r * (unsigned)ld; } };
struct BCols { const float* base; __device__ __forceinline__ const float* ubase(int) const { return base; } __device__ __forceinline__ unsigned col_off(int n4) const { return (unsigned)n4; } };

#define G8_HT 16384
__device__ __forceinline__ void g8_stage_rc(int b, int& R, int& C) { const int st = b / 1024, sb = b % 1024, swz = sb ^ (((sb >> 9) & 1) << 5); R = (st >> 1) * 16 + swz / 64; C = (st & 1) * 32 + (swz % 64) / 2; }
#define G8_WAIT_V(n) asm volatile("s_waitcnt vmcnt(" #n ")" ::: "memory")
#define G8_WAIT_L(n) asm volatile("s_waitcnt lgkmcnt(" #n ")" ::: "memory")
#define G8_BAR __builtin_amdgcn_s_barrier()
#define G8_SCHED __builtin_amdgcn_sched_barrier(0)

template <bool TR, class ALoad, class BLoad, class Mid, class Epi, class BG>
__device__ __forceinline__ void gemm8_tile(unsigned char* smem, const ALoad& al, const BLoad& bl, int nt, const Mid& mid, const Epi& epi, const BG& bg) {
    int tid_ = threadIdx.x; asm volatile("" : "+v"(tid_));
    const int tid = tid_, lane = tid & 63, wid = tid >> 6, wr = wid >> 2, wc = wid & 3, fr = lane & 15, fq = lane >> 4;
    unsigned char* const shm = smem + SM_GEMM;
    const GAS bf16_t* const abase = uniform_ptr(al.ubase());
    const GAS bf16_t* const bbase0 = uniform_ptr(bl.half_base(0));
    const GAS bf16_t* const bbase1 = uniform_ptr(bl.half_base(1));
    unsigned aoff[2][2], boff[2];
#pragma unroll
    for (int i = 0; i < 2; ++i) {
        int R, C; g8_stage_rc(tid * 16 + i * 8192, R, C);
        aoff[0][i] = al.row_off(R) + (unsigned)C; aoff[1][i] = al.row_off(128 + R) + (unsigned)C; boff[i] = bl.row_off(R) + (unsigned)C;
    }
    const int wlds = __builtin_amdgcn_readfirstlane(wid * 1024);
    const int lane_off = fr * 64 + ((fq * 16) ^ ((fr >> 3) << 5));
#define G8_SA(b, h) (shm + ((b) * 2 + (h)) * G8_HT)
#define G8_SB(b, h) (shm + (4 + (b) * 2 + (h)) * G8_HT)
#define G8_STAGE_A(b, h, kt) do { _Pragma("unroll") for (int _i = 0; _i < 2; ++_i) \
        __builtin_amdgcn_global_load_lds((const GAS unsigned*)(abase + (size_t)(kt) * 64 + aoff[h][_i]), (LAS unsigned*)(G8_SA(b, h) + wlds + _i * 8192), 16, 0, 0); } while (0)
#define G8_STAGE_B(b, h, kt) do { _Pragma("unroll") for (int _i = 0; _i < 2; ++_i) \
        __builtin_amdgcn_global_load_lds((const GAS unsigned*)(((h) ? bbase1 : bbase0) + (size_t)(kt) * 64 + boff[_i]), (LAS unsigned*)(G8_SB(b, h) + wlds + _i * 8192), 16, 0, 0); } while (0)
#define G8_LDA(dst, b, h) do { _Pragma("unroll") for (int _m = 0; _m < 4; ++_m) _Pragma("unroll") for (int _k = 0; _k < 2; ++_k) \
        dst[_m][_k] = *(const bf16x8*)(G8_SA(b, h) + ((wr * 4 + _m) * 2 + _k) * 1024 + lane_off); } while (0)
#define G8_LDB(dst, b, h) do { _Pragma("unroll") for (int _n = 0; _n < 2; ++_n) _Pragma("unroll") for (int _k = 0; _k < 2; ++_k) \
        dst[_n][_k] = *(const bf16x8*)(G8_SB(b, h) + ((wc * 2 + _n) * 2 + _k) * 1024 + lane_off); } while (0)
#define G8_MMA(ai, bj, AT, BT) do { __builtin_amdgcn_s_setprio(1); \
        _Pragma("unroll") for (int _m = 0; _m < 4; ++_m) _Pragma("unroll") for (int _n = 0; _n < 2; ++_n) _Pragma("unroll") for (int _k = 0; _k < 2; ++_k) \
            acc[ai][bj][_m][_n] = TR ? __builtin_amdgcn_mfma_f32_16x16x32_bf16(BT[_n][_k], AT[_m][_k], acc[ai][bj][_m][_n], 0, 0, 0) \
                                     : __builtin_amdgcn_mfma_f32_16x16x32_bf16(AT[_m][_k], BT[_n][_k], acc[ai][bj][_m][_n], 0, 0, 0); \
        __builtin_amdgcn_s_setprio(0); } while (0)

    f32x4 acc[2][2][4][2];
#pragma unroll
    for (int a = 0; a < 2; ++a)
#pragma unroll
        for (int b = 0; b < 2; ++b)
#pragma unroll
            for (int m = 0; m < 4; ++m)
#pragma unroll
                for (int n = 0; n < 2; ++n) acc[a][b][m][n] = (f32x4){0.f, 0.f, 0.f, 0.f};
    bf16x8 At[4][2], B0[2][2], B1[2][2];
    __syncthreads();
    if constexpr (BG::ON) bg.issue(0, smem, wid, lane);
    G8_STAGE_B(0, 0, 0); G8_STAGE_A(0, 0, 0); G8_STAGE_B(0, 1, 0); G8_STAGE_A(0, 1, 0);
    if (wr == 1) G8_BAR;
    G8_WAIT_V(4); G8_BAR;
    G8_STAGE_B(1, 0, 1); G8_STAGE_A(1, 0, 1); G8_STAGE_B(1, 1, 1);
    G8_WAIT_V(6); G8_BAR;
    for (int t = 0; t < nt - 2; t += 2) {
        mid(t, acc, wr, fr, fq);
        G8_LDB(B0, 0, 0); G8_SCHED; G8_LDA(At, 0, 0); G8_STAGE_A(1, 1, t + 1);
        G8_WAIT_L(8); G8_BAR; G8_WAIT_L(0); G8_MMA(0, 0, At, B0); G8_BAR; G8_SCHED;
        G8_LDB(B1, 0, 1); G8_STAGE_B(0, 0, t + 2);
        G8_BAR; G8_WAIT_L(0); G8_MMA(0, 1, At, B1); G8_BAR;
        G8_LDA(At, 0, 1); G8_STAGE_A(0, 0, t + 2);
        G8_BAR; G8_WAIT_L(0); G8_MMA(1, 0, At, B0); G8_BAR; G8_SCHED;
        G8_STAGE_B(0, 1, t + 2);
        G8_WAIT_V(6); G8_BAR;
        float bgv[8];
        if constexpr (BG::ON) bg.read(smem, wid, lane, bgv);
        G8_MMA(1, 1, At, B1);
        if constexpr (BG::ON) bg.store(t >> 1, wid, lane, bgv);
        G8_BAR;
        G8_LDB(B0, 1, 0); G8_SCHED; G8_LDA(At, 1, 0); G8_STAGE_A(0, 1, t + 2);
        G8_WAIT_L(8); G8_BAR; G8_WAIT_L(0); G8_MMA(0, 0, At, B0); G8_BAR; G8_SCHED;
        G8_LDB(B1, 1, 1); G8_STAGE_B(1, 0, t + 3);
        if constexpr (BG::ON) { const int nx = (t >> 1) + 1; bg.issue(nx < ((nt - 2) >> 1) ? nx : ((nt - 2) >> 1) - 1, smem, wid, lane); }
        G8_BAR; G8_WAIT_L(0); G8_MMA(0, 1, At, B1); G8_BAR;
        G8_LDA(At, 1, 1); G8_STAGE_A(1, 0, t + 3);
        G8_BAR; G8_WAIT_L(0); G8_MMA(1, 0, At, B0); G8_BAR; G8_SCHED;
        G8_STAGE_B(1, 1, t + 3);
        if constexpr (BG::ON) { G8_WAIT_V(8); } else { G8_WAIT_V(6); }
        G8_BAR; G8_MMA(1, 1, At, B1); G8_BAR;
    }
    { G8_LDB(B0, 0, 0); G8_LDA(At, 0, 0); G8_STAGE_A(1, 1, nt - 1);
      G8_BAR; G8_WAIT_L(0); G8_MMA(0, 0, At, B0); G8_BAR;
      G8_LDB(B1, 0, 1); G8_BAR; G8_WAIT_L(0); G8_MMA(0, 1, At, B1); G8_BAR;
      G8_LDA(At, 0, 1); G8_WAIT_V(4); G8_BAR; G8_WAIT_L(0);
      G8_MMA(1, 0, At, B0); G8_MMA(1, 1, At, B1); G8_BAR; }
    { G8_LDB(B0, 1, 0); G8_LDA(At, 1, 0); G8_WAIT_V(2); G8_BAR; G8_WAIT_L(0); G8_MMA(0, 0, At, B0); G8_BAR;
      G8_LDB(B1, 1, 1); G8_WAIT_V(0); G8_BAR; G8_WAIT_L(0); G8_MMA(0, 1, At, B1); G8_BAR;
      G8_LDA(At, 1, 1); G8_BAR; G8_WAIT_L(0); G8_MMA(1, 0, At, B0); G8_MMA(1, 1, At, B1); G8_BAR; }
    if (wr == 0) G8_BAR;
    epi(acc, wr, wc, fr, fq);
}
struct NoMid8 { template <class ACC> __device__ __forceinline__ void operator()(int, ACC&, int, int, int) const {} };
struct NoBg { static constexpr bool ON = false; };
struct BgConv {
    static constexpr bool ON = true;
    const float* src0; long src_step;
    bf16_t* dst0; long dst_step;
    int chunk0;
    __device__ __forceinline__ void issue(int i, unsigned char* smem, int wave, int lane) const {
        const int c = __builtin_amdgcn_readfirstlane(chunk0 + 256 * i), m = c >> 10, kt = (c >> 5) & 31, n64 = c & 31;
        const GAS float* s = uniform_ptr(src0 + (long)(m >> 4) * src_step + (size_t)(m & 15) * 2048 * 2048 + (size_t)(kt * 64) * 2048 + n64 * 64);
        const int wv = __builtin_amdgcn_readfirstlane(wave);
        const unsigned voff = (unsigned)((lane >> 4) * 2048 + (((lane & 15) ^ wv) & 15) * 4);
        const GAS float* s0 = s + (size_t)(wv * 8) * 2048;
        const GAS float* s1 = s + (size_t)(wv * 8 + 4) * 2048;
        __builtin_amdgcn_global_load_lds((const GAS unsigned*)(s0 + voff), (LAS unsigned*)(smem + SM_CV + wv * 2048), 16, 0, 0);
        __builtin_amdgcn_global_load_lds((const GAS unsigned*)(s1 + voff), (LAS unsigned*)(smem + SM_CV + wv * 2048 + 1024), 16, 0, 0);
    }
    __device__ __forceinline__ void read(unsigned char* smem, int wave, int lane, float (&v)[8]) const {
        asm volatile("" ::: "memory");
        const int kg = lane & 7, n = wave * 8 + (lane >> 3);
        const float* cv = (const float*)(smem + SM_CV + kg * 2048 + ((((n >> 2) ^ kg) & 15) * 4 + (n & 3)) * 4);
#pragma unroll
        for (int j = 0; j < 8; ++j) v[j] = cv[j * 64];
    }
    __device__ __forceinline__ void store(int i, int wave, int lane, const float (&v)[8]) const {
        const int c = __builtin_amdgcn_readfirstlane(chunk0 + 256 * i), m = c >> 10, kt = (c >> 5) & 31, n64 = c & 31;
        const int wv = __builtin_amdgcn_readfirstlane(wave);
        GAS bf16_t* d = (GAS bf16_t*)uniform_ptr(dst0 + (long)(m >> 4) * dst_step + (size_t)(m & 15) * 2048 * 2048 + (size_t)(n64 * 64 + wv * 8) * 2048 + kt * 64);
        u32x4 w; w[0] = pk2(v[0], v[1]); w[1] = pk2(v[2], v[3]); w[2] = pk2(v[4], v[5]); w[3] = pk2(v[6], v[7]);
        *(GAS u32x4*)(d + (unsigned)((lane >> 3) * 2048 + (lane & 7) * 8)) = w;
    }
};
struct BHalves { const bf16_t* h0; const bf16_t* h1; int ld;
    __device__ __forceinline__ const bf16_t* half_base(int h) const { return h ? h1 : h0; }
    __device__ __forceinline__ unsigned row_off(int r) const { return (unsigned)r * (unsigned)ld; } };

#define BG_GU0 (32768 - 45 * 256)
#define BG_DN1 (60 * 256)
struct ConvItem { const float* s; bf16_t* d; int N, ldd; };
#define CV_SMALL 6656
#define CV_DN0 (CV_SMALL)
#define CV_GU0 (CV_DN0 + 2 * (16384 - BG_DN1))
#define CV_END (CV_GU0 + 2 * BG_GU0)
__device__ __forceinline__ ConvItem conv_decode(const MKParams& p, int it, int lane) {
    const int kg = lane & 7, n4 = (lane >> 3) << 2;
    const float* src; bf16_t* dst; int N, ldd, r;
    if (it < 4096) { src = p.w_in; dst = p.w_in_t; N = DIN_; ldd = XN_LD; r = it; }
    else if (it < 6144) { src = p.w_out; dst = p.w_out_t; N = D_; ldd = D_; r = it - 4096; }
    else if (it < 6656) { src = p.w_glu; dst = p.w_glu_t; N = DS_; ldd = DS_; r = it - 6144; }
    else {
        int which, e, rc, sub;
        if (it < CV_GU0) { const int j = it - CV_DN0, d = BG_DN1 + (j >> 1); sub = j & 1; which = 2; e = d >> 10; rc = d & 1023; }
        else { const int j = it - CV_GU0, s = j >> 1; sub = j & 1; which = s >> 14; e = (s >> 10) & 15; rc = s & 1023; }
        r = (rc >> 5) * 64 + (rc & 31) * 2 + sub; N = 2048; ldd = 2048;
        const size_t eo = (size_t)e * D_ * FF_;
        src = (which == 0 ? p.w_gate : (which == 1 ? p.w_up : p.w_down)) + eo;
        dst = (which == 0 ? p.w_gate_t : (which == 1 ? p.w_up_t : p.w_down_t)) + eo;
    }
    const int nn32 = N >> 5, kt = r / nn32, nt = r % nn32;
    ConvItem c;
    c.s = src + (size_t)(kt * 64 + kg * 8) * N + nt * 32 + n4;
    c.d = dst + (size_t)(nt * 32 + n4) * ldd + kt * 64 + kg * 8;
    c.N = N; c.ldd = ldd;
    return c;
}
__device__ __forceinline__ void conv_load(const ConvItem& c, f32x4 (&r)[8]) {
#pragma unroll
    for (int j = 0; j < 8; ++j) r[j] = *(const f32x4*)(c.s + (size_t)j * c.N);
}
__device__ __forceinline__ void conv_store(const ConvItem& c, const f32x4 (&r)[8]) {
#pragma unroll
    for (int i = 0; i < 4; ++i) {
        uint4 w; w.x = pk2(r[0][i], r[1][i]); w.y = pk2(r[2][i], r[3][i]); w.z = pk2(r[4][i], r[5][i]); w.w = pk2(r[6][i], r[7][i]);
        *(uint4*)(c.d + (size_t)i * c.ldd) = w;
    }
}
__device__ __forceinline__ void conv_range(const MKParams& p, int lo, int hi, int gw, int NGW, int lane) {
    int it = lo + gw;
    if (it >= hi) return;
    f32x4 ra[8], rb[8];
    ConvItem ca = conv_decode(p, it, lane), cb = ca;
    conv_load(ca, ra);
    for (;;) {
        const int it2 = it + NGW;
        const bool has2 = it2 < hi;
        if (has2) { cb = conv_decode(p, it2, lane); conv_load(cb, rb); }
        conv_store(ca, ra);
        if (!has2) break;
        const int it3 = it2 + NGW;
        const bool has3 = it3 < hi;
        if (has3) { ca = conv_decode(p, it3, lane); conv_load(ca, ra); }
        conv_store(cb, rb);
        if (!has3) break;
        it = it3;
    }
}
#define CV_P3_END (CV_GU0 + BG_GU0 / 2)
#define CV_P4_END (CV_P3_END + BG_GU0)

template <bool TR>
struct EpiInProj8 {
    const MKParams& p; int m0, n0;
    __device__ __forceinline__ void operator()(f32x4 (&acc)[2][2][4][2], int wr, int wc, int fr, int fq) const {
#pragma unroll
        for (int ai = 0; ai < 2; ++ai)
#pragma unroll
            for (int m = 0; m < 4; ++m) {
                if (TR) {
                    const int token = m0 + ai * 128 + wr * 64 + m * 16 + fr;
                    const float rs = p.rstd_x[token];
#pragma unroll
                    for (int bj = 0; bj < 2; ++bj)
#pragma unroll
                        for (int n = 0; n < 2; ++n) {
                            const int col = n0 + bj * 128 + wc * 32 + n * 16 + fq * 4;
                            const f32x4 a = acc[ai][bj][m][n];
                            uint2 w;
                            if (n0 < 1024) {
                                w.x = pk2(a[0] * rs, a[1] * rs); w.y = pk2(a[2] * rs, a[3] * rs);
                                *(uint2*)(p.ua + ((size_t)(col >> 4) * 256 + (token >> 5)) * 768 + (token & 31) * 16 + (col & 15)) = w;
                            } else if (n0 < 2048) {
                                const float r8 = rs * 0.125f;
                                w.x = pk2(a[0] * r8, a[1] * r8); w.y = pk2(a[2] * r8, a[3] * r8);
                                *(uint2*)(p.qb + (size_t)token * 1024 + (col - 1024)) = w;
                            } else {
                                w.x = pk2(a[0] * rs, a[1] * rs); w.y = pk2(a[2] * rs, a[3] * rs);
                                *(uint2*)(p.kb + (size_t)token * 1024 + (col - 2048)) = w;
                            }
                        }
                } else {
                    const int token = m0 + ai * 128 + wr * 64 + m * 16 + fq * 4;
                    const float4 rs = *(const float4*)(p.rstd_x + token);
#pragma unroll
                    for (int bj = 0; bj < 2; ++bj)
#pragma unroll
                        for (int n = 0; n < 2; ++n) {
                            const int f = n0 - 3072 + bj * 128 + wc * 32 + n * 16 + fr;
                            const f32x4 a = acc[ai][bj][m][n];
                            uint2 w; w.x = pk2(a[0] * rs.x, a[1] * rs.y); w.y = pk2(a[2] * rs.z, a[3] * rs.w);
                            *(uint2*)(p.vT + (size_t)f * L_ + token) = w;
                        }
                }
            }
    }
};
struct MidOut8 {
    const float* rows;
    __device__ __forceinline__ void operator()(int t, f32x4 (&acc)[2][2][4][2], int wr, int fr, int fq) const {
        if (t == 16) {
#pragma unroll
            for (int ai = 0; ai < 2; ++ai)
#pragma unroll
                for (int m = 0; m < 4; ++m) {
                    const float ratio = rows[ai * 128 + wr * 64 + m * 16 + fr];
#pragma unroll
                    for (int bj = 0; bj < 2; ++bj)
#pragma unroll
                        for (int n = 0; n < 2; ++n) acc[ai][bj][m][n] *= ratio;
                }
        }
    }
};
struct EpiOut8 {
    const MKParams& p; const float* rows; int m0, n0, pn;
    __device__ __forceinline__ void operator()(f32x4 (&acc)[2][2][4][2], int wr, int wc, int fr, int fq) const {
#pragma unroll
        for (int ai = 0; ai < 2; ++ai)
#pragma unroll
            for (int m = 0; m < 4; ++m) {
                const int rt = ai * 128 + wr * 64 + m * 16 + fr, token = m0 + rt;
                const float rn = rows[256 + rt];
                float ss = 0.f;
#pragma unroll
                for (int bj = 0; bj < 2; ++bj)
#pragma unroll
                    for (int n = 0; n < 2; ++n) {
                        const int col = n0 + bj * 128 + wc * 32 + n * 16 + fq * 4;
                        const float4 xv = *(const float4*)(p.x + (size_t)token * D_ + col);
                        const float4 g = *(const float4*)(p.g_ffn + col);
                        const f32x4 a = acc[ai][bj][m][n];
                        const float v0 = xv.x + a[0] * rn, v1 = xv.y + a[1] * rn, v2 = xv.z + a[2] * rn, v3 = xv.w + a[3] * rn;
                        ss += v0 * v0 + v1 * v1 + v2 * v2 + v3 * v3;
                        uint2 w; w.x = pk2(v0 * g.x, v1 * g.y); w.y = pk2(v2 * g.z, v3 * g.w);
                        *(uint2*)(p.x1g + (size_t)token * D_ + col) = w;
                    }
                ss += __shfl_xor(ss, 16); ss += __shfl_xor(ss, 32);
                if (fq == 0) p.ssq_x1[token * 32 + pn * 4 + wc] = ss;
            }
    }
};
struct EpiMoe1_8 {
    const MKParams& p; int e, mt, nt;
    __device__ __forceinline__ void operator()(f32x4 (&acc)[2][2][4][2], int wr, int wc, int fr, int fq) const {
#pragma unroll
        for (int ai = 0; ai < 2; ++ai)
#pragma unroll
            for (int m = 0; m < 4; ++m) {
                const int slot = mt * 256 + ai * 128 + wr * 64 + m * 16 + fr;
                const float rs = p.rstd_x1[p.idx[e * CAP_ + slot]];
#pragma unroll
                for (int n = 0; n < 2; ++n) {
                    const f32x4 g = acc[ai][0][m][n] * rs, u = acc[ai][1][m][n] * rs;
                    float a[4];
#pragma unroll
                    for (int i = 0; i < 4; ++i) a[i] = g[i] / (1.f + __expf(-g[i])) * u[i];
                    uint2 w; w.x = pk2(a[0], a[1]); w.y = pk2(a[2], a[3]);
                    *(uint2*)(p.act + (size_t)(e * CAP_ + slot) * FF_ + nt * 128 + wc * 32 + n * 16 + fq * 4) = w;
                }
            }
    }
};
struct EpiMoe2_8 {
    const MKParams& p; int e, mt, nt;
    __device__ __forceinline__ void operator()(f32x4 (&acc)[2][2][4][2], int wr, int wc, int fr, int fq) const {
#pragma unroll
        for (int ai = 0; ai < 2; ++ai)
#pragma unroll
            for (int m = 0; m < 4; ++m) {
                const int slot = mt * 256 + ai * 128 + wr * 64 + m * 16 + fr;
                const float gt = p.gate[e * CAP_ + slot];
#pragma unroll
                for (int bj = 0; bj < 2; ++bj)
#pragma unroll
                    for (int n = 0; n < 2; ++n) {
                        const f32x4 a = acc[ai][bj][m][n] * gt;
                        uint2 w; w.x = pk2(a[0], a[1]); w.y = pk2(a[2], a[3]);
                        *(uint2*)(p.ye + (size_t)(e * CAP_ + slot) * D_ + nt * 256 + bj * 128 + wc * 32 + n * 16 + fq * 4) = w;
                    }
            }
    }
};

__device__ __forceinline__ void phase_prep(const MKParams& p, int gw, int NGW, int lane) {
    for (int row = gw; row < L_; row += NGW) {
        const float4* xr = (const float4*)(p.x + (size_t)row * D_);
        const float4* gr = (const float4*)p.g_mix;
        float s = 0.f;
        uint2* o = (uint2*)(p.xn + (size_t)row * XN_LD);
#pragma unroll
        for (int j = 0; j < 8; ++j) {
            const float4 v = xr[lane + 64 * j]; const float4 g = gr[lane + 64 * j];
            s += v.x * v.x + v.y * v.y + v.z * v.z + v.w * v.w;
            uint2 w; w.x = pk2(v.x * g.x, v.y * g.y); w.y = pk2(v.z * g.z, v.w * g.w);
            o[lane + 64 * j] = w;
        }
        s = wave_sum(s);
        if (lane == 0) p.rstd_x[row] = 1.0f / sqrtf(s * (1.0f / D_) + 1e-6f);
    }
    for (int i = gw * 64 + lane; i < NE_ * D_; i += NGW * 64) {
        const int e = i >> 11, n = i & (D_ - 1);
        const float w = p.w_router[n * NE_ + e];
        const unsigned hi = pk2(w, 0.f) & 0xffffu;
        const float rem = w - __uint_as_float(hi << 16);
        p.wrT[i] = (bf16_t)hi; p.wrT[NE_ * D_ + i] = (bf16_t)(pk2(rem, 0.f) & 0xffffu);
    }
}

__device__ __forceinline__ void phase_inproj(const MKParams& p, unsigned char* smem, int b) {
    for (int it = b; it < 512; it += gridDim.x) {
        const int xcd = it & 7, q = it >> 3;
        const int pn = (q & 1) * 8 + xcd;
        const int pm = q >> 1;
        const int m0 = pm * 256, n0 = pn * 256;
        ARows al{p.xn + (size_t)m0 * XN_LD, XN_LD};
        BHalves bl{p.w_in_t + (size_t)n0 * XN_LD, p.w_in_t + (size_t)(n0 + 128) * XN_LD, XN_LD};
        BgConv bg{p.w_gate, (long)(p.w_up - p.w_gate), p.w_gate_t, (long)(p.w_up_t - p.w_gate_t), BG_GU0 + (it >> 8) * 15 * 256 + (it & 255)};
        if (n0 < 3072) gemm8_tile<true>(smem, al, bl, D_ / 64, NoMid8{}, EpiInProj8<true>{p, m0, n0}, bg);
        else           gemm8_tile<false>(smem, al, bl, D_ / 64, NoMid8{}, EpiInProj8<false>{p, m0, n0}, bg);
    }
}

#define UA_LD 768
#define WSYNC() asm volatile("s_waitcnt lgkmcnt(0)" ::: "memory")
__device__ __forceinline__ void tw_sync(volatile LAS unsigned* cnt, unsigned& epoch, int lane) {
    WSYNC();
    if (lane == 0) __hip_atomic_fetch_add((LAS unsigned*)cnt, 1u, __ATOMIC_RELEASE, __HIP_MEMORY_SCOPE_WORKGROUP);
    ++epoch;
    while (__hip_atomic_load((LAS unsigned*)cnt, __ATOMIC_ACQUIRE, __HIP_MEMORY_SCOPE_WORKGROUP) < 4u * epoch) __builtin_amdgcn_s_sleep(1);
    asm volatile("" ::: "memory");
}
__device__ __forceinline__ void ssm_tables(const MKParams& p, unsigned char* smem, int g, int part, int tw, int lane, volatile LAS unsigned* cnt, unsigned& epoch) {
    float2* apow = (float2*)(smem + SM_GEMM);
    float2* bbar = apow + 2 * 33 * 64;
    float2* cc = bbar + 2 * 64 * 16;
    float* taps = (float*)(cc + 2 * 16 * 64);
    if (tw < 2) {
        const int d = tw;
        const int pp = lane;
        const float lr = (d ? p.a_re_b : p.a_re_f)[g * 64 + pp], li = (d ? p.a_im_b : p.a_im_f)[g * 64 + pp];
        const float dt = expf((d ? p.ldt_b : p.ldt_f)[g]);
        const float x = lr * dt, y = li * dt;
        const float ex = expf(x), cy = cosf(y), sy = sinf(y), sh = sinf(0.5f * y);
        const float ar = ex * cy, ai = ex * sy;
        float sr = 1.f, si = 0.f;
        for (int t = 0; t <= 32; ++t) {
            apow[(d * 33 + t) * 64 + pp] = make_float2(sr, si);
            const float nr = sr * ar - si * ai, ni = sr * ai + si * ar; sr = nr; si = ni;
        }
        if (part == 0) *(float2*)(p.A32 + ((size_t)(g * 2 + d) * 64 + pp) * 2) = apow[(d * 33 + 32) * 64 + pp];
        const float nr = expm1f(x) * cy - 2.f * sh * sh, ni = ex * sy;
        const float den = lr * lr + li * li;
        const float fr_ = (nr * lr + ni * li) / den, fi_ = (ni * lr - nr * li) / den;
        const float* brp = (d ? p.b_re_b : p.b_re_f) + (g * 64 + pp) * 16;
        const float* bip = (d ? p.b_im_b : p.b_im_f) + (g * 64 + pp) * 16;
#pragma unroll
        for (int q4 = 0; q4 < 4; ++q4) {
            const float4 br = *(const float4*)(brp + q4 * 4), bi = *(const float4*)(bip + q4 * 4);
            float2* o = bbar + (d * 64 + pp) * 16 + q4 * 4;
            o[0] = make_float2(fr_ * br.x - fi_ * bi.x, fr_ * bi.x + fi_ * br.x);
            o[1] = make_float2(fr_ * br.y - fi_ * bi.y, fr_ * bi.y + fi_ * br.y);
            o[2] = make_float2(fr_ * br.z - fi_ * bi.z, fr_ * bi.z + fi_ * br.z);
            o[3] = make_float2(fr_ * br.w - fi_ * bi.w, fr_ * bi.w + fi_ * br.w);
        }
        const float* crp = (d ? p.c_re_b : p.c_re_f) + (g * 16) * 64 + pp;
        const float* cip = (d ? p.c_im_b : p.c_im_f) + (g * 16) * 64 + pp;
#pragma unroll
        for (int co = 0; co < 16; ++co) cc[(d * 16 + co) * 64 + pp] = make_float2(crp[co * 64], cip[co * 64]);
    }
    tw_sync(cnt, epoch, lane);
    {
        const int li_ = lane & 15, lk = lane >> 4;
#pragma unroll 1
        for (int co = tw * 4; co < tw * 4 + 4; ++co) {
#pragma unroll 1
            for (int d = 0; d < 2; ++d) {
                f32x4 acc0 = (f32x4){0.f, 0.f, 0.f, 0.f}, acc1 = acc0;
#pragma unroll 4
                for (int s = 0; s < 32; ++s) {
                    const int q = 2 * s + (lk >> 1), ri = lk & 1;
                    const float2 c = cc[(d * 16 + co) * 64 + q], bb = bbar[(d * 64 + q) * 16 + li_];
                    const float gb = ri ? -(c.x * bb.y + c.y * bb.x) : (c.x * bb.x - c.y * bb.y);
                    const float2 a0 = apow[(d * 33 + li_) * 64 + q], a1 = apow[(d * 33 + 16 + li_) * 64 + q];
                    acc0 = __builtin_amdgcn_mfma_f32_16x16x4f32(ri ? a0.y : a0.x, gb, acc0, 0, 0, 0);
                    acc1 = __builtin_amdgcn_mfma_f32_16x16x4f32(ri ? a1.y : a1.x, gb, acc1, 0, 0, 0);
                }
#pragma unroll
                for (int r = 0; r < 4; ++r) {
                    const int t0 = 4 * lk + r, t1 = 16 + 4 * lk + r;
                    float* p0 = taps + ((d ? 31 - t0 : 31 + t0) * 16 + co) * 16 + li_;
                    float* p1 = taps + ((d ? 31 - t1 : 31 + t1) * 16 + co) * 16 + li_;
                    if (d == 1 && t0 == 0) *p0 += acc0[r]; else *p0 = acc0[r];
                    *p1 = acc1[r];
                }
            }
        }
    }
    tw_sync(cnt, epoch, lane);
#pragma unroll 1
    for (int it = lane; it < 32 * 96; it += 64) {
        const int n = part * 128 + tw * 32 + it / 96, k = (it % 96) * 8;
        const int l = n >> 4, co = n & 15;
        float v[8];
        if (k < 512) {
            const int j = k >> 4, ci0 = ((k >> 3) & 1) * 8;
            const float* tp = taps + ((l - j + 31) * 16 + co) * 16 + ci0;
#pragma unroll
            for (int q = 0; q < 8; ++q) v[q] = tp[q];
        } else {
            const int k2 = k - 512, d = k2 >> 7, pp0 = (k2 >> 1) & 63;
            const int t = d ? (32 - l) : (l + 1);
#pragma unroll
            for (int q = 0; q < 4; ++q) {
                const float2 a = apow[(d * 33 + t) * 64 + pp0 + q], c = cc[(d * 16 + co) * 64 + pp0 + q];
                v[2 * q] = c.x * a.x - c.y * a.y; v[2 * q + 1] = -(c.x * a.y + c.y * a.x);
            }
        }
        uint4 w; w.x = pk2(v[0], v[1]); w.y = pk2(v[2], v[3]); w.z = pk2(v[4], v[5]); w.w = pk2(v[6], v[7]);
        *(uint4*)(p.WyT + ((size_t)g * 512 + n) * UA_LD + k) = w;
    }
#pragma unroll 1
    for (int it = lane; it < 16 * 64; it += 64) {
        const int n2 = part * 64 + tw * 16 + (it >> 6), kc = it & 63;
        const int d = n2 >> 7, pp = (n2 >> 1) & 63, ri = n2 & 1, j = kc >> 1, half = kc & 1;
        const int t = d ? j : 31 - j;
        const float2 a = apow[(d * 33 + t) * 64 + pp];
        const float2* bp = bbar + (d * 64 + pp) * 16 + half * 8;
        float v[8];
#pragma unroll
        for (int q = 0; q < 8; ++q) { const float2 b = bp[q]; v[q] = ri ? (a.x * b.y + a.y * b.x) : (a.x * b.x - a.y * b.y); }
        uint4 w; w.x = pk2(v[0], v[1]); w.y = pk2(v[2], v[3]); w.z = pk2(v[4], v[5]); w.w = pk2(v[6], v[7]);
        *(uint4*)(p.PBt + ((size_t)g * 256 + n2) * 512 + kc * 8) = w;
    }
    tw_sync(cnt, epoch, lane);
}

#define SE_PITCH 132
struct EpiSsmE {
    const MKParams& p; unsigned char* smem; int g;
    __device__ __forceinline__ void operator()(f32x4 (&acc)[2][2][4][2], int wr, int wc, int fr, int fq) const {
        float* E = (float*)(smem + SM_GEMM);
        const int tid = opaque_tid();
#pragma unroll
        for (int d = 0; d < 2; ++d) {
            __syncthreads();
#pragma unroll
            for (int ai = 0; ai < 2; ++ai)
#pragma unroll
                for (int m = 0; m < 4; ++m)
#pragma unroll
                    for (int n = 0; n < 2; ++n)
                        *(f32x4*)(E + (ai * 128 + wr * 64 + m * 16 + fr) * SE_PITCH + wc * 32 + n * 16 + fq * 4) = acc[ai][d][m][n];
            __syncthreads();
            if (tid < 64) {
                const int pp = tid;
                const float2 A = *(const float2*)(p.A32 + ((size_t)(g * 2 + d) * 64 + pp) * 2);
                bf16_t* sdst = p.ua + (size_t)g * 256 * UA_LD + 512 + d * 128 + pp * 2;
                float sr = 0.f, si = 0.f;
#pragma unroll 8
                for (int s = 0; s < 256; ++s) {
                    const int c = d ? (255 - s) : s;
                    const float2 e = *(const float2*)(E + c * SE_PITCH + pp * 2);
                    *(unsigned*)(sdst + (size_t)c * UA_LD) = pk2(sr, si);
                    const float nr = A.x * sr - A.y * si + e.x, ni = A.x * si + A.y * sr + e.y;
                    sr = nr; si = ni;
                }
            }
        }
    }
};
__device__ __forceinline__ void ssm_e_item(const MKParams& p, unsigned char* smem, int g) {
    ARows al{p.ua + (size_t)g * 256 * UA_LD, UA_LD};
    BHalves bl{p.PBt + (size_t)g * 256 * 512, p.PBt + ((size_t)g * 256 + 128) * 512, 512};
    gemm8_tile<true>(smem, al, bl, 8, NoMid8{}, EpiSsmE{p, smem, g}, NoBg{});
}

__device__ __forceinline__ float gelu_tanh_f(float x) {
    const float k0 = 0.7978845608028654f, k1 = 0.044715f;
    const float z = k0 * (x + k1 * x * x * x);
    const float e = __expf(2.f * z);
    return 0.5f * x * (2.f - 2.f / (1.f + e));
}
struct EpiSsmY {
    const MKParams& p; int g, nh;
    __device__ __forceinline__ void operator()(f32x4 (&acc)[2][2][4][2], int wr, int wc, int fr, int fq) const {
        const float4 dsk = *(const float4*)(p.ssm_d + g * 16 + fq * 4);
#pragma unroll
        for (int ai = 0; ai < 2; ++ai)
#pragma unroll
            for (int m = 0; m < 4; ++m) {
                const int c = ai * 128 + wr * 64 + m * 16 + fr;
                const bf16_t* urow = p.ua + ((size_t)g * 256 + c) * UA_LD + fq * 4;
#pragma unroll
                for (int bj = 0; bj < 2; ++bj)
#pragma unroll
                    for (int n = 0; n < 2; ++n) {
                        const int l = nh * 16 + bj * 8 + wc * 2 + n;
                        const uint2 uu = *(const uint2*)(urow + l * 16);
                        const f32x4 a = acc[ai][bj][m][n];
                        const float y0 = gelu_tanh_f(a[0] + dsk.x * bflo(uu.x)), y1 = gelu_tanh_f(a[1] + dsk.y * bfhi(uu.x));
                        const float y2 = gelu_tanh_f(a[2] + dsk.z * bflo(uu.y)), y3 = gelu_tanh_f(a[3] + dsk.w * bfhi(uu.y));
                        uint2 w; w.x = pk2(y0, y1); w.y = pk2(y2, y3);
                        *(uint2*)(p.ypre + (size_t)(c * 32 + l) * DS_ + g * 16 + fq * 4) = w;
                    }
            }
    }
};
__device__ __forceinline__ void ssm_y_item(const MKParams& p, unsigned char* smem, int g, int nh) {
    ARows al{p.ua + (size_t)g * 256 * UA_LD, UA_LD};
    BHalves bl{p.WyT + ((size_t)g * 512 + nh * 256) * UA_LD, p.WyT + ((size_t)g * 512 + nh * 256 + 128) * UA_LD, UA_LD};
    gemm8_tile<true>(smem, al, bl, 12, NoMid8{}, EpiSsmY{p, g, nh}, NoBg{});
}

#define NA_RPB (SM_GEMM + 1024)
__device__ __forceinline__ void na_item(const MKParams& p, unsigned char* smem, int r, int hq) {
    int tid_ = threadIdx.x; asm volatile("" : "+v"(tid_));
    const int tid = tid_, lane = tid & 63, wave = tid >> 6, fr = lane & 15, fq = lane >> 4;
    const int h = hq * 4 + (wave >> 1), qh = wave & 1;
    int rs = r - 4; rs = rs < 0 ? 0 : (rs > 120 ? 120 : rs);
    bf16x8 qf[2][2];
#pragma unroll
    for (int qb = 0; qb < 2; ++qb)
#pragma unroll
        for (int ks = 0; ks < 2; ++ks) qf[qb][ks] = *(const bf16x8*)(p.qb + (size_t)(r * 64 + (2 * qh + qb) * 16 + fr) * 1024 + h * 64 + ks * 32 + fq * 8);
    int kbq[2], dxq[2];
#pragma unroll
    for (int qb = 0; qb < 2; ++qb) {
        const int c = (2 * qh + qb) * 16 + fr;
        int cs = c - 8; cs = cs < 0 ? 0 : (cs > 48 ? 48 : cs);
        kbq[qb] = 8 * fq - cs;
        dxq[qb] = (8 * fq - c + 15) * 4;
    }
    f32x4 o[2][4];
    float mrow[2], lrow[2];
#pragma unroll
    for (int qb = 0; qb < 2; ++qb) {
        mrow[qb] = -1e30f; lrow[qb] = 0.f;
#pragma unroll
        for (int mt = 0; mt < 4; ++mt) o[qb][mt] = (f32x4){0.f, 0.f, 0.f, 0.f};
    }
    const int krow_lane = (8 * (fr >> 2) + (fr & 3)) * 1024 + h * 64 + fq * 8;
    const size_t v_lane = (size_t)(h * 64 + fr) * L_ + 8 * fq;
    bf16x8 kf[2][2][2], vf[2][4];
    {
        const bf16_t* kbase = p.kb + (size_t)(rs * 64) * 1024 + krow_lane;
#pragma unroll
        for (int P = 0; P < 2; ++P)
#pragma unroll
            for (int sx = 0; sx < 2; ++sx)
#pragma unroll
                for (int ks = 0; ks < 2; ++ks) kf[P][sx][ks] = *(const bf16x8*)(kbase + (32 * P + 4 * sx) * 1024 + ks * 32);
#pragma unroll
        for (int P = 0; P < 2; ++P)
#pragma unroll
            for (int mt = 0; mt < 4; ++mt) vf[P][mt] = *(const bf16x8*)(p.vT + v_lane + (size_t)mt * 16 * L_ + rs * 64 + 32 * P);
    }
#pragma unroll 1
    for (int i = 0; i < 8; ++i) {
        const int inx = i < 7 ? i + 1 : 7;
        const int tokn = (rs + inx) * 64;
        const unsigned char* brow = smem + NA_RPB + ((h * 15 + (rs + i - r + 7)) * 31) * 4;
        f32x4 s[2][2][2];
#pragma unroll
        for (int P = 0; P < 2; ++P)
#pragma unroll
            for (int sx = 0; sx < 2; ++sx)
#pragma unroll
                for (int qb = 0; qb < 2; ++qb) {
                    f32x4 a = (f32x4){0.f, 0.f, 0.f, 0.f};
                    a = __builtin_amdgcn_mfma_f32_16x16x32_bf16(kf[P][sx][0], qf[qb][0], a, 0, 0, 0);
                    a = __builtin_amdgcn_mfma_f32_16x16x32_bf16(kf[P][sx][1], qf[qb][1], a, 0, 0, 0);
                    s[P][sx][qb] = a;
                }
        {
            const bf16_t* kbase = p.kb + (size_t)tokn * 1024 + krow_lane;
#pragma unroll
            for (int P = 0; P < 2; ++P)
#pragma unroll
                for (int sx = 0; sx < 2; ++sx)
#pragma unroll
                    for (int ks = 0; ks < 2; ++ks) kf[P][sx][ks] = *(const bf16x8*)(kbase + (32 * P + 4 * sx) * 1024 + ks * 32);
        }
        unsigned pp[2][2][4];
#pragma unroll
        for (int qb = 0; qb < 2; ++qb) {
            const unsigned char* bq = brow + dxq[qb];
            float bv[16];
#pragma unroll
            for (int c16 = 0; c16 < 16; ++c16) bv[c16] = *(const float*)(bq + (32 * (c16 >> 3) + 4 * ((c16 >> 2) & 1) + (c16 & 3)) * 4);
            asm volatile("" : "+v"(bv[0]), "+v"(bv[1]), "+v"(bv[2]), "+v"(bv[3]), "+v"(bv[4]), "+v"(bv[5]), "+v"(bv[6]), "+v"(bv[7]),
                              "+v"(bv[8]), "+v"(bv[9]), "+v"(bv[10]), "+v"(bv[11]), "+v"(bv[12]), "+v"(bv[13]), "+v"(bv[14]), "+v"(bv[15]));
            float mx = -1e30f;
#pragma unroll
            for (int P = 0; P < 2; ++P)
#pragma unroll
                for (int sx = 0; sx < 2; ++sx)
#pragma unroll
                    for (int rg = 0; rg < 4; ++rg) {
                        const int cst = 32 * P + 4 * sx + rg;
                        const bool valid = (unsigned)(cst + kbq[qb]) < 16u;
                        const float v = valid ? (s[P][sx][qb][rg] + bv[P * 8 + sx * 4 + rg]) : -1e30f;
                        s[P][sx][qb][rg] = v;
                        mx = fmaxf(mx, v);
                    }
            mx = fmaxf(mx, __shfl_xor(mx, 16));
            mx = fmaxf(mx, __shfl_xor(mx, 32));
            const float mn = fmaxf(mrow[qb], mx);
            const float alpha = __expf(mrow[qb] - mn);
            mrow[qb] = mn;
            float ls = 0.f;
#pragma unroll
            for (int P = 0; P < 2; ++P)
#pragma unroll
                for (int sx = 0; sx < 2; ++sx) {
                    float e[4];
#pragma unroll
                    for (int rg = 0; rg < 4; ++rg) { e[rg] = __expf(s[P][sx][qb][rg] - mn); ls += e[rg]; }
                    pp[qb][P][sx * 2 + 0] = pk2(e[0], e[1]);
                    pp[qb][P][sx * 2 + 1] = pk2(e[2], e[3]);
                }
            lrow[qb] = lrow[qb] * alpha + ls;
#pragma unroll
            for (int mt = 0; mt < 4; ++mt) o[qb][mt] *= alpha;
        }
#pragma unroll
        for (int P = 0; P < 2; ++P)
#pragma unroll
            for (int mt = 0; mt < 4; ++mt)
#pragma unroll
                for (int qb = 0; qb < 2; ++qb) {
                    uint4 w; w.x = pp[qb][P][0]; w.y = pp[qb][P][1]; w.z = pp[qb][P][2]; w.w = pp[qb][P][3];
                    o[qb][mt] = __builtin_amdgcn_mfma_f32_16x16x32_bf16(vf[P][mt], __builtin_bit_cast(bf16x8, w), o[qb][mt], 0, 0, 0);
                }
#pragma unroll
        for (int P = 0; P < 2; ++P)
#pragma unroll
            for (int mt = 0; mt < 4; ++mt) vf[P][mt] = *(const bf16x8*)(p.vT + v_lane + (size_t)mt * 16 * L_ + tokn + 32 * P);
    }
#pragma unroll
    for (int qb = 0; qb < 2; ++qb) {
        float l = lrow[qb];
        l += __shfl_xor(l, 16); l += __shfl_xor(l, 32);
        const float inv = 1.f / l;
        const int token = r * 64 + (2 * qh + qb) * 16 + fr;
        float ss = 0.f;
#pragma unroll
        for (int mt = 0; mt < 4; ++mt) {
            const float4 g = *(const float4*)(p.g_na + h * 64 + mt * 16 + 4 * fq);
            const f32x4 v = o[qb][mt] * inv;
            ss += v[0] * v[0] + v[1] * v[1] + v[2] * v[2] + v[3] * v[3];
            uint2 w; w.x = pk2(v[0] * g.x, v[1] * g.y); w.y = pk2(v[2] * g.z, v[3] * g.w);
            *(uint2*)(p.ymix + (size_t)token * D_ + DS_ + h * 64 + mt * 16 + 4 * fq) = w;
        }
        ss += __shfl_xor(ss, 16); ss += __shfl_xor(ss, 32);
        if (fq == 0) p.ssq_na[token * 16 + h] = ss;
    }
}
#define NA_ITEMS 512
__device__ __forceinline__ void phase2(const MKParams& p, unsigned char* smem, int b, int G, unsigned* counter) {
    for (int it = b; it < 64; it += G) ssm_e_item(p, smem, it);
    __syncthreads();
    const int tq = opaque_tid();
    { float* dst = (float*)(smem + NA_RPB); for (int i = tq; i < 16 * 15 * 31; i += NT_) dst[i] = p.rpb[i]; }
    volatile LAS int* slot = (volatile LAS int*)(smem + 32);
    for (;;) {
        __syncthreads();
        if (tq == 0) *slot = (int)__hip_atomic_fetch_add(counter, 1u, __ATOMIC_RELAXED, __HIP_MEMORY_SCOPE_AGENT);
        __syncthreads();
        const int j = *slot;
        if (j >= NA_ITEMS) break;
        na_item(p, smem, j >> 2, j & 3);
    }
}

struct EpiGlu8 {
    const MKParams& p; int m0, n0, pn;
    __device__ __forceinline__ void operator()(f32x4 (&acc)[2][2][4][2], int wr, int wc, int fr, int fq) const {
#pragma unroll
        for (int ai = 0; ai < 2; ++ai)
#pragma unroll
            for (int m = 0; m < 4; ++m) {
                const int token = m0 + ai * 128 + wr * 64 + m * 16 + fr;
                float ss = 0.f;
#pragma unroll
                for (int bj = 0; bj < 2; ++bj)
#pragma unroll
                    for (int n = 0; n < 2; ++n) {
                        const int col = n0 + bj * 128 + wc * 32 + n * 16 + fq * 4;
                        const float4 b = *(const float4*)(p.b_glu + col);
                        const float4 g = *(const float4*)(p.g_ssm + col);
                        const uint2 yy = *(const uint2*)(p.ypre + (size_t)token * DS_ + col);
                        const f32x4 a = acc[ai][bj][m][n];
                        const float y0 = bflo(yy.x) / (1.f + __expf(-(a[0] + b.x))), y1 = bfhi(yy.x) / (1.f + __expf(-(a[1] + b.y)));
                        const float y2 = bflo(yy.y) / (1.f + __expf(-(a[2] + b.z))), y3 = bfhi(yy.y) / (1.f + __expf(-(a[3] + b.w)));
                        ss += y0 * y0 + y1 * y1 + y2 * y2 + y3 * y3;
                        uint2 w; w.x = pk2(y0 * g.x, y1 * g.y); w.y = pk2(y2 * g.z, y3 * g.w);
                        *(uint2*)(p.ymix + (size_t)token * D_ + col) = w;
                    }
                ss += __shfl_xor(ss, 16); ss += __shfl_xor(ss, 32);
                if (fq == 0) p.ssq_ssm[token * 16 + pn * 4 + wc] = ss;
            }
    }
};
__device__ __forceinline__ void glu_item(const MKParams& p, unsigned char* smem, int it) {
    const int pn = it & 3, pm = it >> 2;
    const int m0 = pm * 256, n0 = pn * 256;
    ARows al{p.ypre + (size_t)m0 * DS_, DS_};
    BHalves bl{p.w_glu_t + (size_t)n0 * DS_, p.w_glu_t + (size_t)(n0 + 128) * DS_, DS_};
    gemm8_tile<true>(smem, al, bl, DS_ / 64, NoMid8{}, EpiGlu8{p, m0, n0, pn}, NoBg{});
}

__device__ __forceinline__ float rstd16(const float* part) {
    const float4 a = ((const float4*)part)[0], b = ((const float4*)part)[1], c = ((const float4*)part)[2], d = ((const float4*)part)[3];
    const float s = ((a.x + a.y) + (a.z + a.w)) + ((b.x + b.y) + (b.z + b.w)) + ((c.x + c.y) + (c.z + c.w)) + ((d.x + d.y) + (d.z + d.w));
    return 1.0f / sqrtf(s * (1.0f / DS_) + 1e-6f);
}
struct MidOut {
    const float* rows;
    __device__ __forceinline__ void operator()(int kt, f32x4 (&acc)[8][4], int wr, int fr, int fq) const {
        if (kt == 16) {
#pragma unroll
            for (int m = 0; m < 8; ++m) {
                const float ratio = rows[wr * 128 + m * 16 + fr];
#pragma unroll
                for (int nn = 0; nn < 4; ++nn) acc[m][nn] *= ratio;
            }
        }
    }
};
struct EpiOut {
    const MKParams& p; const float* rows; int m0, n0, pn;
    __device__ __forceinline__ void operator()(f32x4 (&acc)[8][4], int wr, int wc, int fr, int fq) const {
#pragma unroll
        for (int m = 0; m < 8; ++m) {
            const int token = m0 + wr * 128 + m * 16 + fr;
            const float rn = rows[256 + wr * 128 + m * 16 + fr];
            float ss = 0.f;
#pragma unroll
            for (int nn = 0; nn < 4; ++nn) {
                const int col = n0 + wc * 64 + nn * 16 + fq * 4;
                const float4 xv = *(const float4*)(p.x + (size_t)token * D_ + col);
                const float4 g = *(const float4*)(p.g_ffn + col);
                const f32x4 a = acc[m][nn];
                const float v0 = xv.x + a[0] * rn, v1 = xv.y + a[1] * rn, v2 = xv.z + a[2] * rn, v3 = xv.w + a[3] * rn;
                ss += v0 * v0 + v1 * v1 + v2 * v2 + v3 * v3;
                uint2 w; w.x = pk2(v0 * g.x, v1 * g.y); w.y = pk2(v2 * g.z, v3 * g.w);
                *(uint2*)(p.x1g + (size_t)token * D_ + col) = w;
            }
            ss += __shfl_xor(ss, 16); ss += __shfl_xor(ss, 32);
            if (fq == 0) p.ssq_x1[token * 32 + pn * 4 + wc] = ss;
        }
    }
};
__device__ __forceinline__ void outproj_item(const MKParams& p, unsigned char* smem, int it) {
    const int pn = it & 7, pm = it >> 3;
    const int m0 = pm * 256, n0 = pn * 256;
    float* rows = (float*)(smem + SM_ROWS);
    __syncthreads();
    const int tq = opaque_tid();
    if (tq < 256) {
        const int token = m0 + tq;
        const float rs = rstd16(p.ssq_ssm + token * 16), rn = rstd16(p.ssq_na + token * 16);
        rows[tq] = rs / rn; rows[256 + tq] = rn;
    }
    ARows al{p.ymix + (size_t)m0 * D_, D_};
    BHalves bl{p.w_out_t + (size_t)n0 * D_, p.w_out_t + (size_t)(n0 + 128) * D_, D_};
    BgConv bg{p.w_gate, (long)(p.w_up - p.w_gate), p.w_gate_t, (long)(p.w_up_t - p.w_gate_t), BG_GU0 + 30 * 256 + it};
    gemm8_tile<true>(smem, al, bl, D_ / 64, MidOut8{rows}, EpiOut8{p, rows, m0, n0, pn}, bg);
}

#define RT_PART (SM_GEMM)
__device__ __forceinline__ void router_item(const MKParams& p, unsigned char* smem, int item) {
    const int tid = opaque_tid(), lane = tid & 63, wave = tid >> 6, fr = lane & 15, fq = lane >> 4;
    const int tile = item * 2 + (wave >> 2), kq = wave & 3;
    const int token = tile * 16 + fr;
    const bf16_t* xr = p.x1g + (size_t)token * D_ + kq * 512 + fq * 8;
    const bf16_t* wh = p.wrT + (size_t)fr * D_ + kq * 512 + fq * 8;
    const bf16_t* wl = wh + 16 * D_;
    f32x4 ah = (f32x4){0.f, 0.f, 0.f, 0.f}, alo = (f32x4){0.f, 0.f, 0.f, 0.f};
#pragma unroll 8
    for (int k = 0; k < 512; k += 32) {
        const bf16x8 xb = *(const bf16x8*)(xr + k);
        ah = __builtin_amdgcn_mfma_f32_16x16x32_bf16(*(const bf16x8*)(wh + k), xb, ah, 0, 0, 0);
        alo = __builtin_amdgcn_mfma_f32_16x16x32_bf16(*(const bf16x8*)(wl + k), xb, alo, 0, 0, 0);
    }
    f32x4* part = (f32x4*)(smem + RT_PART);
    __syncthreads();
    part[wave * 64 + lane] = ah + alo;
    __syncthreads();
    if (kq == 0) {
        const f32x4 t = part[wave * 64 + lane] + part[(wave + 1) * 64 + lane] + part[(wave + 2) * 64 + lane] + part[(wave + 3) * 64 + lane];
        const float4 s0 = *(const float4*)(p.ssq_x1 + token * 32 + fq * 8), s1 = *(const float4*)(p.ssq_x1 + token * 32 + fq * 8 + 4);
        float ss = ((s0.x + s0.y) + (s0.z + s0.w)) + ((s1.x + s1.y) + (s1.z + s1.w));
        ss += __shfl_xor(ss, 16); ss += __shfl_xor(ss, 32);
        const float rs = 1.0f / sqrtf(ss * (1.0f / D_) + 1e-6f);
        float l[4];
#pragma unroll
        for (int i = 0; i < 4; ++i) l[i] = t[i] * rs;
        float mx = fmaxf(fmaxf(l[0], l[1]), fmaxf(l[2], l[3]));
        mx = fmaxf(mx, __shfl_xor(mx, 16)); mx = fmaxf(mx, __shfl_xor(mx, 32));
        float e[4], sum = 0.f;
#pragma unroll
        for (int i = 0; i < 4; ++i) { e[i] = expf(l[i] - mx); sum += e[i]; }
        sum += __shfl_xor(sum, 16); sum += __shfl_xor(sum, 32);
        const float inv = 1.f / sum;
#pragma unroll
        for (int i = 0; i < 4; ++i) {
            const float a = e[i] * inv;
            p.aff_t[(size_t)(4 * fq + i) * L_ + token] = a;
            atomicAdd(p.ahist + (4 * fq + i) * 4096 + (__float_as_uint(a) >> 19), 1u);
        }
        if (fq == 0) p.rstd_x1[token] = rs;
    }
}

#define TK_MISC (SM_GEMM)
#define TK_SUF  (SM_GEMM + 64)
#define TK_LIST (SM_GEMM + 1024)
__device__ __forceinline__ void topk_item(const MKParams& p, unsigned char* smem, int e) {
    const int tid = opaque_tid(), lane = tid & 63, wave = tid >> 6;
    unsigned* misc = (unsigned*)(smem + TK_MISC);
    unsigned* wsum = (unsigned*)(smem + TK_SUF);
    uint2* list = (uint2*)(smem + TK_LIST);
    const float* a = p.aff_t + (size_t)e * L_;
    unsigned key[16];
#pragma unroll
    for (int i = 0; i < 16; ++i) key[i] = __float_as_uint(a[tid + NT_ * i]);
    const uint4 h0 = *(const uint4*)(p.ahist + e * 4096 + tid * 8), h1 = *(const uint4*)(p.ahist + e * 4096 + tid * 8 + 4);
    const unsigned hb[8] = {h0.x, h0.y, h0.z, h0.w, h1.x, h1.y, h1.z, h1.w};
    unsigned own = 0;
#pragma unroll
    for (int i = 0; i < 8; ++i) own += hb[i];
    unsigned suf = own;
#pragma unroll
    for (int o = 1; o < 64; o <<= 1) { const unsigned t = __shfl_down(suf, o); if (lane + o < 64) suf += t; }
    __syncthreads();
    if (lane == 0) wsum[wave] = suf;
    if (tid == 0) { misc[2] = 0u; misc[3] = 0u; }
    __syncthreads();
    unsigned above = suf - own;
#pragma unroll
    for (int w = 0; w < 8; ++w) if (w > wave) above += wsum[w];
    if (above < (unsigned)CAP_ && (unsigned)CAP_ <= above + own) {
        unsigned cnt = above;
#pragma unroll
        for (int i = 7; i >= 0; --i) {
            if (cnt < (unsigned)CAP_ && (unsigned)CAP_ <= cnt + hb[i]) { misc[0] = (unsigned)(tid * 8 + i); misc[1] = (unsigned)CAP_ - cnt; }
            cnt += hb[i];
        }
    }
    __syncthreads();
    const unsigned T = misc[0], need = misc[1];
#pragma unroll
    for (int i = 0; i < 16; ++i)
        if ((key[i] >> 19) == T) { const unsigned s = atomicAdd(&misc[3], 1u); list[s] = make_uint2(key[i], (unsigned)(tid + NT_ * i)); }
    __syncthreads();
    const unsigned nc = misc[3];
#pragma unroll
    for (int i = 0; i < 16; ++i) {
        const int token = tid + NT_ * i;
        const unsigned bin = key[i] >> 19;
        if (bin != T) {
            int slot = -1;
            if (bin > T) {
                slot = (int)atomicAdd(&misc[2], 1u);
                p.idx[e * CAP_ + slot] = token;
                p.gate[e * CAP_ + slot] = __uint_as_float(key[i]);
            }
            p.slot_of[token * NE_ + e] = slot;
        }
    }
    for (unsigned c0 = tid; c0 < nc; c0 += NT_) {
        const uint2 me = list[c0];
        unsigned rank = 0;
        unsigned j = 0;
        for (; j + 4 <= nc; j += 4) {
            const uint2 a0 = list[j], a1 = list[j + 1], a2 = list[j + 2], a3 = list[j + 3];
            rank += (a0.x > me.x || (a0.x == me.x && a0.y < me.y)) ? 1u : 0u;
            rank += (a1.x > me.x || (a1.x == me.x && a1.y < me.y)) ? 1u : 0u;
            rank += (a2.x > me.x || (a2.x == me.x && a2.y < me.y)) ? 1u : 0u;
            rank += (a3.x > me.x || (a3.x == me.x && a3.y < me.y)) ? 1u : 0u;
        }
        for (; j < nc; ++j) { const uint2 a0 = list[j]; rank += (a0.x > me.x || (a0.x == me.x && a0.y < me.y)) ? 1u : 0u; }
        int slot = -1;
        if (rank < need) {
            slot = (int)atomicAdd(&misc[2], 1u);
            p.idx[e * CAP_ + slot] = (int)me.y;
            p.gate[e * CAP_ + slot] = __uint_as_float(me.x);
        }
        p.slot_of[me.y * NE_ + e] = slot;
    }
    __syncthreads();
}

struct AGather { const bf16_t* base; const int* rows; __device__ __forceinline__ const bf16_t* ubase() const { return base; } __device__ __forceinline__ unsigned row_off(int r) const { return (unsigned)rows[r] * (unsigned)D_; } };
struct BMoe1 {
    const float* wg; long up_minus_gate; int col0;
    __device__ __forceinline__ const float* ubase(int wave) const { return wg + (long)(wave & 1) * up_minus_gate; }
    __device__ __forceinline__ unsigned col_off(int n4) const {
        const int wc = n4 >> 6, nn = (n4 >> 4) & 3, i = n4 & 15;
        return (unsigned)(col0 + wc * 32 + (nn & 1) * 16 + i);
    }
};
struct EpiMoe1 {
    const MKParams& p; int e, mt, nt;
    __device__ __forceinline__ void operator()(f32x4 (&acc)[8][4], int wr, int wc, int fr, int fq) const {
#pragma unroll
        for (int m = 0; m < 8; ++m) {
            const int slot = mt * 256 + wr * 128 + m * 16 + fr;
            const float rs = p.rstd_x1[p.idx[e * CAP_ + slot]];
#pragma unroll
            for (int nn = 0; nn < 2; ++nn) {
                const f32x4 g = acc[m][nn] * rs, u = acc[m][nn + 2] * rs;
                float a[4];
#pragma unroll
                for (int i = 0; i < 4; ++i) a[i] = g[i] / (1.f + __expf(-g[i])) * u[i];
                uint2 w; w.x = pk2(a[0], a[1]); w.y = pk2(a[2], a[3]);
                *(uint2*)(p.act + (size_t)(e * CAP_ + slot) * FF_ + nt * 128 + wc * 32 + nn * 16 + fq * 4) = w;
            }
        }
    }
};
__device__ __forceinline__ void moe1_item(const MKParams& p, unsigned char* smem, int it) {
    const int rnd = it >> 8, b = it & 255, xcd = b & 7, s = b >> 3;
    const int mt = s & 3, wt = rnd * 64 + xcd * 8 + (s >> 2);
    const int e = wt >> 4, nt = wt & 15;
    AGather al{p.x1g, p.idx + e * CAP_ + mt * 256};
    BHalves bl{p.w_gate_t + ((size_t)e * FF_ + nt * 128) * D_, p.w_up_t + ((size_t)e * FF_ + nt * 128) * D_, D_};
    BgConv bg{p.w_down, 0L, p.w_down_t, 0L, rnd * 15 * 256 + b};
    gemm8_tile<true>(smem, al, bl, D_ / 64, NoMid8{}, EpiMoe1_8{p, e, mt, nt}, bg);
}

struct EpiMoe2 {
    const MKParams& p; int e, mt, nt;
    __device__ __forceinline__ void operator()(f32x4 (&acc)[8][4], int wr, int wc, int fr, int fq) const {
#pragma unroll
        for (int m = 0; m < 8; ++m) {
            const int slot = mt * 256 + wr * 128 + m * 16 + fr;
            const float gt = p.gate[e * CAP_ + slot];
#pragma unroll
            for (int nn = 0; nn < 4; ++nn) {
                const f32x4 a = acc[m][nn] * gt;
                uint2 w; w.x = pk2(a[0], a[1]); w.y = pk2(a[2], a[3]);
                *(uint2*)(p.ye + (size_t)(e * CAP_ + slot) * D_ + nt * 256 + wc * 64 + nn * 16 + fq * 4) = w;
            }
        }
    }
};
__device__ __forceinline__ void moe2_item(const MKParams& p, unsigned char* smem, int it) {
    const int rnd = it >> 8, b = it & 255, xcd = b & 7, s = b >> 3;
    const int mt = s & 3, wt = rnd * 64 + xcd * 8 + (s >> 2);
    const int e = wt >> 3, nt = wt & 7;
    ARows al{p.act + (size_t)(e * CAP_ + mt * 256) * FF_, FF_};
    BHalves bl{p.w_down_t + ((size_t)e * D_ + nt * 256) * FF_, p.w_down_t + ((size_t)e * D_ + nt * 256 + 128) * FF_, FF_};
    gemm8_tile<true>(smem, al, bl, FF_ / 64, NoMid8{}, EpiMoe2_8{p, e, mt, nt}, NoBg{});
}

__device__ __forceinline__ void final_token(const MKParams& p, int token, int lane) {
    float v[4][8];
#pragma unroll
    for (int j = 0; j < 4; ++j) {
        const int n = j * 512 + lane * 8;
        const uint4 w = *(const uint4*)(p.x1g + (size_t)token * D_ + n);
        const float4 g0 = *(const float4*)(p.g_ffn + n), g1 = *(const float4*)(p.g_ffn + n + 4);
        v[j][0] = bflo(w.x) / g0.x; v[j][1] = bfhi(w.x) / g0.y; v[j][2] = bflo(w.y) / g0.z; v[j][3] = bfhi(w.y) / g0.w;
        v[j][4] = bflo(w.z) / g1.x; v[j][5] = bfhi(w.z) / g1.y; v[j][6] = bflo(w.w) / g1.z; v[j][7] = bfhi(w.w) / g1.w;
    }
#pragma unroll 1
    for (int e = 0; e < NE_; ++e) {
        const int slot = p.slot_of[token * NE_ + e];
        if (slot >= 0) {
            const bf16_t* yr = p.ye + (size_t)(e * CAP_ + slot) * D_;
#pragma unroll
            for (int j = 0; j < 4; ++j) {
                const uint4 w = *(const uint4*)(yr + j * 512 + lane * 8);
                v[j][0] += bflo(w.x); v[j][1] += bfhi(w.x); v[j][2] += bflo(w.y); v[j][3] += bfhi(w.y);
                v[j][4] += bflo(w.z); v[j][5] += bfhi(w.z); v[j][6] += bflo(w.w); v[j][7] += bfhi(w.w);
            }
        }
    }
    float ss = 0.f;
#pragma unroll
    for (int j = 0; j < 4; ++j)
#pragma unroll
        for (int i = 0; i < 8; ++i) ss += v[j][i] * v[j][i];
    ss = wave_sum(ss);
    const float rs = 1.0f / sqrtf(ss * (1.0f / D_) + 1e-6f);
#pragma unroll
    for (int j = 0; j < 4; ++j) {
        const int n = j * 512 + lane * 8;
        const float4 g0 = *(const float4*)(p.g_final + n), g1 = *(const float4*)(p.g_final + n + 4);
        float4 o0, o1;
        o0.x = v[j][0] * rs * g0.x; o0.y = v[j][1] * rs * g0.y; o0.z = v[j][2] * rs * g0.z; o0.w = v[j][3] * rs * g0.w;
        o1.x = v[j][4] * rs * g1.x; o1.y = v[j][5] * rs * g1.y; o1.z = v[j][6] * rs * g1.z; o1.w = v[j][7] * rs * g1.w;
        *(float4*)(p.out + (size_t)token * D_ + n) = o0;
        *(float4*)(p.out + (size_t)token * D_ + n + 4) = o1;
    }
}


#ifndef REP0
#define REP0 1
#endif
#ifndef REP1
#define REP1 1
#endif
#ifndef REP2
#define REP2 1
#endif
#ifndef REP3
#define REP3 1
#endif
#ifndef REP4
#define REP4 1
#endif
#ifndef REP5
#define REP5 1
#endif
#ifndef REP6
#define REP6 1
#endif
#ifndef REP7
#define REP7 1
#endif
#ifndef REP8
#define REP8 1
#endif
#ifndef REP9
#define REP9 1
#endif
#ifndef REP10
#define REP10 1
#endif
#ifndef REP12
#define REP12 1
#endif
#ifndef REP13
#define REP13 0
#endif
__global__ __launch_bounds__(NT_, 2) void k_mega(MKParams p) {
    extern __shared__ __attribute__((aligned(16))) unsigned char smem[];
    volatile LAS unsigned* st = (volatile LAS unsigned*)smem;
    if (threadIdx.x < 4) st[threadIdx.x] = 0u;
    if (threadIdx.x == 4) *(volatile LAS unsigned*)(smem + 64) = 0u;
    __syncthreads();
    xcd_barrier_post(p.bar, st);
    if (p.never) cg::this_grid().sync();
    const int G = gridDim.x, b0 = blockIdx.x;
    {
        const int tq = opaque_tid(), lane = tq & 63, wave = __builtin_amdgcn_readfirstlane(tq >> 6);
        if (wave < 4) {
            unsigned epoch = 0;
            volatile LAS unsigned* cnt = (volatile LAS unsigned*)(smem + 64);
            for (int rep = 0; rep < p.rep[10]; ++rep)
                for (int it = b0; it < 256; it += G) ssm_tables(p, smem, it >> 2, it & 3, wave, lane, cnt, epoch);
        } else {
            const int gw = b0 * 4 + (wave - 4), NGW = G * 4;
            for (int rep = 0; rep < p.rep[0]; ++rep) conv_range(p, 0, CV_GU0, gw, NGW, lane);
            phase_prep(p, gw, NGW, lane);
            for (int i = gw * 64 + lane; i < NE_ * 4096; i += NGW * 64) p.ahist[i] = 0u;
        }
    }
    xcd_barrier(p.bar, st);
    if (threadIdx.x == 0) {
        bool even = (G % 8) == 0;
        for (int j = 0; j < 8; ++j) even = even && (xb_ld(&p.bar[XB_XCNT(j)]) == (unsigned)(G / 8));
        st[2] = even ? (st[2] + 8u * st[3]) : (unsigned)blockIdx.x;
    }
    __syncthreads();
    const int b = (int)st[2];
    for (int rep = 0; rep < p.rep[1]; ++rep) {
    phase_inproj(p, smem, b);
    xcd_barrier(p.bar, st);
    }
    for (int rep = 0; rep < p.rep[2]; ++rep) {
    phase2(p, smem, b, G, p.bar + 64 + rep);
    xcd_barrier(p.bar, st);
    }
    for (int rep = 0; rep < p.rep[3]; ++rep) {
    for (int it = b; it < 128; it += G) { const int q = it >> 3; ssm_y_item(p, smem, (it & 7) + 8 * (q >> 1), q & 1); }
    if (b >= 128) { const int tq = opaque_tid(); conv_range(p, CV_GU0, CV_P3_END, (b - 128) * 8 + (tq >> 6), 128 * 8, tq & 63); }
    xcd_barrier(p.bar, st);
    }
    for (int rep = 0; rep < p.rep[4]; ++rep) {
    for (int it = b; it < 128; it += G) glu_item(p, smem, it);
    if (b >= 128) { const int tq = opaque_tid(); conv_range(p, CV_P3_END, CV_P4_END, (b - 128) * 8 + (tq >> 6), 128 * 8, tq & 63); }
    xcd_barrier(p.bar, st);
    }
    for (int rep = 0; rep < p.rep[5]; ++rep) {
    for (int it = b; it < 256; it += G) outproj_item(p, smem, it);
    xcd_barrier(p.bar, st);
    }
    for (int rep = 0; rep < p.rep[6]; ++rep) {
    for (int it = b; it < L_ / 32; it += G) router_item(p, smem, it);
    xcd_barrier(p.bar, st);
    }
    for (int rep = 0; rep < p.rep[7]; ++rep) {
    for (int it = b; it < NE_; it += G) topk_item(p, smem, it);
    if (b >= 16) { const int tq = opaque_tid(); conv_range(p, CV_P4_END, CV_END, (b - 16) * 8 + (tq >> 6), 240 * 8, tq & 63); }
    xcd_barrier(p.bar, st);
    }
    for (int rep = 0; rep < p.rep[8]; ++rep) {
    for (int it = b; it < 1024; it += G) moe1_item(p, smem, it);
    xcd_barrier(p.bar, st);
    }
    for (int rep = 0; rep < p.rep[9]; ++rep) {
    for (int it = b; it < 512; it += G) moe2_item(p, smem, it);
    xcd_barrier(p.bar, st);
    }
    for (int i = 0; i < p.rep[13]; ++i) xcd_barrier(p.bar, st);
    for (int rep = 0; rep < p.rep[12]; ++rep)
    { int tq = threadIdx.x; asm volatile("" : "+v"(tq));
      for (int t = b * 8 + (tq >> 6); t < L_; t += G * 8) final_token(p, t, tq & 63); }
}

extern "C" void kernel_launch(void* const* d_in, const int* in_sizes, int n_in, void* d_out, int out_size, void* d_ws, size_t ws_size,
                              hipStream_t stream) {
    (void)in_sizes; (void)n_in; (void)out_size; (void)ws_size;
    static int grid = 0;
    if (!grid) {
        int dev = 0, cus = 0, per_cu = 0;
        (void)hipGetDevice(&dev);
        (void)hipDeviceGetAttribute(&cus, hipDeviceAttributeMultiprocessorCount, dev);
        (void)hipFuncSetAttribute((const void*)k_mega, hipFuncAttributeMaxDynamicSharedMemorySize, MK_LDS);
        (void)hipOccupancyMaxActiveBlocksPerMultiprocessor(&per_cu, (const void*)k_mega, NT_, MK_LDS);
        if (per_cu < 1) per_cu = 1;
        grid = cus;
    }
    MKParams mp{};
    const float* const* in = (const float* const*)d_in;
    mp.x = in[0]; mp.g_mix = in[1]; mp.w_in = in[2];
    mp.a_re_f = in[3]; mp.a_im_f = in[4]; mp.ldt_f = in[5]; mp.b_re_f = in[6]; mp.b_im_f = in[7]; mp.c_re_f = in[8]; mp.c_im_f = in[9];
    mp.a_re_b = in[10]; mp.a_im_b = in[11]; mp.ldt_b = in[12]; mp.b_re_b = in[13]; mp.b_im_b = in[14]; mp.c_re_b = in[15]; mp.c_im_b = in[16];
    mp.ssm_d = in[17]; mp.w_glu = in[18]; mp.b_glu = in[19]; mp.rpb = in[20]; mp.g_ssm = in[21]; mp.g_na = in[22]; mp.w_out = in[23];
    mp.g_ffn = in[24]; mp.w_router = in[25]; mp.w_gate = in[26]; mp.w_up = in[27]; mp.w_down = in[28]; mp.g_final = in[29];
    mp.out = (float*)d_out;
    unsigned char* ws = (unsigned char*)d_ws;
    size_t off = 0;
    auto take = [&](size_t bytes) { unsigned char* q = ws + off; off += (bytes + 255) & ~(size_t)255; return q; };
    mp.bar = (unsigned*)take(XCD_BAR_WORDS * 4);
    mp.xn = (bf16_t*)take((size_t)L_ * XN_LD * 2);
    mp.rstd_x = (float*)take(L_ * 4);
    mp.ua = (bf16_t*)take((size_t)64 * 256 * 768 * 2);
    mp.qb = (bf16_t*)take((size_t)L_ * DS_ * 2);
    mp.kb = (bf16_t*)take((size_t)L_ * DS_ * 2);
    mp.vT = (bf16_t*)take((size_t)L_ * DS_ * 2);
    mp.PBt = (bf16_t*)take((size_t)64 * 256 * 512 * 2);
    mp.WyT = (bf16_t*)take((size_t)64 * 512 * 768 * 2);
    mp.A32 = (float*)take(64 * 2 * 64 * 2 * 4);
    mp.ypre = (bf16_t*)take((size_t)L_ * DS_ * 2);
    mp.ymix = (bf16_t*)take((size_t)L_ * D_ * 2);
    mp.ssq_na = (float*)take((size_t)L_ * 16 * 4);
    mp.ssq_ssm = (float*)take((size_t)L_ * 16 * 4);
    mp.x1g = (bf16_t*)take((size_t)L_ * D_ * 2);
    mp.ssq_x1 = (float*)take((size_t)L_ * 32 * 4);
    mp.wrT = (bf16_t*)take((size_t)2 * NE_ * D_ * 2);
    mp.aff_t = (float*)take((size_t)NE_ * L_ * 4);
    mp.rstd_x1 = (float*)take(L_ * 4);
    mp.idx = (int*)take(NE_ * CAP_ * 4);
    mp.gate = (float*)take(NE_ * CAP_ * 4);
    mp.slot_of = (int*)take((size_t)L_ * NE_ * 4);
    mp.ahist = (unsigned*)take((size_t)NE_ * 4096 * 4);
    mp.act = (bf16_t*)take((size_t)NE_ * CAP_ * FF_ * 2);
    mp.ye = (bf16_t*)take((size_t)NE_ * CAP_ * D_ * 2);
    mp.w_in_t = (bf16_t*)take((size_t)DIN_ * XN_LD * 2);
    mp.w_out_t = (bf16_t*)take((size_t)D_ * D_ * 2);
    mp.w_glu_t = (bf16_t*)take((size_t)DS_ * DS_ * 2);
    mp.w_gate_t = (bf16_t*)take((size_t)NE_ * D_ * FF_ * 2);
    mp.w_up_t = (bf16_t*)take((size_t)NE_ * D_ * FF_ * 2);
    mp.w_down_t = (bf16_t*)take((size_t)NE_ * D_ * FF_ * 2);
    { const int reps[14] = {REP0, REP1, REP2, REP3, REP4, REP5, REP6, REP7, REP8, REP9, REP10, 1, REP12, REP13}; for (int i = 0; i < 14; ++i) mp.rep[i] = reps[i]; }
    mp.bg = 1;
    mp.never = 0; mp.pad = 0;
    (void)hipMemsetAsync(mp.bar, 0, XCD_BAR_WORDS * sizeof(unsigned), stream);
    void* args[] = {&mp};
    (void)hipLaunchCooperativeKernel((const void*)k_mega, dim3(grid), dim3(NT_), args, MK_LDS, stream);
}
```

```cpp
#include <hip/hip_runtime.h>
#include <math.h>
#include <stdint.h>

#define L_   8192
#define D_   2048
#define DIN_ 4096
#define DS_  1024
#define NG_  64
#define NP_  64
#define NE_  16
#define CAP_ 1024
#define FF_  2048

__device__ __forceinline__ float wave_sum(float v) {
#pragma unroll
    for (int o = 32; o >= 1; o >>= 1) v += __shfl_xor(v, o);
    return v;
}

#include <hip/hip_cooperative_groups.h>
namespace cg = cooperative_groups;
#define XB_TMO      128
#define XB_XCNT(j)  (256  + 64 * (j))
#define XB_XSUB(j)  (1280 + 64 * (j))
#define XB_XGEN(j)  (2304 + 64 * (j))
#define XB_TOP      3328
#define XB_TOPGEN   3392
#define XCD_BAR_WORDS 3456
#define XB_SPIN_CAP (1u << 18)
#define LAS __attribute__((address_space(3)))
__device__ __forceinline__ unsigned xb_ld(unsigned* p)              { return __hip_atomic_load(p, __ATOMIC_RELAXED, __HIP_MEMORY_SCOPE_AGENT); }
__device__ __forceinline__ unsigned xb_add(unsigned* p, unsigned v) { return __hip_atomic_fetch_add(p, v, __ATOMIC_RELAXED, __HIP_MEMORY_SCOPE_AGENT); }
__device__ __forceinline__ unsigned xb_xcc_id() { return (unsigned)__builtin_amdgcn_s_getreg((3 << 11) | 20) & 0xFu; }
#define XB_SPIN(cond, bar) do { unsigned _sp = 0; while (cond) { __builtin_amdgcn_s_sleep(1); \
    if ((++_sp & 255u) == 0u) { if (xb_ld(&(bar)[XB_TMO])) break; if (_sp > XB_SPIN_CAP) { atomicAdd(&(bar)[XB_TMO], 1u); break; } } } } while (0)
__device__ __forceinline__ void xcd_barrier_post(unsigned* bar, volatile LAS unsigned* st) {
    if (threadIdx.x == 0) { const unsigned x = xb_xcc_id(); const unsigned r = xb_add(&bar[XB_XCNT(x)], 1u); st[2] = x; st[3] = r; }
}
__device__ __forceinline__ void xcd_barrier_complete(unsigned* bar, unsigned x, unsigned& nloc, unsigned& nx) {
    const unsigned G = gridDim.x * gridDim.y * gridDim.z;
    unsigned sum, cnt, mine, sp = 0u;
    for (;;) {
        sum = 0u; cnt = 0u; mine = 0u;
#pragma unroll
        for (unsigned j = 0; j < 16; ++j) { const unsigned c = xb_ld(&bar[XB_XCNT(j)]); sum += c; cnt += (c > 0u) ? 1u : 0u; mine = (j == x) ? c : mine; }
        if (sum == G) break;
        __builtin_amdgcn_s_sleep(1);
        if ((++sp & 255u) == 0u) { if (xb_ld(&bar[XB_TMO])) break; if (sp > XB_SPIN_CAP) { atomicAdd(&bar[XB_TMO], 1u); break; } }
    }
    nloc = mine > 0u ? mine : 1u; nx = cnt > 0u ? cnt : 1u;
}
__device__ __forceinline__ void xcd_barrier(unsigned* bar, volatile LAS unsigned* st) {
    asm volatile("s_waitcnt vmcnt(0)" ::: "memory");
    __syncthreads();
    if (threadIdx.x == 0) {
        __builtin_amdgcn_s_waitcnt(0);
        const unsigned x = xb_xcc_id();
        unsigned nloc = st[0], nx = st[1];
        if (nloc == 0u) { xcd_barrier_complete(bar, x, nloc, nx); st[0] = nloc; st[1] = nx; }
        const unsigned old = xb_add(&bar[XB_XSUB(x)], 1u);
        const unsigned gen = old / nloc;
        if (old + 1u == (gen + 1u) * nloc) {
            __builtin_amdgcn_fence(__ATOMIC_RELEASE, "agent");
            asm volatile("s_waitcnt vmcnt(0)" ::: "memory");
            const unsigned og = xb_add(&bar[XB_TOP], 1u);
            const unsigned tg = og / nx;
            if (og + 1u == (tg + 1u) * nx) xb_add(&bar[XB_TOPGEN], 1u);
            else XB_SPIN(xb_ld(&bar[XB_TOPGEN]) == tg, bar);
            __builtin_amdgcn_fence(__ATOMIC_ACQUIRE, "agent");
            xb_add(&bar[XB_XGEN(x)], 1u);
            asm volatile("s_waitcnt vmcnt(0)" ::: "memory");
        } else {
            XB_SPIN(xb_ld(&bar[XB_XGEN(x)]) == gen, bar);
            __builtin_amdgcn_fence(__ATOMIC_ACQUIRE, "agent");
            asm volatile("s_waitcnt vmcnt(0)" ::: "memory");
        }
    }
    __syncthreads();
}

typedef short bf16x8 __attribute__((ext_vector_type(8)));
typedef float f32x4 __attribute__((ext_vector_type(4)));
typedef float f32x2 __attribute__((ext_vector_type(2)));
typedef __bf16 bf16x2v __attribute__((ext_vector_type(2)));
typedef unsigned short bf16_t;
typedef unsigned u32x4 __attribute__((ext_vector_type(4)));
#define NT_ 512
#define XN_LD (D_ + 64)
#define SM_MISC 0
#define SM_ROWS 1024
#define SM_GEMM 4096
#define SM_CV (SM_GEMM + 131072)
#define MK_LDS (152 * 1024)

__device__ __forceinline__ unsigned pk2(float lo, float hi) {
    f32x2 v = {lo, hi};
    return __builtin_bit_cast(unsigned, __builtin_convertvector(v, bf16x2v));
}
__device__ __forceinline__ float bf2f(bf16_t h) { return __uint_as_float(((unsigned)h) << 16); }
__device__ __forceinline__ float bflo(unsigned w) { return __uint_as_float(w << 16); }
__device__ __forceinline__ float bfhi(unsigned w) { return __uint_as_float(w & 0xffff0000u); }

struct MKParams {
    const float *x, *g_mix, *w_in;
    const float *a_re_f, *a_im_f, *ldt_f, *b_re_f, *b_im_f, *c_re_f, *c_im_f;
    const float *a_re_b, *a_im_b, *ldt_b, *b_re_b, *b_im_b, *c_re_b, *c_im_b;
    const float *ssm_d, *w_glu, *b_glu, *rpb, *g_ssm, *g_na, *w_out, *g_ffn, *w_router, *w_gate, *w_up, *w_down, *g_final;
    float* out;
    bf16_t* xn;
    float* rstd_x;
    bf16_t* ua;
    bf16_t* qb;
    bf16_t* kb;
    bf16_t* vT;
    bf16_t* PBt;
    bf16_t* WyT;
    float* A32;
    bf16_t* ypre;
    bf16_t* ymix;
    float* ssq_na;
    float* ssq_ssm;
    bf16_t* x1g;
    float* ssq_x1;
    bf16_t* wrT;
    float* aff_t;
    float* rstd_x1;
    int* idx;
    float* gate;
    int* slot_of;
    unsigned* ahist;
    bf16_t* act;
    bf16_t* ye;
    bf16_t* w_in_t;
    bf16_t* w_out_t;
    bf16_t* w_glu_t;
    bf16_t *w_gate_t, *w_up_t, *w_down_t;
    unsigned* bar;
    int bg;
    int rep[14];
    int never; int pad;
};

#define GAS __attribute__((address_space(1)))
__device__ __forceinline__ int opaque_tid() { int t = threadIdx.x; asm volatile("" : "+v"(t)); return t; }
template <class T> __device__ __forceinline__ const GAS T* uniform_ptr(const T* p) {
    const unsigned long long v = (unsigned long long)p;
    const unsigned lo = __builtin_amdgcn_readfirstlane((unsigned)v), hi = __builtin_amdgcn_readfirstlane((unsigned)(v >> 32));
    return (const GAS T*)(((unsigned long long)hi << 32) | lo);
}
__device__ __forceinline__ int tile_off(int row, int chunk) { return row * 128 + (((chunk ^ (row >> 1)) & 7) << 4); }

template <int MT, bool TR, int BMODE, class ALoad, class BLoad, class Mid, class Epi>
__device__ __forceinline__ void gemm_tile(unsigned char* smem, const ALoad& al, const BLoad& bl, int ldb, int nkt, const Mid& mid, const Epi& epi) {
    int tid_ = threadIdx.x; asm volatile("" : "+v"(tid_));
    const int tid = tid_, lane = tid & 63, wave = tid >> 6;
    const int wr = wave >> 2, wc = wave & 3, fr = lane & 15, fq = lane >> 4;
    constexpr int AR = MT / 2;
    const GAS bf16_t* const abase = uniform_ptr(al.ubase());
    unsigned aoff[AR];
#pragma unroll
    for (int i = 0; i < AR; ++i) {
        const int row = i * 64 + (tid >> 3);
        aoff[i] = al.row_off(row) + (unsigned)((((lane & 7) ^ (row >> 1)) & 7) << 3);
    }
    const int a_lds = __builtin_amdgcn_readfirstlane(wave * 1024);
    const int b_kg = lane & 7, b_n4 = ((wave << 3) | (lane >> 3)) << 2;
    const auto* const bbase = uniform_ptr(bl.ubase(__builtin_amdgcn_readfirstlane(wave)));
    unsigned boff = 0, boff16[4];
    if constexpr (BMODE == 0) { boff = bl.col_off(b_n4) + (unsigned)(b_kg * 8) * (unsigned)ldb; }
    else {
#pragma unroll
        for (int i = 0; i < 4; ++i) { const int row = i * 64 + (tid >> 3); boff16[i] = bl.row_off(row) + (unsigned)((((lane & 7) ^ (row >> 1)) & 7) << 3); }
    }
    unsigned char* const sA = smem + SM_GEMM;
    unsigned char* const sB = smem + SM_GEMM + 32768;
    const int key = (fr >> 1) & 7;
    const int c0 = ((fq ^ key) & 7) << 4, c1 = (((fq | 4) ^ key) & 7) << 4;
    const int a_frag = (wr * (MT * 16) + fr) * 128;
    const int b_frag = (wc * 64 + fr) * 128;

    f32x4 acc[MT][4];
#pragma unroll
    for (int m = 0; m < MT; ++m)
#pragma unroll
        for (int n = 0; n < 4; ++n) acc[m][n] = (f32x4){0.f, 0.f, 0.f, 0.f};

    f32x4 rb[8];
    __syncthreads();
#pragma unroll
    for (int i = 0; i < AR; ++i)
        __builtin_amdgcn_global_load_lds((const GAS unsigned*)(abase + aoff[i]), (__attribute__((address_space(3))) unsigned*)(sA + a_lds + i * 8192), 16, 0, 0);
    if constexpr (BMODE == 0) {
#pragma unroll
        for (int j = 0; j < 8; ++j) rb[j] = *(const GAS f32x4*)((const GAS float*)bbase + (size_t)j * ldb + boff);
        const float* f = (const float*)rb;
#pragma unroll
        for (int i = 0; i < 4; ++i) {
            uint4 w; w.x = pk2(f[0 * 4 + i], f[1 * 4 + i]); w.y = pk2(f[2 * 4 + i], f[3 * 4 + i]); w.z = pk2(f[4 * 4 + i], f[5 * 4 + i]); w.w = pk2(f[6 * 4 + i], f[7 * 4 + i]);
            *(uint4*)(sB + tile_off(b_n4 + i, b_kg)) = w;
        }
    } else {
#pragma unroll
        for (int i = 0; i < 4; ++i)
            __builtin_amdgcn_global_load_lds((const GAS unsigned*)((const GAS bf16_t*)bbase + boff16[i]), (__attribute__((address_space(3))) unsigned*)(sB + a_lds + i * 8192), 16, 0, 0);
    }
    __syncthreads();
    for (int kt = 0; kt < nkt; ++kt) {
        const int cur = (kt & 1) * 65536;
        const int nxt = cur ^ 65536;
        const bool more = (kt + 1 < nkt);
        if (more) {
#pragma unroll
            for (int i = 0; i < AR; ++i)
                __builtin_amdgcn_global_load_lds((const GAS unsigned*)(abase + (kt + 1) * 64 + aoff[i]), (__attribute__((address_space(3))) unsigned*)(sA + nxt + a_lds + i * 8192), 16, 0, 0);
            if constexpr (BMODE == 0) {
#pragma unroll
                for (int j = 0; j < 8; ++j) rb[j] = *(const GAS f32x4*)((const GAS float*)bbase + (size_t)((kt + 1) * 64 + j) * ldb + boff);
            } else {
#pragma unroll
                for (int i = 0; i < 4; ++i)
                    __builtin_amdgcn_global_load_lds((const GAS unsigned*)((const GAS bf16_t*)bbase + (kt + 1) * 64 + boff16[i]), (__attribute__((address_space(3))) unsigned*)(sB + nxt + a_lds + i * 8192), 16, 0, 0);
            }
        }
        mid(kt, acc, wr, fr, fq);
        constexpr int GQ = MT / 2, NG = 2 * GQ;
        bf16x8 bfr[4], af[2][2];
#pragma unroll
        for (int n = 0; n < 4; ++n) bfr[n] = *(const bf16x8*)(sB + cur + b_frag + n * 2048 + c0);
#pragma unroll
        for (int m = 0; m < 2; ++m) af[0][m] = *(const bf16x8*)(sA + cur + a_frag + m * 2048 + c0);
#pragma unroll
        for (int g = 0; g < NG; ++g) {
            const int ks = g / GQ, mq = g % GQ;
            if (g + 1 < NG) {
                const int ks1 = (g + 1) / GQ, mq1 = (g + 1) % GQ;
#pragma unroll
                for (int m = 0; m < 2; ++m) af[(g + 1) & 1][m] = *(const bf16x8*)(sA + cur + a_frag + (mq1 * 2 + m) * 2048 + (ks1 ? c1 : c0));
            }
#pragma unroll
            for (int m = 0; m < 2; ++m)
#pragma unroll
                for (int n = 0; n < 4; ++n)
                    acc[mq * 2 + m][n] = TR ? __builtin_amdgcn_mfma_f32_16x16x32_bf16(bfr[n], af[g & 1][m], acc[mq * 2 + m][n], 0, 0, 0)
                                            : __builtin_amdgcn_mfma_f32_16x16x32_bf16(af[g & 1][m], bfr[n], acc[mq * 2 + m][n], 0, 0, 0);
            if (g == GQ - 1) {
#pragma unroll
                for (int n = 0; n < 4; ++n) bfr[n] = *(const bf16x8*)(sB + cur + b_frag + n * 2048 + c1);
            }
            if (BMODE == 0 && g == NG - 2) {
                if (more) {
                    const float* f = (const float*)rb;
#pragma unroll
                    for (int i = 0; i < 4; ++i) {
                        uint4 w; w.x = pk2(f[0 * 4 + i], f[1 * 4 + i]); w.y = pk2(f[2 * 4 + i], f[3 * 4 + i]); w.z = pk2(f[4 * 4 + i], f[5 * 4 + i]); w.w = pk2(f[6 * 4 + i], f[7 * 4 + i]);
                        *(uint4*)(sB + nxt + tile_off(b_n4 + i, b_kg)) = w;
                    }
                }
            }
            __builtin_amdgcn_sched_barrier(0);
        }
        __syncthreads();
    }
    epi(acc, wr, wc, fr, fq);
}

struct NoMid { template <class ACC> __device__ __forceinline__ void operator()(int, ACC&, int, int, int) const {} };
struct ARows { const bf16_t* base; int lda; __device__ __forceinline__ const bf16_t* ubase() const { return base; } __device__ __forceinline__ unsigned row_off(int r) const { return (unsigned)r * (unsigned)lda; } };
struct BRows16 { const bf16_t* base; int ld; __device__ __forceinline__ const bf16_t* ubase(int) const { return base; } __device__ __forceinline__ unsigned row_off(int r) const { return (unsigned)r * (unsigned)ld; } };
struct BCols { const float* base; __device__ __forceinline__ const float* ubase(int) const { return base; } __device__ __forceinline__ unsigned col_off(int n4) const { return (unsigned)n4; } };

#define G8_HT 16384
__device__ __forceinline__ void g8_stage_rc(int b, int& R, int& C) { const int st = b / 1024, sb = b % 1024, swz = sb ^ (((sb >> 9) & 1) << 5); R = (st >> 1) * 16 + swz / 64; C = (st & 1) * 32 + (swz % 64) / 2; }
#define G8_WAIT_V(n) asm volatile("s_waitcnt vmcnt(" #n ")" ::: "memory")
#define G8_WAIT_L(n) asm volatile("s_waitcnt lgkmcnt(" #n ")" ::: "memory")
#define G8_BAR __builtin_amdgcn_s_barrier()
#define G8_SCHED __builtin_amdgcn_sched_barrier(0)

template <bool TR, class ALoad, class BLoad, class Mid, class Epi, class BG>
__device__ __forceinline__ void gemm8_tile(unsigned char* smem, const ALoad& al, const BLoad& bl, int nt, const Mid& mid, const Epi& epi, const BG& bg) {
    int tid_ = threadIdx.x; asm volatile("" : "+v"(tid_));
    const int tid = tid_, lane = tid & 63, wid = tid >> 6, wr = wid >> 2, wc = wid & 3, fr = lane & 15, fq = lane >> 4;
    unsigned char* const shm = smem + SM_GEMM;
    const GAS bf16_t* const abase = uniform_ptr(al.ubase());
    const GAS bf16_t* const bbase0 = uniform_ptr(bl.half_base(0));
    const GAS bf16_t* const bbase1 = uniform_ptr(bl.half_base(1));
    unsigned aoff[2][2], boff[2];
#pragma unroll
    for (int i = 0; i < 2; ++i) {
        int R, C; g8_stage_rc(tid * 16 + i * 8192, R, C);
        aoff[0][i] = al.row_off(R) + (unsigned)C; aoff[1][i] = al.row_off(128 + R) + (unsigned)C; boff[i] = bl.row_off(R) + (unsigned)C;
    }
    const int wlds = __builtin_amdgcn_readfirstlane(wid * 1024);
    const int lane_off = fr * 64 + ((fq * 16) ^ ((fr >> 3) << 5));
#define G8_SA(b, h) (shm + ((b) * 2 + (h)) * G8_HT)
#define G8_SB(b, h) (shm + (4 + (b) * 2 + (h)) * G8_HT)
#define G8_STAGE_A(b, h, kt) do { _Pragma("unroll") for (int _i = 0; _i < 2; ++_i) \
        __builtin_amdgcn_global_load_lds((const GAS unsigned*)(abase + (size_t)(kt) * 64 + aoff[h][_i]), (LAS unsigned*)(G8_SA(b, h) + wlds + _i * 8192), 16, 0, 0); } while (0)
#define G8_STAGE_B(b, h, kt) do { _Pragma("unroll") for (int _i = 0; _i < 2; ++_i) \
        __builtin_amdgcn_global_load_lds((const GAS unsigned*)(((h) ? bbase1 : bbase0) + (size_t)(kt) * 64 + boff[_i]), (LAS unsigned*)(G8_SB(b, h) + wlds + _i * 8192), 16, 0, 0); } while (0)
#define G8_LDA(dst, b, h) do { _Pragma("unroll") for (int _m = 0; _m < 4; ++_m) _Pragma("unroll") for (int _k = 0; _k < 2; ++_k) \
        dst[_m][_k] = *(const bf16x8*)(G8_SA(b, h) + ((wr * 4 + _m) * 2 + _k) * 1024 + lane_off); } while (0)
#define G8_LDB(dst, b, h) do { _Pragma("unroll") for (int _n = 0; _n < 2; ++_n) _Pragma("unroll") for (int _k = 0; _k < 2; ++_k) \
        dst[_n][_k] = *(const bf16x8*)(G8_SB(b, h) + ((wc * 2 + _n) * 2 + _k) * 1024 + lane_off); } while (0)
#define G8_MMA(ai, bj, AT, BT) do { __builtin_amdgcn_s_setprio(1); \
        _Pragma("unroll") for (int _m = 0; _m < 4; ++_m) _Pragma("unroll") for (int _n = 0; _n < 2; ++_n) _Pragma("unroll") for (int _k = 0; _k < 2; ++_k) \
            acc[ai][bj][_m][_n] = TR ? __builtin_amdgcn_mfma_f32_16x16x32_bf16(BT[_n][_k], AT[_m][_k], acc[ai][bj][_m][_n], 0, 0, 0) \
                                     : __builtin_amdgcn_mfma_f32_16x16x32_bf16(AT[_m][_k], BT[_n][_k], acc[ai][bj][_m][_n], 0, 0, 0); \
        __builtin_amdgcn_s_setprio(0); } while (0)

    f32x4 acc[2][2][4][2];
#pragma unroll
    for (int a = 0; a < 2; ++a)
#pragma unroll
        for (int b = 0; b < 2; ++b)
#pragma unroll
            for (int m = 0; m < 4; ++m)
#pragma unroll
                for (int n = 0; n < 2; ++n) acc[a][b][m][n] = (f32x4){0.f, 0.f, 0.f, 0.f};
    bf16x8 At[4][2], B0[2][2], B1[2][2];
    __syncthreads();
    if constexpr (BG::ON) bg.issue(0, smem, wid, lane);
    G8_STAGE_B(0, 0, 0); G8_STAGE_A(0, 0, 0); G8_STAGE_B(0, 1, 0); G8_STAGE_A(0, 1, 0);
    if (wr == 1) G8_BAR;
    G8_WAIT_V(4); G8_BAR;
    G8_STAGE_B(1, 0, 1); G8_STAGE_A(1, 0, 1); G8_STAGE_B(1, 1, 1);
    G8_WAIT_V(6); G8_BAR;
    for (int t = 0; t < nt - 2; t += 2) {
        mid(t, acc, wr, fr, fq);
        G8_LDB(B0, 0, 0); G8_SCHED; G8_LDA(At, 0, 0); G8_STAGE_A(1, 1, t + 1);
        G8_WAIT_L(8); G8_BAR; G8_WAIT_L(0); G8_MMA(0, 0, At, B0); G8_BAR; G8_SCHED;
        G8_LDB(B1, 0, 1); G8_STAGE_B(0, 0, t + 2);
        G8_BAR; G8_WAIT_L(0); G8_MMA(0, 1, At, B1); G8_BAR;
        G8_LDA(At, 0, 1); G8_STAGE_A(0, 0, t + 2);
        G8_BAR; G8_WAIT_L(0); G8_MMA(1, 0, At, B0); G8_BAR; G8_SCHED;
        G8_STAGE_B(0, 1, t + 2);
        G8_WAIT_V(6); G8_BAR;
        float bgv[8];
        if constexpr (BG::ON) bg.read(smem, wid, lane, bgv);
        G8_MMA(1, 1, At, B1);
        if constexpr (BG::ON) bg.store(t >> 1, wid, lane, bgv);
        G8_BAR;
        G8_LDB(B0, 1, 0); G8_SCHED; G8_LDA(At, 1, 0); G8_STAGE_A(0, 1, t + 2);
        G8_WAIT_L(8); G8_BAR; G8_WAIT_L(0); G8_MMA(0, 0, At, B0); G8_BAR; G8_SCHED;
        G8_LDB(B1, 1, 1); G8_STAGE_B(1, 0, t + 3);
        if constexpr (BG::ON) { const int nx = (t >> 1) + 1; bg.issue(nx < ((nt - 2) >> 1) ? nx : ((nt - 2) >> 1) - 1, smem, wid, lane); }
        G8_BAR; G8_WAIT_L(0); G8_MMA(0, 1, At, B1); G8_BAR;
        G8_LDA(At, 1, 1); G8_STAGE_A(1, 0, t + 3);
        G8_BAR; G8_WAIT_L(0); G8_MMA(1, 0, At, B0); G8_BAR; G8_SCHED;
        G8_STAGE_B(1, 1, t + 3);
        if constexpr (BG::ON) { G8_WAIT_V(8); } else { G8_WAIT_V(6); }
        G8_BAR; G8_MMA(1, 1, At, B1); G8_BAR;
    }
    { G8_LDB(B0, 0, 0); G8_LDA(At, 0, 0); G8_STAGE_A(1, 1, nt - 1);
      G8_BAR; G8_WAIT_L(0); G8_MMA(0, 0, At, B0); G8_BAR;
      G8_LDB(B1, 0, 1); G8_BAR; G8_WAIT_L(0); G8_MMA(0, 1, At, B1); G8_BAR;
      G8_LDA(At, 0, 1); G8_WAIT_V(4); G8_BAR; G8_WAIT_L(0);
      G8_MMA(1, 0, At, B0); G8_MMA(1, 1, At, B1); G8_BAR; }
    { G8_LDB(B0, 1, 0); G8_LDA(At, 1, 0); G8_WAIT_V(2); G8_BAR; G8_WAIT_L(0); G8_MMA(0, 0, At, B0); G8_BAR;
      G8_LDB(B1, 1, 1); G8_WAIT_V(0); G8_BAR; G8_WAIT_L(0); G8_MMA(0, 1, At, B1); G8_BAR;
      G8_LDA(At, 1, 1); G8_BAR; G8_WAIT_L(0); G8_MMA(1, 0, At, B0); G8_MMA(1, 1, At, B1); G8_BAR; }
    if (wr == 0) G8_BAR;
    epi(acc, wr, wc, fr, fq);
}
struct NoMid8 { template <class ACC> __device__ __forceinline__ void operator()(int, ACC&, int, int, int) const {} };
struct NoBg { static constexpr bool ON = false; };
struct BgConv {
    static constexpr bool ON = true;
    const float* src0; long src_step;
    bf16_t* dst0; long dst_step;
    int chunk0;
    __device__ __forceinline__ void issue(int i, unsigned char* smem, int wave, int lane) const {
        const int c = __builtin_amdgcn_readfirstlane(chunk0 + 256 * i), m = c >> 10, kt = (c >> 5) & 31, n64 = c & 31;
        const GAS float* s = uniform_ptr(src0 + (long)(m >> 4) * src_step + (size_t)(m & 15) * 2048 * 2048 + (size_t)(kt * 64) * 2048 + n64 * 64);
        const int wv = __builtin_amdgcn_readfirstlane(wave);
        const unsigned voff = (unsigned)((lane >> 4) * 2048 + (((lane & 15) ^ wv) & 15) * 4);
        const GAS float* s0 = s + (size_t)(wv * 8) * 2048;
        const GAS float* s1 = s + (size_t)(wv * 8 + 4) * 2048;
        __builtin_amdgcn_global_load_lds((const GAS unsigned*)(s0 + voff), (LAS unsigned*)(smem + SM_CV + wv * 2048), 16, 0, 0);
        __builtin_amdgcn_global_load_lds((const GAS unsigned*)(s1 + voff), (LAS unsigned*)(smem + SM_CV + wv * 2048 + 1024), 16, 0, 0);
    }
    __device__ __forceinline__ void read(unsigned char* smem, int wave, int lane, float (&v)[8]) const {
        asm volatile("" ::: "memory");
        const int kg = lane & 7, n = wave * 8 + (lane >> 3);
        const float* cv = (const float*)(smem + SM_CV + kg * 2048 + ((((n >> 2) ^ kg) & 15) * 4 + (n & 3)) * 4);
#pragma unroll
        for (int j = 0; j < 8; ++j) v[j] = cv[j * 64];
    }
    __device__ __forceinline__ void store(int i, int wave, int lane, const float (&v)[8]) const {
        const int c = __builtin_amdgcn_readfirstlane(chunk0 + 256 * i), m = c >> 10, kt = (c >> 5) & 31, n64 = c & 31;
        const int wv = __builtin_amdgcn_readfirstlane(wave);
        GAS bf16_t* d = (GAS bf16_t*)uniform_ptr(dst0 + (long)(m >> 4) * dst_step + (size_t)(m & 15) * 2048 * 2048 + (size_t)(n64 * 64 + wv * 8) * 2048 + kt * 64);
        u32x4 w; w[0] = pk2(v[0], v[1]); w[1] = pk2(v[2], v[3]); w[2] = pk2(v[4], v[5]); w[3] = pk2(v[6], v[7]);
        *(GAS u32x4*)(d + (unsigned)((lane >> 3) * 2048 + (lane & 7) * 8)) = w;
    }
};
struct BHalves { const bf16_t* h0; const bf16_t* h1; int ld;
    __device__ __forceinline__ const bf16_t* half_base(int h) const { return h ? h1 : h0; }
    __device__ __forceinline__ unsigned row_off(int r) const { return (unsigned)r * (unsigned)ld; } };

#define BG_GU0 (32768 - 45 * 256)
#define BG_DN1 (60 * 256)
struct ConvItem { const float* s; bf16_t* d; int N, ldd; };
#define CV_SMALL 6656
#define CV_DN0 (CV_SMALL)
#define CV_GU0 (CV_DN0 + 2 * (16384 - BG_DN1))
#define CV_END (CV_GU0 + 2 * BG_GU0)
__device__ __forceinline__ ConvItem conv_decode(const MKParams& p, int it, int lane) {
    const int kg = lane & 7, n4 = (lane >> 3) << 2;
    const float* src; bf16_t* dst; int N, ldd, r;
    if (it < 4096) { src = p.w_in; dst = p.w_in_t; N = DIN_; ldd = XN_LD; r = it; }
    else if (it < 6144) { src = p.w_out; dst = p.w_out_t; N = D_; ldd = D_; r = it - 4096; }
    else if (it < 6656) { src = p.w_glu; dst = p.w_glu_t; N = DS_; ldd = DS_; r = it - 6144; }
    else {
        int which, e, rc, sub;
        if (it < CV_GU0) { const int j = it - CV_DN0, d = BG_DN1 + (j >> 1); sub = j & 1; which = 2; e = d >> 10; rc = d & 1023; }
        else { const int j = it - CV_GU0, s = j >> 1; sub = j & 1; which = s >> 14; e = (s >> 10) & 15; rc = s & 1023; }
        r = (rc >> 5) * 64 + (rc & 31) * 2 + sub; N = 2048; ldd = 2048;
        const size_t eo = (size_t)e * D_ * FF_;
        src = (which == 0 ? p.w_gate : (which == 1 ? p.w_up : p.w_down)) + eo;
        dst = (which == 0 ? p.w_gate_t : (which == 1 ? p.w_up_t : p.w_down_t)) + eo;
    }
    const int nn32 = N >> 5, kt = r / nn32, nt = r % nn32;
    ConvItem c;
    c.s = src + (size_t)(kt * 64 + kg * 8) * N + nt * 32 + n4;
    c.d = dst + (size_t)(nt * 32 + n4) * ldd + kt * 64 + kg * 8;
    c.N = N; c.ldd = ldd;
    return c;
}
__device__ __forceinline__ void conv_load(const ConvItem& c, f32x4 (&r)[8]) {
#pragma unroll
    for (int j = 0; j < 8; ++j) r[j] = *(const f32x4*)(c.s + (size_t)j * c.N);
}
__device__ __forceinline__ void conv_store(const ConvItem& c, const f32x4 (&r)[8]) {
#pragma unroll
    for (int i = 0; i < 4; ++i) {
        uint4 w; w.x = pk2(r[0][i], r[1][i]); w.y = pk2(r[2][i], r[3][i]); w.z = pk2(r[4][i], r[5][i]); w.w = pk2(r[6][i], r[7][i]);
        *(uint4*)(c.d + (size_t)i * c.ldd) = w;
    }
}
__device__ __forceinline__ void conv_range(const MKParams& p, int lo, int hi, int gw, int NGW, int lane) {
    int it = lo + gw;
    f32x4 r0[8], r1[8], r2[8], r3[8];
    ConvItem c0, c1, c2, c3;
    c0 = c1 = c2 = c3 = conv_decode(p, lo, lane);
    bool h0 = it < hi, h1 = it + NGW < hi, h2 = it + 2 * NGW < hi, h3 = it + 3 * NGW < hi;
    if (h0) { c0 = conv_decode(p, it, lane); conv_load(c0, r0); }
    if (h1) { c1 = conv_decode(p, it + NGW, lane); conv_load(c1, r1); }
    if (h2) { c2 = conv_decode(p, it + 2 * NGW, lane); conv_load(c2, r2); }
    if (h3) { c3 = conv_decode(p, it + 3 * NGW, lane); conv_load(c3, r3); }
    while (h0) {
        it += 4 * NGW;
        conv_store(c0, r0); h0 = it < hi;               if (h0) { c0 = conv_decode(p, it, lane); conv_load(c0, r0); }
        if (!h1) break;
        conv_store(c1, r1); h1 = it + NGW < hi;         if (h1) { c1 = conv_decode(p, it + NGW, lane); conv_load(c1, r1); }
        if (!h2) break;
        conv_store(c2, r2); h2 = it + 2 * NGW < hi;     if (h2) { c2 = conv_decode(p, it + 2 * NGW, lane); conv_load(c2, r2); }
        if (!h3) break;
        conv_store(c3, r3); h3 = it + 3 * NGW < hi;     if (h3) { c3 = conv_decode(p, it + 3 * NGW, lane); conv_load(c3, r3); }
    }
}
#define CV_P0_END (CV_GU0 + 13500)
#define CV_P3_END (CV_P0_END + 6800)
#define CV_P4_END (CV_P3_END + 14200)

template <bool TR>
struct EpiInProj8 {
    const MKParams& p; int m0, n0;
    __device__ __forceinline__ void operator()(f32x4 (&acc)[2][2][4][2], int wr, int wc, int fr, int fq) const {
#pragma unroll
        for (int ai = 0; ai < 2; ++ai)
#pragma unroll
            for (int m = 0; m < 4; ++m) {
                if (TR) {
                    const int token = m0 + ai * 128 + wr * 64 + m * 16 + fr;
                    const float rs = p.rstd_x[token];
#pragma unroll
                    for (int bj = 0; bj < 2; ++bj)
#pragma unroll
                        for (int n = 0; n < 2; ++n) {
                            const int col = n0 + bj * 128 + wc * 32 + n * 16 + fq * 4;
                            const f32x4 a = acc[ai][bj][m][n];
                            uint2 w;
                            if (n0 < 1024) {
                                w.x = pk2(a[0] * rs, a[1] * rs); w.y = pk2(a[2] * rs, a[3] * rs);
                                *(uint2*)(p.ua + ((size_t)(col >> 4) * 256 + (token >> 5)) * 768 + (token & 31) * 16 + (col & 15)) = w;
                            } else if (n0 < 2048) {
                                const float r8 = rs * 0.125f;
                                w.x = pk2(a[0] * r8, a[1] * r8); w.y = pk2(a[2] * r8, a[3] * r8);
                                *(uint2*)(p.qb + (size_t)token * 1024 + (col - 1024)) = w;
                            } else {
                                w.x = pk2(a[0] * rs, a[1] * rs); w.y = pk2(a[2] * rs, a[3] * rs);
                                *(uint2*)(p.kb + (size_t)token * 1024 + (col - 2048)) = w;
                            }
                        }
                } else {
                    const int token = m0 + ai * 128 + wr * 64 + m * 16 + fq * 4;
                    const float4 rs = *(const float4*)(p.rstd_x + token);
#pragma unroll
                    for (int bj = 0; bj < 2; ++bj)
#pragma unroll
                        for (int n = 0; n < 2; ++n) {
                            const int f = n0 - 3072 + bj * 128 + wc * 32 + n * 16 + fr;
                            const f32x4 a = acc[ai][bj][m][n];
                            uint2 w; w.x = pk2(a[0] * rs.x, a[1] * rs.y); w.y = pk2(a[2] * rs.z, a[3] * rs.w);
                            *(uint2*)(p.vT + (size_t)f * L_ + token) = w;
                        }
                }
            }
    }
};
struct MidOut8 {
    const float* rows;
    __device__ __forceinline__ void operator()(int t, f32x4 (&acc)[2][2][4][2], int wr, int fr, int fq) const {
        if (t == 16) {
#pragma unroll
            for (int ai = 0; ai < 2; ++ai)
#pragma unroll
                for (int m = 0; m < 4; ++m) {
                    const float ratio = rows[ai * 128 + wr * 64 + m * 16 + fr];
#pragma unroll
                    for (int bj = 0; bj < 2; ++bj)
#pragma unroll
                        for (int n = 0; n < 2; ++n) acc[ai][bj][m][n] *= ratio;
                }
        }
    }
};
struct EpiOut8 {
    const MKParams& p; const float* rows; int m0, n0, pn;
    __device__ __forceinline__ void operator()(f32x4 (&acc)[2][2][4][2], int wr, int wc, int fr, int fq) const {
#pragma unroll
        for (int ai = 0; ai < 2; ++ai)
#pragma unroll
            for (int m = 0; m < 4; ++m) {
                const int rt = ai * 128 + wr * 64 + m * 16 + fr, token = m0 + rt;
                const float rn = rows[256 + rt];
                float ss = 0.f;
#pragma unroll
                for (int bj = 0; bj < 2; ++bj)
#pragma unroll
                    for (int n = 0; n < 2; ++n) {
                        const int col = n0 + bj * 128 + wc * 32 + n * 16 + fq * 4;
                        const float4 xv = *(const float4*)(p.x + (size_t)token * D_ + col);
                        const float4 g = *(const float4*)(p.g_ffn + col);
                        const f32x4 a = acc[ai][bj][m][n];
                        const float v0 = xv.x + a[0] * rn, v1 = xv.y + a[1] * rn, v2 = xv.z + a[2] * rn, v3 = xv.w + a[3] * rn;
                        ss += v0 * v0 + v1 * v1 + v2 * v2 + v3 * v3;
                        uint2 w; w.x = pk2(v0 * g.x, v1 * g.y); w.y = pk2(v2 * g.z, v3 * g.w);
                        *(uint2*)(p.x1g + (size_t)token * D_ + col) = w;
                    }
                ss += __shfl_xor(ss, 16); ss += __shfl_xor(ss, 32);
                if (fq == 0) p.ssq_x1[token * 32 + pn * 4 + wc] = ss;
            }
    }
};
struct EpiMoe1_8 {
    const MKParams& p; int e, mt, nt;
    __device__ __forceinline__ void operator()(f32x4 (&acc)[2][2][4][2], int wr, int wc, int fr, int fq) const {
#pragma unroll
        for (int ai = 0; ai < 2; ++ai)
#pragma unroll
            for (int m = 0; m < 4; ++m) {
                const int slot = mt * 256 + ai * 128 + wr * 64 + m * 16 + fr;
                const float rs = p.rstd_x1[p.idx[e * CAP_ + slot]];
#pragma unroll
                for (int n = 0; n < 2; ++n) {
                    const f32x4 g = acc[ai][0][m][n] * rs, u = acc[ai][1][m][n] * rs;
                    float a[4];
#pragma unroll
                    for (int i = 0; i < 4; ++i) a[i] = g[i] / (1.f + __expf(-g[i])) * u[i];
                    uint2 w; w.x = pk2(a[0], a[1]); w.y = pk2(a[2], a[3]);
                    *(uint2*)(p.act + (size_t)(e * CAP_ + slot) * FF_ + nt * 128 + wc * 32 + n * 16 + fq * 4) = w;
                }
            }
    }
};
struct EpiMoe2_8 {
    const MKParams& p; int e, mt, nt;
    __device__ __forceinline__ void operator()(f32x4 (&acc)[2][2][4][2], int wr, int wc, int fr, int fq) const {
#pragma unroll
        for (int ai = 0; ai < 2; ++ai)
#pragma unroll
            for (int m = 0; m < 4; ++m) {
                const int slot = mt * 256 + ai * 128 + wr * 64 + m * 16 + fr;
                const float gt = p.gate[e * CAP_ + slot];
#pragma unroll
                for (int bj = 0; bj < 2; ++bj)
#pragma unroll
                    for (int n = 0; n < 2; ++n) {
                        const f32x4 a = acc[ai][bj][m][n] * gt;
                        uint2 w; w.x = pk2(a[0], a[1]); w.y = pk2(a[2], a[3]);
                        *(uint2*)(p.ye + (size_t)(e * CAP_ + slot) * D_ + nt * 256 + bj * 128 + wc * 32 + n * 16 + fq * 4) = w;
                    }
            }
    }
};

__device__ __forceinline__ void phase_prep(const MKParams& p, int gw, int NGW, int lane) {
    for (int row = gw; row < L_; row += NGW) {
        const float4* xr = (const float4*)(p.x + (size_t)row * D_);
        const float4* gr = (const float4*)p.g_mix;
        float s = 0.f;
        uint2* o = (uint2*)(p.xn + (size_t)row * XN_LD);
#pragma unroll
        for (int j = 0; j < 8; ++j) {
            const float4 v = xr[lane + 64 * j]; const float4 g = gr[lane + 64 * j];
            s += v.x * v.x + v.y * v.y + v.z * v.z + v.w * v.w;
            uint2 w; w.x = pk2(v.x * g.x, v.y * g.y); w.y = pk2(v.z * g.z, v.w * g.w);
            o[lane + 64 * j] = w;
        }
        s = wave_sum(s);
        if (lane == 0) p.rstd_x[row] = 1.0f / sqrtf(s * (1.0f / D_) + 1e-6f);
    }
    for (int i = gw * 64 + lane; i < NE_ * D_; i += NGW * 64) {
        const int e = i >> 11, n = i & (D_ - 1);
        const float w = p.w_router[n * NE_ + e];
        const unsigned hi = pk2(w, 0.f) & 0xffffu;
        const float rem = w - __uint_as_float(hi << 16);
        p.wrT[i] = (bf16_t)hi; p.wrT[NE_ * D_ + i] = (bf16_t)(pk2(rem, 0.f) & 0xffffu);
    }
}

__device__ __forceinline__ void phase_inproj(const MKParams& p, unsigned char* smem, int b) {
    for (int it = b; it < 512; it += gridDim.x) {
        const int xcd = it & 7, q = it >> 3;
        const int pn = (q & 1) * 8 + xcd;
        const int pm = q >> 1;
        const int m0 = pm * 256, n0 = pn * 256;
        ARows al{p.xn + (size_t)m0 * XN_LD, XN_LD};
        BHalves bl{p.w_in_t + (size_t)n0 * XN_LD, p.w_in_t + (size_t)(n0 + 128) * XN_LD, XN_LD};
        BgConv bg{p.w_gate, (long)(p.w_up - p.w_gate), p.w_gate_t, (long)(p.w_up_t - p.w_gate_t), BG_GU0 + (it >> 8) * 15 * 256 + (it & 255)};
        if (n0 < 3072) gemm8_tile<true>(smem, al, bl, D_ / 64, NoMid8{}, EpiInProj8<true>{p, m0, n0}, bg);
        else           gemm8_tile<false>(smem, al, bl, D_ / 64, NoMid8{}, EpiInProj8<false>{p, m0, n0}, bg);
    }
}

#define UA_LD 768
#define WSYNC() asm volatile("s_waitcnt lgkmcnt(0)" ::: "memory")
__device__ __forceinline__ void tw_sync(volatile LAS unsigned* cnt, unsigned& epoch, int lane) {
    WSYNC();
    if (lane == 0) __hip_atomic_fetch_add((LAS unsigned*)cnt, 1u, __ATOMIC_RELEASE, __HIP_MEMORY_SCOPE_WORKGROUP);
    ++epoch;
    while (__hip_atomic_load((LAS unsigned*)cnt, __ATOMIC_ACQUIRE, __HIP_MEMORY_SCOPE_WORKGROUP) < 4u * epoch) __builtin_amdgcn_s_sleep(1);
    asm volatile("" ::: "memory");
}
__device__ __forceinline__ void ssm_tables(const MKParams& p, unsigned char* smem, int g, int part, int tw, int lane, volatile LAS unsigned* cnt, unsigned& epoch) {
    float2* apow = (float2*)(smem + SM_GEMM);
    float2* bbar = apow + 2 * 33 * 64;
    float2* cc = bbar + 2 * 64 * 16;
    float* taps = (float*)(cc + 2 * 16 * 64);
    if (tw < 2) {
        const int d = tw;
        const int pp = lane;
        const float lr = (d ? p.a_re_b : p.a_re_f)[g * 64 + pp], li = (d ? p.a_im_b : p.a_im_f)[g * 64 + pp];
        const float dt = expf((d ? p.ldt_b : p.ldt_f)[g]);
        const float x = lr * dt, y = li * dt;
        const float ex = expf(x), cy = cosf(y), sy = sinf(y), sh = sinf(0.5f * y);
        const float ar = ex * cy, ai = ex * sy;
        float sr = 1.f, si = 0.f;
        for (int t = 0; t <= 32; ++t) {
            apow[(d * 33 + t) * 64 + pp] = make_float2(sr, si);
            const float nr = sr * ar - si * ai, ni = sr * ai + si * ar; sr = nr; si = ni;
        }
        if (part == 0) *(float2*)(p.A32 + ((size_t)(g * 2 + d) * 64 + pp) * 2) = apow[(d * 33 + 32) * 64 + pp];
        const float nr = expm1f(x) * cy - 2.f * sh * sh, ni = ex * sy;
        const float den = lr * lr + li * li;
        const float fr_ = (nr * lr + ni * li) / den, fi_ = (ni * lr - nr * li) / den;
        const float* brp = (d ? p.b_re_b : p.b_re_f) + (g * 64 + pp) * 16;
        const float* bip = (d ? p.b_im_b : p.b_im_f) + (g * 64 + pp) * 16;
#pragma unroll
        for (int q4 = 0; q4 < 4; ++q4) {
            const float4 br = *(const float4*)(brp + q4 * 4), bi = *(const float4*)(bip + q4 * 4);
            float2* o = bbar + (d * 64 + pp) * 16 + q4 * 4;
            o[0] = make_float2(fr_ * br.x - fi_ * bi.x, fr_ * bi.x + fi_ * br.x);
            o[1] = make_float2(fr_ * br.y - fi_ * bi.y, fr_ * bi.y + fi_ * br.y);
            o[2] = make_float2(fr_ * br.z - fi_ * bi.z, fr_ * bi.z + fi_ * br.z);
            o[3] = make_float2(fr_ * br.w - fi_ * bi.w, fr_ * bi.w + fi_ * br.w);
        }
        const float* crp = (d ? p.c_re_b : p.c_re_f) + (g * 16) * 64 + pp;
        const float* cip = (d ? p.c_im_b : p.c_im_f) + (g * 16) * 64 + pp;
#pragma unroll
        for (int co = 0; co < 16; ++co) cc[(d * 16 + co) * 64 + pp] = make_float2(crp[co * 64], cip[co * 64]);
    }
    tw_sync(cnt, epoch, lane);
    {
        const int li_ = lane & 15, lk = lane >> 4;
#pragma unroll 1
        for (int co = tw * 4; co < tw * 4 + 4; ++co) {
#pragma unroll 1
            for (int d = 0; d < 2; ++d) {
                f32x4 acc0 = (f32x4){0.f, 0.f, 0.f, 0.f}, acc1 = acc0;
#pragma unroll 4
                for (int s = 0; s < 32; ++s) {
                    const int q = 2 * s + (lk >> 1), ri = lk & 1;
                    const float2 c = cc[(d * 16 + co) * 64 + q], bb = bbar[(d * 64 + q) * 16 + li_];
                    const float gb = ri ? -(c.x * bb.y + c.y * bb.x) : (c.x * bb.x - c.y * bb.y);
                    const float2 a0 = apow[(d * 33 + li_) * 64 + q], a1 = apow[(d * 33 + 16 + li_) * 64 + q];
                    acc0 = __builtin_amdgcn_mfma_f32_16x16x4f32(ri ? a0.y : a0.x, gb, acc0, 0, 0, 0);
                    acc1 = __builtin_amdgcn_mfma_f32_16x16x4f32(ri ? a1.y : a1.x, gb, acc1, 0, 0, 0);
                }
#pragma unroll
                for (int r = 0; r < 4; ++r) {
                    const int t0 = 4 * lk + r, t1 = 16 + 4 * lk + r;
                    float* p0 = taps + ((d ? 31 - t0 : 31 + t0) * 16 + co) * 16 + li_;
                    float* p1 = taps + ((d ? 31 - t1 : 31 + t1) * 16 + co) * 16 + li_;
                    if (d == 1 && t0 == 0) *p0 += acc0[r]; else *p0 = acc0[r];
                    *p1 = acc1[r];
                }
            }
        }
    }
    tw_sync(cnt, epoch, lane);
#pragma unroll 1
    for (int it = lane; it < 32 * 96; it += 64) {
        const int n = part * 128 + tw * 32 + it / 96, k = (it % 96) * 8;
        const int l = n >> 4, co = n & 15;
        float v[8];
        if (k < 512) {
            const int j = k >> 4, ci0 = ((k >> 3) & 1) * 8;
            const float* tp = taps + ((l - j + 31) * 16 + co) * 16 + ci0;
#pragma unroll
            for (int q = 0; q < 8; ++q) v[q] = tp[q];
        } else {
            const int k2 = k - 512, d = k2 >> 7, pp0 = (k2 >> 1) & 63;
            const int t = d ? (32 - l) : (l + 1);
#pragma unroll
            for (int q = 0; q < 4; ++q) {
                const float2 a = apow[(d * 33 + t) * 64 + pp0 + q], c = cc[(d * 16 + co) * 64 + pp0 + q];
                v[2 * q] = c.x * a.x - c.y * a.y; v[2 * q + 1] = -(c.x * a.y + c.y * a.x);
            }
        }
        uint4 w; w.x = pk2(v[0], v[1]); w.y = pk2(v[2], v[3]); w.z = pk2(v[4], v[5]); w.w = pk2(v[6], v[7]);
        *(uint4*)(p.WyT + ((size_t)g * 512 + n) * UA_LD + k) = w;
    }
#pragma unroll 1
    for (int it = lane; it < 16 * 64; it += 64) {
        const int n2 = part * 64 + tw * 16 + (it >> 6), kc = it & 63;
        const int d = n2 >> 7, pp = (n2 >> 1) & 63, ri = n2 & 1, j = kc >> 1, half = kc & 1;
        const int t = d ? j : 31 - j;
        const float2 a = apow[(d * 33 + t) * 64 + pp];
        const float2* bp = bbar + (d * 64 + pp) * 16 + half * 8;
        float v[8];
#pragma unroll
        for (int q = 0; q < 8; ++q) { const float2 b = bp[q]; v[q] = ri ? (a.x * b.y + a.y * b.x) : (a.x * b.x - a.y * b.y); }
        uint4 w; w.x = pk2(v[0], v[1]); w.y = pk2(v[2], v[3]); w.z = pk2(v[4], v[5]); w.w = pk2(v[6], v[7]);
        *(uint4*)(p.PBt + ((size_t)g * 256 + n2) * 512 + kc * 8) = w;
    }
    tw_sync(cnt, epoch, lane);
}

#define SE_PITCH 132
struct EpiSsmE {
    const MKParams& p; unsigned char* smem; int g;
    __device__ __forceinline__ void operator()(f32x4 (&acc)[2][2][4][2], int wr, int wc, int fr, int fq) const {
        float* E = (float*)(smem + SM_GEMM);
        const int tid = opaque_tid();
#pragma unroll
        for (int d = 0; d < 2; ++d) {
            __syncthreads();
#pragma unroll
            for (int ai = 0; ai < 2; ++ai)
#pragma unroll
                for (int m = 0; m < 4; ++m)
#pragma unroll
                    for (int n = 0; n < 2; ++n)
                        *(f32x4*)(E + (ai * 128 + wr * 64 + m * 16 + fr) * SE_PITCH + wc * 32 + n * 16 + fq * 4) = acc[ai][d][m][n];
            __syncthreads();
            if (tid < 64) {
                const int pp = tid;
                const float2 A = *(const float2*)(p.A32 + ((size_t)(g * 2 + d) * 64 + pp) * 2);
                bf16_t* sdst = p.ua + (size_t)g * 256 * UA_LD + 512 + d * 128 + pp * 2;
                float sr = 0.f, si = 0.f;
#pragma unroll 8
                for (int s = 0; s < 256; ++s) {
                    const int c = d ? (255 - s) : s;
                    const float2 e = *(const float2*)(E + c * SE_PITCH + pp * 2);
                    *(unsigned*)(sdst + (size_t)c * UA_LD) = pk2(sr, si);
                    const float nr = A.x * sr - A.y * si + e.x, ni = A.x * si + A.y * sr + e.y;
                    sr = nr; si = ni;
                }
            }
        }
    }
};
__device__ __forceinline__ void ssm_e_item(const MKParams& p, unsigned char* smem, int g) {
    ARows al{p.ua + (size_t)g * 256 * UA_LD, UA_LD};
    BHalves bl{p.PBt + (size_t)g * 256 * 512, p.PBt + ((size_t)g * 256 + 128) * 512, 512};
    gemm8_tile<true>(smem, al, bl, 8, NoMid8{}, EpiSsmE{p, smem, g}, NoBg{});
}

__device__ __forceinline__ float gelu_tanh_f(float x) {
    const float k0 = 0.7978845608028654f, k1 = 0.044715f;
    const float z = k0 * (x + k1 * x * x * x);
    const float e = __expf(2.f * z);
    return 0.5f * x * (2.f - 2.f / (1.f + e));
}
struct EpiSsmY {
    const MKParams& p; int g, nh;
    __device__ __forceinline__ void operator()(f32x4 (&acc)[2][2][4][2], int wr, int wc, int fr, int fq) const {
        const float4 dsk = *(const float4*)(p.ssm_d + g * 16 + fq * 4);
#pragma unroll
        for (int ai = 0; ai < 2; ++ai)
#pragma unroll
            for (int m = 0; m < 4; ++m) {
                const int c = ai * 128 + wr * 64 + m * 16 + fr;
                const bf16_t* urow = p.ua + ((size_t)g * 256 + c) * UA_LD + fq * 4;
#pragma unroll
                for (int bj = 0; bj < 2; ++bj)
#pragma unroll
                    for (int n = 0; n < 2; ++n) {
                        const int l = nh * 16 + bj * 8 + wc * 2 + n;
                        const uint2 uu = *(const uint2*)(urow + l * 16);
                        const f32x4 a = acc[ai][bj][m][n];
                        const float y0 = gelu_tanh_f(a[0] + dsk.x * bflo(uu.x)), y1 = gelu_tanh_f(a[1] + dsk.y * bfhi(uu.x));
                        const float y2 = gelu_tanh_f(a[2] + dsk.z * bflo(uu.y)), y3 = gelu_tanh_f(a[3] + dsk.w * bfhi(uu.y));
                        uint2 w; w.x = pk2(y0, y1); w.y = pk2(y2, y3);
                        *(uint2*)(p.ypre + (size_t)(c * 32 + l) * DS_ + g * 16 + fq * 4) = w;
                    }
            }
    }
};
__device__ __forceinline__ void ssm_y_item(const MKParams& p, unsigned char* smem, int g, int nh) {
    ARows al{p.ua + (size_t)g * 256 * UA_LD, UA_LD};
    BHalves bl{p.WyT + ((size_t)g * 512 + nh * 256) * UA_LD, p.WyT + ((size_t)g * 512 + nh * 256 + 128) * UA_LD, UA_LD};
    gemm8_tile<true>(smem, al, bl, 12, NoMid8{}, EpiSsmY{p, g, nh}, NoBg{});
}

#define NA_RPB (SM_GEMM + 1024)
__device__ __forceinline__ void na_item(const MKParams& p, unsigned char* smem, int r, int hq) {
    int tid_ = threadIdx.x; asm volatile("" : "+v"(tid_));
    const int tid = tid_, lane = tid & 63, wave = tid >> 6, fr = lane & 15, fq = lane >> 4;
    const int h = hq * 4 + (wave >> 1), qh = wave & 1;
    int rs = r - 4; rs = rs < 0 ? 0 : (rs > 120 ? 120 : rs);
    bf16x8 qf[2][2];
#pragma unroll
    for (int qb = 0; qb < 2; ++qb)
#pragma unroll
        for (int ks = 0; ks < 2; ++ks) qf[qb][ks] = *(const bf16x8*)(p.qb + (size_t)(r * 64 + (2 * qh + qb) * 16 + fr) * 1024 + h * 64 + ks * 32 + fq * 8);
    int kbq[2], dxq[2];
#pragma unroll
    for (int qb = 0; qb < 2; ++qb) {
        const int c = (2 * qh + qb) * 16 + fr;
        int cs = c - 8; cs = cs < 0 ? 0 : (cs > 48 ? 48 : cs);
        kbq[qb] = 8 * fq - cs;
        dxq[qb] = (8 * fq - c + 15) * 4;
    }
    f32x4 o[2][4];
    float mrow[2], lrow[2];
#pragma unroll
    for (int qb = 0; qb < 2; ++qb) {
        mrow[qb] = -1e30f; lrow[qb] = 0.f;
#pragma unroll
        for (int mt = 0; mt < 4; ++mt) o[qb][mt] = (f32x4){0.f, 0.f, 0.f, 0.f};
    }
    const int krow_lane = (8 * (fr >> 2) + (fr & 3)) * 1024 + h * 64 + fq * 8;
    const size_t v_lane = (size_t)(h * 64 + fr) * L_ + 8 * fq;
    bf16x8 kf[2][2][2], vf[2][4];
    {
        const bf16_t* kbase = p.kb + (size_t)(rs * 64) * 1024 + krow_lane;
#pragma unroll
        for (int P = 0; P < 2; ++P)
#pragma unroll
            for (int sx = 0; sx < 2; ++sx)
#pragma unroll
                for (int ks = 0; ks < 2; ++ks) kf[P][sx][ks] = *(const bf16x8*)(kbase + (32 * P + 4 * sx) * 1024 + ks * 32);
#pragma unroll
        for (int P = 0; P < 2; ++P)
#pragma unroll
            for (int mt = 0; mt < 4; ++mt) vf[P][mt] = *(const bf16x8*)(p.vT + v_lane + (size_t)mt * 16 * L_ + rs * 64 + 32 * P);
    }
#pragma unroll 1
    for (int i = 0; i < 8; ++i) {
        const int inx = i < 7 ? i + 1 : 7;
        const int tokn = (rs + inx) * 64;
        const unsigned char* brow = smem + NA_RPB + ((h * 15 + (rs + i - r + 7)) * 31) * 4;
        f32x4 s[2][2][2];
#pragma unroll
        for (int P = 0; P < 2; ++P)
#pragma unroll
            for (int sx = 0; sx < 2; ++sx)
#pragma unroll
                for (int qb = 0; qb < 2; ++qb) {
                    f32x4 a = (f32x4){0.f, 0.f, 0.f, 0.f};
                    a = __builtin_amdgcn_mfma_f32_16x16x32_bf16(kf[P][sx][0], qf[qb][0], a, 0, 0, 0);
                    a = __builtin_amdgcn_mfma_f32_16x16x32_bf16(kf[P][sx][1], qf[qb][1], a, 0, 0, 0);
                    s[P][sx][qb] = a;
                }
        {
            const bf16_t* kbase = p.kb + (size_t)tokn * 1024 + krow_lane;
#pragma unroll
            for (int P = 0; P < 2; ++P)
#pragma unroll
                for (int sx = 0; sx < 2; ++sx)
#pragma unroll
                    for (int ks = 0; ks < 2; ++ks) kf[P][sx][ks] = *(const bf16x8*)(kbase + (32 * P + 4 * sx) * 1024 + ks * 32);
        }
        unsigned pp[2][2][4];
#pragma unroll
        for (int qb = 0; qb < 2; ++qb) {
            const unsigned char* bq = brow + dxq[qb];
            float bv[16];
#pragma unroll
            for (int c16 = 0; c16 < 16; ++c16) bv[c16] = *(const float*)(bq + (32 * (c16 >> 3) + 4 * ((c16 >> 2) & 1) + (c16 & 3)) * 4);
            asm volatile("" : "+v"(bv[0]), "+v"(bv[1]), "+v"(bv[2]), "+v"(bv[3]), "+v"(bv[4]), "+v"(bv[5]), "+v"(bv[6]), "+v"(bv[7]),
                              "+v"(bv[8]), "+v"(bv[9]), "+v"(bv[10]), "+v"(bv[11]), "+v"(bv[12]), "+v"(bv[13]), "+v"(bv[14]), "+v"(bv[15]));
            float mx = -1e30f;
#pragma unroll
            for (int P = 0; P < 2; ++P)
#pragma unroll
                for (int sx = 0; sx < 2; ++sx)
#pragma unroll
                    for (int rg = 0; rg < 4; ++rg) {
                        const int cst = 32 * P + 4 * sx + rg;
                        const bool valid = (unsigned)(cst + kbq[qb]) < 16u;
                        const float v = valid ? (s[P][sx][qb][rg] + bv[P * 8 + sx * 4 + rg]) : -1e30f;
                        s[P][sx][qb][rg] = v;
                        mx = fmaxf(mx, v);
                    }
            mx = fmaxf(mx, __shfl_xor(mx, 16));
            mx = fmaxf(mx, __shfl_xor(mx, 32));
            const float mn = fmaxf(mrow[qb], mx);
            const float alpha = __expf(mrow[qb] - mn);
            mrow[qb] = mn;
            float ls = 0.f;
#pragma unroll
            for (int P = 0; P < 2; ++P)
#pragma unroll
                for (int sx = 0; sx < 2; ++sx) {
                    float e[4];
#pragma unroll
                    for (int rg = 0; rg < 4; ++rg) { e[rg] = __expf(s[P][sx][qb][rg] - mn); ls += e[rg]; }
                    pp[qb][P][sx * 2 + 0] = pk2(e[0], e[1]);
                    pp[qb][P][sx * 2 + 1] = pk2(e[2], e[3]);
                }
            lrow[qb] = lrow[qb] * alpha + ls;
#pragma unroll
            for (int mt = 0; mt < 4; ++mt) o[qb][mt] *= alpha;
        }
#pragma unroll
        for (int P = 0; P < 2; ++P)
#pragma unroll
            for (int mt = 0; mt < 4; ++mt)
#pragma unroll
                for (int qb = 0; qb < 2; ++qb) {
                    uint4 w; w.x = pp[qb][P][0]; w.y = pp[qb][P][1]; w.z = pp[qb][P][2]; w.w = pp[qb][P][3];
                    o[qb][mt] = __builtin_amdgcn_mfma_f32_16x16x32_bf16(vf[P][mt], __builtin_bit_cast(bf16x8, w), o[qb][mt], 0, 0, 0);
                }
#pragma unroll
        for (int P = 0; P < 2; ++P)
#pragma unroll
            for (int mt = 0; mt < 4; ++mt) vf[P][mt] = *(const bf16x8*)(p.vT + v_lane + (size_t)mt * 16 * L_ + tokn + 32 * P);
    }
#pragma unroll
    for (int qb = 0; qb < 2; ++qb) {
        float l = lrow[qb];
        l += __shfl_xor(l, 16); l += __shfl_xor(l, 32);
        const float inv = 1.f / l;
        const int token = r * 64 + (2 * qh + qb) * 16 + fr;
        float ss = 0.f;
#pragma unroll
        for (int mt = 0; mt < 4; ++mt) {
            const float4 g = *(const float4*)(p.g_na + h * 64 + mt * 16 + 4 * fq);
            const f32x4 v = o[qb][mt] * inv;
            ss += v[0] * v[0] + v[1] * v[1] + v[2] * v[2] + v[3] * v[3];
            uint2 w; w.x = pk2(v[0] * g.x, v[1] * g.y); w.y = pk2(v[2] * g.z, v[3] * g.w);
            *(uint2*)(p.ymix + (size_t)token * D_ + DS_ + h * 64 + mt * 16 + 4 * fq) = w;
        }
        ss += __shfl_xor(ss, 16); ss += __shfl_xor(ss, 32);
        if (fq == 0) p.ssq_na[token * 16 + h] = ss;
    }
}
#define NA_ITEMS 512
__device__ __forceinline__ void phase2(const MKParams& p, unsigned char* smem, int b, int G, unsigned* counter) {
    for (int it = b; it < 64; it += G) ssm_e_item(p, smem, it);
    __syncthreads();
    const int tq = opaque_tid();
    { float* dst = (float*)(smem + NA_RPB); for (int i = tq; i < 16 * 15 * 31; i += NT_) dst[i] = p.rpb[i]; }
    volatile LAS int* slot = (volatile LAS int*)(smem + 32);
    for (;;) {
        __syncthreads();
        if (tq == 0) *slot = (int)__hip_atomic_fetch_add(counter, 1u, __ATOMIC_RELAXED, __HIP_MEMORY_SCOPE_AGENT);
        __syncthreads();
        const int j = *slot;
        if (j >= NA_ITEMS) break;
        na_item(p, smem, j >> 2, j & 3);
    }
}

struct EpiGlu8 {
    const MKParams& p; int m0, n0, pn;
    __device__ __forceinline__ void operator()(f32x4 (&acc)[2][2][4][2], int wr, int wc, int fr, int fq) const {
#pragma unroll
        for (int ai = 0; ai < 2; ++ai)
#pragma unroll
            for (int m = 0; m < 4; ++m) {
                const int token = m0 + ai * 128 + wr * 64 + m * 16 + fr;
                float ss = 0.f;
#pragma unroll
                for (int bj = 0; bj < 2; ++bj)
#pragma unroll
                    for (int n = 0; n < 2; ++n) {
                        const int col = n0 + bj * 128 + wc * 32 + n * 16 + fq * 4;
                        const float4 b = *(const float4*)(p.b_glu + col);
                        const float4 g = *(const float4*)(p.g_ssm + col);
                        const uint2 yy = *(const uint2*)(p.ypre + (size_t)token * DS_ + col);
                        const f32x4 a = acc[ai][bj][m][n];
                        const float y0 = bflo(yy.x) / (1.f + __expf(-(a[0] + b.x))), y1 = bfhi(yy.x) / (1.f + __expf(-(a[1] + b.y)));
                        const float y2 = bflo(yy.y) / (1.f + __expf(-(a[2] + b.z))), y3 = bfhi(yy.y) / (1.f + __expf(-(a[3] + b.w)));
                        ss += y0 * y0 + y1 * y1 + y2 * y2 + y3 * y3;
                        uint2 w; w.x = pk2(y0 * g.x, y1 * g.y); w.y = pk2(y2 * g.z, y3 * g.w);
                        *(uint2*)(p.ymix + (size_t)token * D_ + col) = w;
                    }
                ss += __shfl_xor(ss, 16); ss += __shfl_xor(ss, 32);
                if (fq == 0) p.ssq_ssm[token * 16 + pn * 4 + wc] = ss;
            }
    }
};
__device__ __forceinline__ void glu_item(const MKParams& p, unsigned char* smem, int it) {
    const int pn = it & 3, pm = it >> 2;
    const int m0 = pm * 256, n0 = pn * 256;
    ARows al{p.ypre + (size_t)m0 * DS_, DS_};
    BHalves bl{p.w_glu_t + (size_t)n0 * DS_, p.w_glu_t + (size_t)(n0 + 128) * DS_, DS_};
    gemm8_tile<true>(smem, al, bl, DS_ / 64, NoMid8{}, EpiGlu8{p, m0, n0, pn}, NoBg{});
}

__device__ __forceinline__ float rstd16(const float* part) {
    const float4 a = ((const float4*)part)[0], b = ((const float4*)part)[1], c = ((const float4*)part)[2], d = ((const float4*)part)[3];
    const float s = ((a.x + a.y) + (a.z + a.w)) + ((b.x + b.y) + (b.z + b.w)) + ((c.x + c.y) + (c.z + c.w)) + ((d.x + d.y) + (d.z + d.w));
    return 1.0f / sqrtf(s * (1.0f / DS_) + 1e-6f);
}
struct MidOut {
    const float* rows;
    __device__ __forceinline__ void operator()(int kt, f32x4 (&acc)[8][4], int wr, int fr, int fq) const {
        if (kt == 16) {
#pragma unroll
            for (int m = 0; m < 8; ++m) {
                const float ratio = rows[wr * 128 + m * 16 + fr];
#pragma unroll
                for (int nn = 0; nn < 4; ++nn) acc[m][nn] *= ratio;
            }
        }
    }
};
struct EpiOut {
    const MKParams& p; const float* rows; int m0, n0, pn;
    __device__ __forceinline__ void operator()(f32x4 (&acc)[8][4], int wr, int wc, int fr, int fq) const {
#pragma unroll
        for (int m = 0; m < 8; ++m) {
            const int token = m0 + wr * 128 + m * 16 + fr;
            const float rn = rows[256 + wr * 128 + m * 16 + fr];
            float ss = 0.f;
#pragma unroll
            for (int nn = 0; nn < 4; ++nn) {
                const int col = n0 + wc * 64 + nn * 16 + fq * 4;
                const float4 xv = *(const float4*)(p.x + (size_t)token * D_ + col);
                const float4 g = *(const float4*)(p.g_ffn + col);
                const f32x4 a = acc[m][nn];
                const float v0 = xv.x + a[0] * rn, v1 = xv.y + a[1] * rn, v2 = xv.z + a[2] * rn, v3 = xv.w + a[3] * rn;
                ss += v0 * v0 + v1 * v1 + v2 * v2 + v3 * v3;
                uint2 w; w.x = pk2(v0 * g.x, v1 * g.y); w.y = pk2(v2 * g.z, v3 * g.w);
                *(uint2*)(p.x1g + (size_t)token * D_ + col) = w;
            }
            ss += __shfl_xor(ss, 16); ss += __shfl_xor(ss, 32);
            if (fq == 0) p.ssq_x1[token * 32 + pn * 4 + wc] = ss;
        }
    }
};
__device__ __forceinline__ void outproj_item(const MKParams& p, unsigned char* smem, int it) {
    const int pn = it & 7, pm = it >> 3;
    const int m0 = pm * 256, n0 = pn * 256;
    float* rows = (float*)(smem + SM_ROWS);
    __syncthreads();
    const int tq = opaque_tid();
    if (tq < 256) {
        const int token = m0 + tq;
        const float rs = rstd16(p.ssq_ssm + token * 16), rn = rstd16(p.ssq_na + token * 16);
        rows[tq] = rs / rn; rows[256 + tq] = rn;
    }
    ARows al{p.ymix + (size_t)m0 * D_, D_};
    BHalves bl{p.w_out_t + (size_t)n0 * D_, p.w_out_t + (size_t)(n0 + 128) * D_, D_};
    BgConv bg{p.w_gate, (long)(p.w_up - p.w_gate), p.w_gate_t, (long)(p.w_up_t - p.w_gate_t), BG_GU0 + 30 * 256 + it};
    gemm8_tile<true>(smem, al, bl, D_ / 64, MidOut8{rows}, EpiOut8{p, rows, m0, n0, pn}, bg);
}

#define RT_PART (SM_GEMM)
__device__ __forceinline__ void router_item(const MKParams& p, unsigned char* smem, int item) {
    const int tid = opaque_tid(), lane = tid & 63, wave = tid >> 6, fr = lane & 15, fq = lane >> 4;
    const int tile = item * 2 + (wave >> 2), kq = wave & 3;
    const int token = tile * 16 + fr;
    const bf16_t* xr = p.x1g + (size_t)token * D_ + kq * 512 + fq * 8;
    const bf16_t* wh = p.wrT + (size_t)fr * D_ + kq * 512 + fq * 8;
    const bf16_t* wl = wh + 16 * D_;
    f32x4 ah = (f32x4){0.f, 0.f, 0.f, 0.f}, alo = (f32x4){0.f, 0.f, 0.f, 0.f};
#pragma unroll 8
    for (int k = 0; k < 512; k += 32) {
        const bf16x8 xb = *(const bf16x8*)(xr + k);
        ah = __builtin_amdgcn_mfma_f32_16x16x32_bf16(*(const bf16x8*)(wh + k), xb, ah, 0, 0, 0);
        alo = __builtin_amdgcn_mfma_f32_16x16x32_bf16(*(const bf16x8*)(wl + k), xb, alo, 0, 0, 0);
    }
    f32x4* part = (f32x4*)(smem + RT_PART);
    __syncthreads();
    part[wave * 64 + lane] = ah + alo;
    __syncthreads();
    if (kq == 0) {
        const f32x4 t = part[wave * 64 + lane] + part[(wave + 1) * 64 + lane] + part[(wave + 2) * 64 + lane] + part[(wave + 3) * 64 + lane];
        const float4 s0 = *(const float4*)(p.ssq_x1 + token * 32 + fq * 8), s1 = *(const float4*)(p.ssq_x1 + token * 32 + fq * 8 + 4);
        float ss = ((s0.x + s0.y) + (s0.z + s0.w)) + ((s1.x + s1.y) + (s1.z + s1.w));
        ss += __shfl_xor(ss, 16); ss += __shfl_xor(ss, 32);
        const float rs = 1.0f / sqrtf(ss * (1.0f / D_) + 1e-6f);
        float l[4];
#pragma unroll
        for (int i = 0; i < 4; ++i) l[i] = t[i] * rs;
        float mx = fmaxf(fmaxf(l[0], l[1]), fmaxf(l[2], l[3]));
        mx = fmaxf(mx, __shfl_xor(mx, 16)); mx = fmaxf(mx, __shfl_xor(mx, 32));
        float e[4], sum = 0.f;
#pragma unroll
        for (int i = 0; i < 4; ++i) { e[i] = expf(l[i] - mx); sum += e[i]; }
        sum += __shfl_xor(sum, 16); sum += __shfl_xor(sum, 32);
        const float inv = 1.f / sum;
#pragma unroll
        for (int i = 0; i < 4; ++i) {
            const float a = e[i] * inv;
            p.aff_t[(size_t)(4 * fq + i) * L_ + token] = a;
            atomicAdd(p.ahist + (4 * fq + i) * 4096 + (__float_as_uint(a) >> 19), 1u);
        }
        if (fq == 0) p.rstd_x1[token] = rs;
    }
}

#define TK_MISC (SM_GEMM)
#define TK_SUF  (SM_GEMM + 64)
#define TK_LIST (SM_GEMM + 1024)
__device__ __forceinline__ void topk_item(const MKParams& p, unsigned char* smem, int e) {
    const int tid = opaque_tid(), lane = tid & 63, wave = tid >> 6;
    unsigned* misc = (unsigned*)(smem + TK_MISC);
    unsigned* wsum = (unsigned*)(smem + TK_SUF);
    uint2* list = (uint2*)(smem + TK_LIST);
    const float* a = p.aff_t + (size_t)e * L_;
    unsigned key[16];
#pragma unroll
    for (int i = 0; i < 16; ++i) key[i] = __float_as_uint(a[tid + NT_ * i]);
    const uint4 h0 = *(const uint4*)(p.ahist + e * 4096 + tid * 8), h1 = *(const uint4*)(p.ahist + e * 4096 + tid * 8 + 4);
    const unsigned hb[8] = {h0.x, h0.y, h0.z, h0.w, h1.x, h1.y, h1.z, h1.w};
    unsigned own = 0;
#pragma unroll
    for (int i = 0; i < 8; ++i) own += hb[i];
    unsigned suf = own;
#pragma unroll
    for (int o = 1; o < 64; o <<= 1) { const unsigned t = __shfl_down(suf, o); if (lane + o < 64) suf += t; }
    __syncthreads();
    if (lane == 0) wsum[wave] = suf;
    if (tid == 0) { misc[2] = 0u; misc[3] = 0u; }
    __syncthreads();
    unsigned above = suf - own;
#pragma unroll
    for (int w = 0; w < 8; ++w) if (w > wave) above += wsum[w];
    if (above < (unsigned)CAP_ && (unsigned)CAP_ <= above + own) {
        unsigned cnt = above;
#pragma unroll
        for (int i = 7; i >= 0; --i) {
            if (cnt < (unsigned)CAP_ && (unsigned)CAP_ <= cnt + hb[i]) { misc[0] = (unsigned)(tid * 8 + i); misc[1] = (unsigned)CAP_ - cnt; }
            cnt += hb[i];
        }
    }
    __syncthreads();
    const unsigned T = misc[0], need = misc[1];
#pragma unroll
    for (int i = 0; i < 16; ++i)
        if ((key[i] >> 19) == T) { const unsigned s = atomicAdd(&misc[3], 1u); list[s] = make_uint2(key[i], (unsigned)(tid + NT_ * i)); }
    __syncthreads();
    const unsigned nc = misc[3];
#pragma unroll
    for (int i = 0; i < 16; ++i) {
        const int token = tid + NT_ * i;
        const unsigned bin = key[i] >> 19;
        if (bin != T) {
            int slot = -1;
            if (bin > T) {
                slot = (int)atomicAdd(&misc[2], 1u);
                p.idx[e * CAP_ + slot] = token;
                p.gate[e * CAP_ + slot] = __uint_as_float(key[i]);
            }
            p.slot_of[token * NE_ + e] = slot;
        }
    }
    for (unsigned c0 = tid; c0 < nc; c0 += NT_) {
        const uint2 me = list[c0];
        unsigned rank = 0;
        unsigned j = 0;
        for (; j + 4 <= nc; j += 4) {
            const uint2 a0 = list[j], a1 = list[j + 1], a2 = list[j + 2], a3 = list[j + 3];
            rank += (a0.x > me.x || (a0.x == me.x && a0.y < me.y)) ? 1u : 0u;
            rank += (a1.x > me.x || (a1.x == me.x && a1.y < me.y)) ? 1u : 0u;
            rank += (a2.x > me.x || (a2.x == me.x && a2.y < me.y)) ? 1u : 0u;
            rank += (a3.x > me.x || (a3.x == me.x && a3.y < me.y)) ? 1u : 0u;
        }
        for (; j < nc; ++j) { const uint2 a0 = list[j]; rank += (a0.x > me.x || (a0.x == me.x && a0.y < me.y)) ? 1u : 0u; }
        int slot = -1;
        if (rank < need) {
            slot = (int)atomicAdd(&misc[2], 1u);
            p.idx[e * CAP_ + slot] = (int)me.y;
            p.gate[e * CAP_ + slot] = __uint_as_float(me.x);
        }
        p.slot_of[me.y * NE_ + e] = slot;
    }
    __syncthreads();
}

struct AGather { const bf16_t* base; const int* rows; __device__ __forceinline__ const bf16_t* ubase() const { return base; } __device__ __forceinline__ unsigned row_off(int r) const { return (unsigned)rows[r] * (unsigned)D_; } };
struct BMoe1 {
    const float* wg; long up_minus_gate; int col0;
    __device__ __forceinline__ const float* ubase(int wave) const { return wg + (long)(wave & 1) * up_minus_gate; }
    __device__ __forceinline__ unsigned col_off(int n4) const {
        const int wc = n4 >> 6, nn = (n4 >> 4) & 3, i = n4 & 15;
        return (unsigned)(col0 + wc * 32 + (nn & 1) * 16 + i);
    }
};
struct EpiMoe1 {
    const MKParams& p; int e, mt, nt;
    __device__ __forceinline__ void operator()(f32x4 (&acc)[8][4], int wr, int wc, int fr, int fq) const {
#pragma unroll
        for (int m = 0; m < 8; ++m) {
            const int slot = mt * 256 + wr * 128 + m * 16 + fr;
            const float rs = p.rstd_x1[p.idx[e * CAP_ + slot]];
#pragma unroll
            for (int nn = 0; nn < 2; ++nn) {
                const f32x4 g = acc[m][nn] * rs, u = acc[m][nn + 2] * rs;
                float a[4];
#pragma unroll
                for (int i = 0; i < 4; ++i) a[i] = g[i] / (1.f + __expf(-g[i])) * u[i];
                uint2 w; w.x = pk2(a[0], a[1]); w.y = pk2(a[2], a[3]);
                *(uint2*)(p.act + (size_t)(e * CAP_ + slot) * FF_ + nt * 128 + wc * 32 + nn * 16 + fq * 4) = w;
            }
        }
    }
};
__device__ __forceinline__ void moe1_item(const MKParams& p, unsigned char* smem, int it) {
    const int rnd = it >> 8, b = it & 255, xcd = b & 7, s = b >> 3;
    const int mt = s & 3, wt = rnd * 64 + xcd * 8 + (s >> 2);
    const int e = wt >> 4, nt = wt & 15;
    AGather al{p.x1g, p.idx + e * CAP_ + mt * 256};
    BHalves bl{p.w_gate_t + ((size_t)e * FF_ + nt * 128) * D_, p.w_up_t + ((size_t)e * FF_ + nt * 128) * D_, D_};
    BgConv bg{p.w_down, 0L, p.w_down_t, 0L, rnd * 15 * 256 + b};
    gemm8_tile<true>(smem, al, bl, D_ / 64, NoMid8{}, EpiMoe1_8{p, e, mt, nt}, bg);
}

struct EpiMoe2 {
    const MKParams& p; int e, mt, nt;
    __device__ __forceinline__ void operator()(f32x4 (&acc)[8][4], int wr, int wc, int fr, int fq) const {
#pragma unroll
        for (int m = 0; m < 8; ++m) {
            const int slot = mt * 256 + wr * 128 + m * 16 + fr;
            const float gt = p.gate[e * CAP_ + slot];
#pragma unroll
            for (int nn = 0; nn < 4; ++nn) {
                const f32x4 a = acc[m][nn] * gt;
                uint2 w; w.x = pk2(a[0], a[1]); w.y = pk2(a[2], a[3]);
                *(uint2*)(p.ye + (size_t)(e * CAP_ + slot) * D_ + nt * 256 + wc * 64 + nn * 16 + fq * 4) = w;
            }
        }
    }
};
__device__ __forceinline__ void moe2_item(const MKParams& p, unsigned char* smem, int it) {
    const int rnd = it >> 8, b = it & 255, xcd = b & 7, s = b >> 3;
    const int mt = s & 3, wt = rnd * 64 + xcd * 8 + (s >> 2);
    const int e = wt >> 3, nt = wt & 7;
    ARows al{p.act + (size_t)(e * CAP_ + mt * 256) * FF_, FF_};
    BHalves bl{p.w_down_t + ((size_t)e * D_ + nt * 256) * FF_, p.w_down_t + ((size_t)e * D_ + nt * 256 + 128) * FF_, FF_};
    gemm8_tile<true>(smem, al, bl, FF_ / 64, NoMid8{}, EpiMoe2_8{p, e, mt, nt}, NoBg{});
}

__device__ __forceinline__ void final_token(const MKParams& p, int token, int lane) {
    float v[4][8];
#pragma unroll
    for (int j = 0; j < 4; ++j) {
        const int n = j * 512 + lane * 8;
        const uint4 w = *(const uint4*)(p.x1g + (size_t)token * D_ + n);
        const float4 g0 = *(const float4*)(p.g_ffn + n), g1 = *(const float4*)(p.g_ffn + n + 4);
        v[j][0] = bflo(w.x) / g0.x; v[j][1] = bfhi(w.x) / g0.y; v[j][2] = bflo(w.y) / g0.z; v[j][3] = bfhi(w.y) / g0.w;
        v[j][4] = bflo(w.z) / g1.x; v[j][5] = bfhi(w.z) / g1.y; v[j][6] = bflo(w.w) / g1.z; v[j][7] = bfhi(w.w) / g1.w;
    }
#pragma unroll 1
    for (int e = 0; e < NE_; ++e) {
        const int slot = p.slot_of[token * NE_ + e];
        if (slot >= 0) {
            const bf16_t* yr = p.ye + (size_t)(e * CAP_ + slot) * D_;
#pragma unroll
            for (int j = 0; j < 4; ++j) {
                const uint4 w = *(const uint4*)(yr + j * 512 + lane * 8);
                v[j][0] += bflo(w.x); v[j][1] += bfhi(w.x); v[j][2] += bflo(w.y); v[j][3] += bfhi(w.y);
                v[j][4] += bflo(w.z); v[j][5] += bfhi(w.z); v[j][6] += bflo(w.w); v[j][7] += bfhi(w.w);
            }
        }
    }
    float ss = 0.f;
#pragma unroll
    for (int j = 0; j < 4; ++j)
#pragma unroll
        for (int i = 0; i < 8; ++i) ss += v[j][i] * v[j][i];
    ss = wave_sum(ss);
    const float rs = 1.0f / sqrtf(ss * (1.0f / D_) + 1e-6f);
#pragma unroll
    for (int j = 0; j < 4; ++j) {
        const int n = j * 512 + lane * 8;
        const float4 g0 = *(const float4*)(p.g_final + n), g1 = *(const float4*)(p.g_final + n + 4);
        float4 o0, o1;
        o0.x = v[j][0] * rs * g0.x; o0.y = v[j][1] * rs * g0.y; o0.z = v[j][2] * rs * g0.z; o0.w = v[j][3] * rs * g0.w;
        o1.x = v[j][4] * rs * g1.x; o1.y = v[j][5] * rs * g1.y; o1.z = v[j][6] * rs * g1.z; o1.w = v[j][7] * rs * g1.w;
        *(float4*)(p.out + (size_t)token * D_ + n) = o0;
        *(float4*)(p.out + (size_t)token * D_ + n + 4) = o1;
    }
}


#ifndef REP0
#define REP0 1
#endif
#ifndef REP1
#define REP1 1
#endif
#ifndef REP2
#define REP2 1
#endif
#ifndef REP3
#define REP3 1
#endif
#ifndef REP4
#define REP4 1
#endif
#ifndef REP5
#define REP5 1
#endif
#ifndef REP6
#define REP6 1
#endif
#ifndef REP7
#define REP7 1
#endif
#ifndef REP8
#define REP8 1
#endif
#ifndef REP9
#define REP9 1
#endif
#ifndef REP10
#define REP10 1
#endif
#ifndef REP12
#define REP12 1
#endif
#ifndef REP13
#define REP13 0
#endif
__global__ __launch_bounds__(NT_, 2) void k_mega(MKParams p) {
    extern __shared__ __attribute__((aligned(16))) unsigned char smem[];
    volatile LAS unsigned* st = (volatile LAS unsigned*)smem;
    if (threadIdx.x < 4) st[threadIdx.x] = 0u;
    if (threadIdx.x == 4) *(volatile LAS unsigned*)(smem + 64) = 0u;
    __syncthreads();
    xcd_barrier_post(p.bar, st);
    if (p.never) cg::this_grid().sync();
    const int G = gridDim.x, b0 = blockIdx.x;
    {
        const int tq = opaque_tid(), lane = tq & 63, wave = __builtin_amdgcn_readfirstlane(tq >> 6);
        if (wave < 4) {
            unsigned epoch = 0;
            volatile LAS unsigned* cnt = (volatile LAS unsigned*)(smem + 64);
            for (int rep = 0; rep < p.rep[10]; ++rep)
                for (int it = b0; it < 256; it += G) ssm_tables(p, smem, it >> 2, it & 3, wave, lane, cnt, epoch);
        } else {
            const int gw = b0 * 4 + (wave - 4), NGW = G * 4;
            for (int rep = 0; rep < p.rep[0]; ++rep) conv_range(p, 0, CV_P0_END, gw, NGW, lane);
            phase_prep(p, gw, NGW, lane);
            for (int i = gw * 64 + lane; i < NE_ * 4096; i += NGW * 64) p.ahist[i] = 0u;
        }
    }
    xcd_barrier(p.bar, st);
    if (threadIdx.x == 0) {
        bool even = (G % 8) == 0;
        for (int j = 0; j < 8; ++j) even = even && (xb_ld(&p.bar[XB_XCNT(j)]) == (unsigned)(G / 8));
        st[2] = even ? (st[2] + 8u * st[3]) : (unsigned)blockIdx.x;
    }
    __syncthreads();
    const int b = (int)st[2];
    for (int rep = 0; rep < p.rep[1]; ++rep) {
    phase_inproj(p, smem, b);
    xcd_barrier(p.bar, st);
    }
    for (int rep = 0; rep < p.rep[2]; ++rep) {
    phase2(p, smem, b, G, p.bar + 64 + rep);
    xcd_barrier(p.bar, st);
    }
    for (int rep = 0; rep < p.rep[3]; ++rep) {
    for (int it = b; it < 128; it += G) { const int q = it >> 3; ssm_y_item(p, smem, (it & 7) + 8 * (q >> 1), q & 1); }
    if (b >= 128) { const int tq = opaque_tid(); conv_range(p, CV_P0_END, CV_P3_END, (b - 128) * 8 + (tq >> 6), 128 * 8, tq & 63); }
    xcd_barrier(p.bar, st);
    }
    for (int rep = 0; rep < p.rep[4]; ++rep) {
    for (int it = b; it < 128; it += G) glu_item(p, smem, it);
    if (b >= 128) { const int tq = opaque_tid(); conv_range(p, CV_P3_END, CV_P4_END, (b - 128) * 8 + (tq >> 6), 128 * 8, tq & 63); }
    xcd_barrier(p.bar, st);
    }
    for (int rep = 0; rep < p.rep[5]; ++rep) {
    for (int it = b; it < 256; it += G) outproj_item(p, smem, it);
    xcd_barrier(p.bar, st);
    }
    for (int rep = 0; rep < p.rep[6]; ++rep) {
    for (int it = b; it < L_ / 32; it += G) router_item(p, smem, it);
    xcd_barrier(p.bar, st);
    }
    for (int rep = 0; rep < p.rep[7]; ++rep) {
    for (int it = b; it < NE_; it += G) topk_item(p, smem, it);
    if (b >= 16) { const int tq = opaque_tid(); conv_range(p, CV_P4_END, CV_END, (b - 16) * 8 + (tq >> 6), 240 * 8, tq & 63); }
    xcd_barrier(p.bar, st);
    }
    for (int rep = 0; rep < p.rep[8]; ++rep) {
    for (int it = b; it < 1024; it += G) moe1_item(p, smem, it);
    xcd_barrier(p.bar, st);
    }
    for (int rep = 0; rep < p.rep[9]; ++rep) {
    for (int it = b; it < 512; it += G) moe2_item(p, smem, it);
    xcd_barrier(p.bar, st);
    }
    for (int i = 0; i < p.rep[13]; ++i) xcd_barrier(p.bar, st);
    for (int rep = 0; rep < p.rep[12]; ++rep)
    { int tq = threadIdx.x; asm volatile("" : "+v"(tq));
      for (int t = b * 8 + (tq >> 6); t < L_; t += G * 8) final_token(p, t, tq & 63); }
}

extern "C" void kernel_launch(void* const* d_in, const int* in_sizes, int n_in, void* d_out, int out_size, void* d_ws, size_t ws_size,
                              hipStream_t stream) {
    (void)in_sizes; (void)n_in; (void)out_size; (void)ws_size;
    static int grid = 0;
    if (!grid) {
        int dev = 0, cus = 0, per_cu = 0;
        (void)hipGetDevice(&dev);
        (void)hipDeviceGetAttribute(&cus, hipDeviceAttributeMultiprocessorCount, dev);
        (void)hipFuncSetAttribute((const void*)k_mega, hipFuncAttributeMaxDynamicSharedMemorySize, MK_LDS);
        (void)hipOccupancyMaxActiveBlocksPerMultiprocessor(&per_cu, (const void*)k_mega, NT_, MK_LDS);
        if (per_cu < 1) per_cu = 1;
        grid = cus;
    }
    MKParams mp{};
    const float* const* in = (const float* const*)d_in;
    mp.x = in[0]; mp.g_mix = in[1]; mp.w_in = in[2];
    mp.a_re_f = in[3]; mp.a_im_f = in[4]; mp.ldt_f = in[5]; mp.b_re_f = in[6]; mp.b_im_f = in[7]; mp.c_re_f = in[8]; mp.c_im_f = in[9];
    mp.a_re_b = in[10]; mp.a_im_b = in[11]; mp.ldt_b = in[12]; mp.b_re_b = in[13]; mp.b_im_b = in[14]; mp.c_re_b = in[15]; mp.c_im_b = in[16];
    mp.ssm_d = in[17]; mp.w_glu = in[18]; mp.b_glu = in[19]; mp.rpb = in[20]; mp.g_ssm = in[21]; mp.g_na = in[22]; mp.w_out = in[23];
    mp.g_ffn = in[24]; mp.w_router = in[25]; mp.w_gate = in[26]; mp.w_up = in[27]; mp.w_down = in[28]; mp.g_final = in[29];
    mp.out = (float*)d_out;
    unsigned char* ws = (unsigned char*)d_ws;
    size_t off = 0;
    auto take = [&](size_t bytes) { unsigned char* q = ws + off; off += (bytes + 255) & ~(size_t)255; return q; };
    mp.bar = (unsigned*)take(XCD_BAR_WORDS * 4);
    mp.xn = (bf16_t*)take((size_t)L_ * XN_LD * 2);
    mp.rstd_x = (float*)take(L_ * 4);
    mp.ua = (bf16_t*)take((size_t)64 * 256 * 768 * 2);
    mp.qb = (bf16_t*)take((size_t)L_ * DS_ * 2);
    mp.kb = (bf16_t*)take((size_t)L_ * DS_ * 2);
    mp.vT = (bf16_t*)take((size_t)L_ * DS_ * 2);
    mp.PBt = (bf16_t*)take((size_t)64 * 256 * 512 * 2);
    mp.WyT = (bf16_t*)take((size_t)64 * 512 * 768 * 2);
    mp.A32 = (float*)take(64 * 2 * 64 * 2 * 4);
    mp.ypre = (bf16_t*)take((size_t)L_ * DS_ * 2);
    mp.ymix = (bf16_t*)take((size_t)L_ * D_ * 2);
    mp.ssq_na = (float*)take((size_t)L_ * 16 * 4);
    mp.ssq_ssm = (float*)take((size_t)L_ * 16 * 4);
    mp.x1g = (bf16_t*)take((size_t)L_ * D_ * 2);
    mp.ssq_x1 = (float*)take((size_t)L_ * 32 * 4);
    mp.wrT = (bf16_t*)take((size_t)2 * NE_ * D_ * 2);
    mp.aff_t = (float*)take((size_t)NE_ * L_ * 4);
    mp.rstd_x1 = (float*)take(L_ * 4);
    mp.idx = (int*)take(NE_ * CAP_ * 4);
    mp.gate = (float*)take(NE_ * CAP_ * 4);
    mp.slot_of = (int*)take((size_t)L_ * NE_ * 4);
    mp.ahist = (unsigned*)take((size_t)NE_ * 4096 * 4);
    mp.act = (bf16_t*)take((size_t)NE_ * CAP_ * FF_ * 2);
    mp.ye = (bf16_t*)take((size_t)NE_ * CAP_ * D_ * 2);
    mp.w_in_t = (bf16_t*)take((size_t)DIN_ * XN_LD * 2);
    mp.w_out_t = (bf16_t*)take((size_t)D_ * D_ * 2);
    mp.w_glu_t = (bf16_t*)take((size_t)DS_ * DS_ * 2);
    mp.w_gate_t = (bf16_t*)take((size_t)NE_ * D_ * FF_ * 2);
    mp.w_up_t = (bf16_t*)take((size_t)NE_ * D_ * FF_ * 2);
    mp.w_down_t = (bf16_t*)take((size_t)NE_ * D_ * FF_ * 2);
    { const int reps[14] = {REP0, REP1, REP2, REP3, REP4, REP5, REP6, REP7, REP8, REP9, REP10, 1, REP12, REP13}; for (int i = 0; i < 14; ++i) mp.rep[i] = reps[i]; }
    mp.bg = 1;
    mp.never = 0; mp.pad = 0;
    (void)hipMemsetAsync(mp.bar, 0, XCD_BAR_WORDS * sizeof(unsigned), stream);
    void* args[] = {&mp};
    (void)hipLaunchCooperativeKernel((const void*)k_mega, dim3(grid), dim3(NT_), args, MK_LDS, stream);
}
```

```cpp
#include <hip/hip_runtime.h>
#include <math.h>
#include <stdint.h>

#define L_   8192
#define D_   2048
#define DIN_ 4096
#define DS_  1024
#define NG_  64
#define NP_  64
#define NE_  16
#define CAP_ 1024
#define FF_  2048

__device__ __forceinline__ float wave_sum(float v) {
#pragma unroll
    for (int o = 32; o >= 1; o >>= 1) v += __shfl_xor(v, o);
    return v;
}

#include <hip/hip_cooperative_groups.h>
namespace cg = cooperative_groups;
#define XB_TMO      128
#define XB_XCNT(j)  (256  + 64 * (j))
#define XB_XSUB(j)  (1280 + 64 * (j))
#define XB_XGEN(j)  (2304 + 64 * (j))
#define XB_TOP      3328
#define XB_TOPGEN   3392
#define XCD_BAR_WORDS 3456
#define XB_SPIN_CAP (1u << 18)
#define LAS __attribute__((address_space(3)))
__device__ __forceinline__ unsigned xb_ld(unsigned* p)              { return __hip_atomic_load(p, __ATOMIC_RELAXED, __HIP_MEMORY_SCOPE_AGENT); }
__device__ __forceinline__ unsigned xb_add(unsigned* p, unsigned v) { return __hip_atomic_fetch_add(p, v, __ATOMIC_RELAXED, __HIP_MEMORY_SCOPE_AGENT); }
__device__ __forceinline__ unsigned xb_xcc_id() { return (unsigned)__builtin_amdgcn_s_getreg((3 << 11) | 20) & 0xFu; }
#define XB_SPIN(cond, bar) do { unsigned _sp = 0; while (cond) { __builtin_amdgcn_s_sleep(1); \
    if ((++_sp & 255u) == 0u) { if (xb_ld(&(bar)[XB_TMO])) break; if (_sp > XB_SPIN_CAP) { atomicAdd(&(bar)[XB_TMO], 1u); break; } } } } while (0)
__device__ __forceinline__ void xcd_barrier_post(unsigned* bar, volatile LAS unsigned* st) {
    if (threadIdx.x == 0) { const unsigned x = xb_xcc_id(); const unsigned r = xb_add(&bar[XB_XCNT(x)], 1u); st[2] = x; st[3] = r; }
}
__device__ __forceinline__ void xcd_barrier_complete(unsigned* bar, unsigned x, unsigned& nloc, unsigned& nx) {
    const unsigned G = gridDim.x * gridDim.y * gridDim.z;
    unsigned sum, cnt, mine, sp = 0u;
    for (;;) {
        sum = 0u; cnt = 0u; mine = 0u;
#pragma unroll
        for (unsigned j = 0; j < 16; ++j) { const unsigned c = xb_ld(&bar[XB_XCNT(j)]); sum += c; cnt += (c > 0u) ? 1u : 0u; mine = (j == x) ? c : mine; }
        if (sum == G) break;
        __builtin_amdgcn_s_sleep(1);
        if ((++sp & 255u) == 0u) { if (xb_ld(&bar[XB_TMO])) break; if (sp > XB_SPIN_CAP) { atomicAdd(&bar[XB_TMO], 1u); break; } }
    }
    nloc = mine > 0u ? mine : 1u; nx = cnt > 0u ? cnt : 1u;
}
__device__ __forceinline__ void xcd_barrier(unsigned* bar, volatile LAS unsigned* st) {
    asm volatile("s_waitcnt vmcnt(0)" ::: "memory");
    __syncthreads();
    if (threadIdx.x == 0) {
        __builtin_amdgcn_s_waitcnt(0);
        const unsigned x = xb_xcc_id();
        unsigned nloc = st[0], nx = st[1];
        if (nloc == 0u) { xcd_barrier_complete(bar, x, nloc, nx); st[0] = nloc; st[1] = nx; }
        const unsigned old = xb_add(&bar[XB_XSUB(x)], 1u);
        const unsigned gen = old / nloc;
        if (old + 1u == (gen + 1u) * nloc) {
            __builtin_amdgcn_fence(__ATOMIC_RELEASE, "agent");
            asm volatile("s_waitcnt vmcnt(0)" ::: "memory");
            const unsigned og = xb_add(&bar[XB_TOP], 1u);
            const unsigned tg = og / nx;
            if (og + 1u == (tg + 1u) * nx) xb_add(&bar[XB_TOPGEN], 1u);
            else XB_SPIN(xb_ld(&bar[XB_TOPGEN]) == tg, bar);
            __builtin_amdgcn_fence(__ATOMIC_ACQUIRE, "agent");
            xb_add(&bar[XB_XGEN(x)], 1u);
            asm volatile("s_waitcnt vmcnt(0)" ::: "memory");
        } else {
            XB_SPIN(xb_ld(&bar[XB_XGEN(x)]) == gen, bar);
            __builtin_amdgcn_fence(__ATOMIC_ACQUIRE, "agent");
            asm volatile("s_waitcnt vmcnt(0)" ::: "memory");
        }
    }
    __syncthreads();
}

typedef short bf16x8 __attribute__((ext_vector_type(8)));
typedef float f32x4 __attribute__((ext_vector_type(4)));
typedef float f32x2 __attribute__((ext_vector_type(2)));
typedef __bf16 bf16x2v __attribute__((ext_vector_type(2)));
typedef unsigned short bf16_t;
typedef unsigned u32x4 __attribute__((ext_vector_type(4)));
#define NT_ 512
#define XN_LD (D_ + 64)
#define SM_MISC 0
#define SM_ROWS 1024
#define SM_GEMM 4096
#define SM_CV (SM_GEMM + 131072)
#define MK_LDS (152 * 1024)

__device__ __forceinline__ unsigned pk2(float lo, float hi) {
    f32x2 v = {lo, hi};
    return __builtin_bit_cast(unsigned, __builtin_convertvector(v, bf16x2v));
}
__device__ __forceinline__ float bf2f(bf16_t h) { return __uint_as_float(((unsigned)h) << 16); }
__device__ __forceinline__ float bflo(unsigned w) { return __uint_as_float(w << 16); }
__device__ __forceinline__ float bfhi(unsigned w) { return __uint_as_float(w & 0xffff0000u); }

struct MKParams {
    const float *x, *g_mix, *w_in;
    const float *a_re_f, *a_im_f, *ldt_f, *b_re_f, *b_im_f, *c_re_f, *c_im_f;
    const float *a_re_b, *a_im_b, *ldt_b, *b_re_b, *b_im_b, *c_re_b, *c_im_b;
    const float *ssm_d, *w_glu, *b_glu, *rpb, *g_ssm, *g_na, *w_out, *g_ffn, *w_router, *w_gate, *w_up, *w_down, *g_final;
    float* out;
    bf16_t* xn;
    float* rstd_x;
    bf16_t* ua;
    bf16_t* qb;
    bf16_t* kb;
    bf16_t* vT;
    bf16_t* PBt;
    bf16_t* WyT;
    float* A32;
    bf16_t* ypre;
    bf16_t* ymix;
    float* ssq_na;
    float* ssq_ssm;
    bf16_t* x1g;
    float* ssq_x1;
    bf16_t* wrT;
    float* aff_t;
    float* rstd_x1;
    int* idx;
    float* gate;
    int* slot_of;
    unsigned* ahist;
    bf16_t* act;
    bf16_t* ye;
    bf16_t* w_in_t;
    bf16_t* w_out_t;
    bf16_t* w_glu_t;
    bf16_t *w_gate_t, *w_up_t, *w_down_t;
    unsigned* bar;
    int bg;
    int rep[14];
    int never; int pad;
};

#define GAS __attribute__((address_space(1)))
__device__ __forceinline__ int opaque_tid() { int t = threadIdx.x; asm volatile("" : "+v"(t)); return t; }
template <class T> __device__ __forceinline__ const GAS T* uniform_ptr(const T* p) {
    const unsigned long long v = (unsigned long long)p;
    const unsigned lo = __builtin_amdgcn_readfirstlane((unsigned)v), hi = __builtin_amdgcn_readfirstlane((unsigned)(v >> 32));
    return (const GAS T*)(((unsigned long long)hi << 32) | lo);
}
__device__ __forceinline__ int tile_off(int row, int chunk) { return row * 128 + (((chunk ^ (row >> 1)) & 7) << 4); }

template <int MT, bool TR, int BMODE, class ALoad, class BLoad, class Mid, class Epi>
__device__ __forceinline__ void gemm_tile(unsigned char* smem, const ALoad& al, const BLoad& bl, int ldb, int nkt, const Mid& mid, const Epi& epi) {
    int tid_ = threadIdx.x; asm volatile("" : "+v"(tid_));
    const int tid = tid_, lane = tid & 63, wave = tid >> 6;
    const int wr = wave >> 2, wc = wave & 3, fr = lane & 15, fq = lane >> 4;
    constexpr int AR = MT / 2;
    const GAS bf16_t* const abase = uniform_ptr(al.ubase());
    unsigned aoff[AR];
#pragma unroll
    for (int i = 0; i < AR; ++i) {
        const int row = i * 64 + (tid >> 3);
        aoff[i] = al.row_off(row) + (unsigned)((((lane & 7) ^ (row >> 1)) & 7) << 3);
    }
    const int a_lds = __builtin_amdgcn_readfirstlane(wave * 1024);
    const int b_kg = lane & 7, b_n4 = ((wave << 3) | (lane >> 3)) << 2;
    const auto* const bbase = uniform_ptr(bl.ubase(__builtin_amdgcn_readfirstlane(wave)));
    unsigned boff = 0, boff16[4];
    if constexpr (BMODE == 0) { boff = bl.col_off(b_n4) + (unsigned)(b_kg * 8) * (unsigned)ldb; }
    else {
#pragma unroll
        for (int i = 0; i < 4; ++i) { const int row = i * 64 + (tid >> 3); boff16[i] = bl.row_off(row) + (unsigned)((((lane & 7) ^ (row >> 1)) & 7) << 3); }
    }
    unsigned char* const sA = smem + SM_GEMM;
    unsigned char* const sB = smem + SM_GEMM + 32768;
    const int key = (fr >> 1) & 7;
    const int c0 = ((fq ^ key) & 7) << 4, c1 = (((fq | 4) ^ key) & 7) << 4;
    const int a_frag = (wr * (MT * 16) + fr) * 128;
    const int b_frag = (wc * 64 + fr) * 128;

    f32x4 acc[MT][4];
#pragma unroll
    for (int m = 0; m < MT; ++m)
#pragma unroll
        for (int n = 0; n < 4; ++n) acc[m][n] = (f32x4){0.f, 0.f, 0.f, 0.f};

    f32x4 rb[8];
    __syncthreads();
#pragma unroll
    for (int i = 0; i < AR; ++i)
        __builtin_amdgcn_global_load_lds((const GAS unsigned*)(abase + aoff[i]), (__attribute__((address_space(3))) unsigned*)(sA + a_lds + i * 8192), 16, 0, 0);
    if constexpr (BMODE == 0) {
#pragma unroll
        for (int j = 0; j < 8; ++j) rb[j] = *(const GAS f32x4*)((const GAS float*)bbase + (size_t)j * ldb + boff);
        const float* f = (const float*)rb;
#pragma unroll
        for (int i = 0; i < 4; ++i) {
            uint4 w; w.x = pk2(f[0 * 4 + i], f[1 * 4 + i]); w.y = pk2(f[2 * 4 + i], f[3 * 4 + i]); w.z = pk2(f[4 * 4 + i], f[5 * 4 + i]); w.w = pk2(f[6 * 4 + i], f[7 * 4 + i]);
            *(uint4*)(sB + tile_off(b_n4 + i, b_kg)) = w;
        }
    } else {
#pragma unroll
        for (int i = 0; i < 4; ++i)
            __builtin_amdgcn_global_load_lds((const GAS unsigned*)((const GAS bf16_t*)bbase + boff16[i]), (__attribute__((address_space(3))) unsigned*)(sB + a_lds + i * 8192), 16, 0, 0);
    }
    __syncthreads();
    for (int kt = 0; kt < nkt; ++kt) {
        const int cur = (kt & 1) * 65536;
        const int nxt = cur ^ 65536;
        const bool more = (kt + 1 < nkt);
        if (more) {
#pragma unroll
            for (int i = 0; i < AR; ++i)
                __builtin_amdgcn_global_load_lds((const GAS unsigned*)(abase + (kt + 1) * 64 + aoff[i]), (__attribute__((address_space(3))) unsigned*)(sA + nxt + a_lds + i * 8192), 16, 0, 0);
            if constexpr (BMODE == 0) {
#pragma unroll
                for (int j = 0; j < 8; ++j) rb[j] = *(const GAS f32x4*)((const GAS float*)bbase + (size_t)((kt + 1) * 64 + j) * ldb + boff);
            } else {
#pragma unroll
                for (int i = 0; i < 4; ++i)
                    __builtin_amdgcn_global_load_lds((const GAS unsigned*)((const GAS bf16_t*)bbase + (kt + 1) * 64 + boff16[i]), (__attribute__((address_space(3))) unsigned*)(sB + nxt + a_lds + i * 8192), 16, 0, 0);
            }
        }
        mid(kt, acc, wr, fr, fq);
        constexpr int GQ = MT / 2, NG = 2 * GQ;
        bf16x8 bfr[4], af[2][2];
#pragma unroll
        for (int n = 0; n < 4; ++n) bfr[n] = *(const bf16x8*)(sB + cur + b_frag + n * 2048 + c0);
#pragma unroll
        for (int m = 0; m < 2; ++m) af[0][m] = *(const bf16x8*)(sA + cur + a_frag + m * 2048 + c0);
#pragma unroll
        for (int g = 0; g < NG; ++g) {
            const int ks = g / GQ, mq = g % GQ;
            if (g + 1 < NG) {
                const int ks1 = (g + 1) / GQ, mq1 = (g + 1) % GQ;
#pragma unroll
                for (int m = 0; m < 2; ++m) af[(g + 1) & 1][m] = *(const bf16x8*)(sA + cur + a_frag + (mq1 * 2 + m) * 2048 + (ks1 ? c1 : c0));
            }
#pragma unroll
            for (int m = 0; m < 2; ++m)
#pragma unroll
                for (int n = 0; n < 4; ++n)
                    acc[mq * 2 + m][n] = TR ? __builtin_amdgcn_mfma_f32_16x16x32_bf16(bfr[n], af[g & 1][m], acc[mq * 2 + m][n], 0, 0, 0)
                                            : __builtin_amdgcn_mfma_f32_16x16x32_bf16(af[g & 1][m], bfr[n], acc[mq * 2 + m][n], 0, 0, 0);
            if (g == GQ - 1) {
#pragma unroll
                for (int n = 0; n < 4; ++n) bfr[n] = *(const bf16x8*)(sB + cur + b_frag + n * 2048 + c1);
            }
            if (BMODE == 0 && g == NG - 2) {
                if (more) {
                    const float* f = (const float*)rb;
#pragma unroll
                    for (int i = 0; i < 4; ++i) {
                        uint4 w; w.x = pk2(f[0 * 4 + i], f[1 * 4 + i]); w.y = pk2(f[2 * 4 + i], f[3 * 4 + i]); w.z = pk2(f[4 * 4 + i], f[5 * 4 + i]); w.w = pk2(f[6 * 4 + i], f[7 * 4 + i]);
                        *(uint4*)(sB + nxt + tile_off(b_n4 + i, b_kg)) = w;
                    }
                }
            }
            __builtin_amdgcn_sched_barrier(0);
        }
        __syncthreads();
    }
    epi(acc, wr, wc, fr, fq);
}

struct NoMid { template <class ACC> __device__ __forceinline__ void operator()(int, ACC&, int, int, int) const {} };
struct ARows { const bf16_t* base; int lda; __device__ __forceinline__ const bf16_t* ubase() const { return base; } __device__ __forceinline__ unsigned row_off(int r) const { return (unsigned)r * (unsigned)lda; } };
struct BRows16 { const bf16_t* base; int ld; __device__ __forceinline__ const bf16_t* ubase(int) const { return base; } __device__ __forceinline__ unsigned row_off(int r) const { return (unsigned)r * (unsigned)ld; } };
struct BCols { const float* base; __device__ __forceinline__ const float* ubase(int) const { return base; } __device__ __forceinline__ unsigned col_off(int n4) const { return (unsigned)n4; } };

#define G8_HT 16384
__device__ __forceinline__ void g8_stage_rc(int b, int& R, int& C) { const int st = b / 1024, sb = b % 1024, swz = sb ^ (((sb >> 9) & 1) << 5); R = (st >> 1) * 16 + swz / 64; C = (st & 1) * 32 + (swz % 64) / 2; }
#define G8_WAIT_V(n) asm volatile("s_waitcnt vmcnt(" #n ")" ::: "memory")
#define G8_WAIT_L(n) asm volatile("s_waitcnt lgkmcnt(" #n ")" ::: "memory")
#define G8_BAR __builtin_amdgcn_s_barrier()
#define G8_SCHED __builtin_amdgcn_sched_barrier(0)

template <bool TR, class ALoad, class BLoad, class Mid, class Epi, class BG>
__device__ __forceinline__ void gemm8_tile(unsigned char* smem, const ALoad& al, const BLoad& bl, int nt, const Mid& mid, const Epi& epi, const BG& bg) {
    int tid_ = threadIdx.x; asm volatile("" : "+v"(tid_));
    const int tid = tid_, lane = tid & 63, wid = tid >> 6, wr = wid >> 2, wc = wid & 3, fr = lane & 15, fq = lane >> 4;
    unsigned char* const shm = smem + SM_GEMM;
    const GAS bf16_t* const abase = uniform_ptr(al.ubase());
    const GAS bf16_t* const bbase0 = uniform_ptr(bl.half_base(0));
    const GAS bf16_t* const bbase1 = uniform_ptr(bl.half_base(1));
    unsigned aoff[2][2], boff[2];
#pragma unroll
    for (int i = 0; i < 2; ++i) {
        int R, C; g8_stage_rc(tid * 16 + i * 8192, R, C);
        aoff[0][i] = al.row_off(R) + (unsigned)C; aoff[1][i] = al.row_off(128 + R) + (unsigned)C; boff[i] = bl.row_off(R) + (unsigned)C;
    }
    const int wlds = __builtin_amdgcn_readfirstlane(wid * 1024);
    const int lane_off = fr * 64 + ((fq * 16) ^ ((fr >> 3) << 5));
#define G8_SA(b, h) (shm + ((b) * 2 + (h)) * G8_HT)
#define G8_SB(b, h) (shm + (4 + (b) * 2 + (h)) * G8_HT)
#define G8_STAGE_A(b, h, kt) do { _Pragma("unroll") for (int _i = 0; _i < 2; ++_i) \
        __builtin_amdgcn_global_load_lds((const GAS unsigned*)(abase + (size_t)(kt) * 64 + aoff[h][_i]), (LAS unsigned*)(G8_SA(b, h) + wlds + _i * 8192), 16, 0, 0); } while (0)
#define G8_STAGE_B(b, h, kt) do { _Pragma("unroll") for (int _i = 0; _i < 2; ++_i) \
        __builtin_amdgcn_global_load_lds((const GAS unsigned*)(((h) ? bbase1 : bbase0) + (size_t)(kt) * 64 + boff[_i]), (LAS unsigned*)(G8_SB(b, h) + wlds + _i * 8192), 16, 0, 0); } while (0)
#define G8_LDA(dst, b, h) do { _Pragma("unroll") for (int _m = 0; _m < 4; ++_m) _Pragma("unroll") for (int _k = 0; _k < 2; ++_k) \
        dst[_m][_k] = *(const bf16x8*)(G8_SA(b, h) + ((wr * 4 + _m) * 2 + _k) * 1024 + lane_off); } while (0)
#define G8_LDB(dst, b, h) do { _Pragma("unroll") for (int _n = 0; _n < 2; ++_n) _Pragma("unroll") for (int _k = 0; _k < 2; ++_k) \
        dst[_n][_k] = *(const bf16x8*)(G8_SB(b, h) + ((wc * 2 + _n) * 2 + _k) * 1024 + lane_off); } while (0)
#define G8_MMA(ai, bj, AT, BT) do { __builtin_amdgcn_s_setprio(1); \
        _Pragma("unroll") for (int _m = 0; _m < 4; ++_m) _Pragma("unroll") for (int _n = 0; _n < 2; ++_n) _Pragma("unroll") for (int _k = 0; _k < 2; ++_k) \
            acc[ai][bj][_m][_n] = TR ? __builtin_amdgcn_mfma_f32_16x16x32_bf16(BT[_n][_k], AT[_m][_k], acc[ai][bj][_m][_n], 0, 0, 0) \
                                     : __builtin_amdgcn_mfma_f32_16x16x32_bf16(AT[_m][_k], BT[_n][_k], acc[ai][bj][_m][_n], 0, 0, 0); \
        __builtin_amdgcn_s_setprio(0); } while (0)

    f32x4 acc[2][2][4][2];
#pragma unroll
    for (int a = 0; a < 2; ++a)
#pragma unroll
        for (int b = 0; b < 2; ++b)
#pragma unroll
            for (int m = 0; m < 4; ++m)
#pragma unroll
                for (int n = 0; n < 2; ++n) acc[a][b][m][n] = (f32x4){0.f, 0.f, 0.f, 0.f};
    bf16x8 At[4][2], B0[2][2], B1[2][2];
    __syncthreads();
    if constexpr (BG::ON) bg.issue(0, smem, wid, lane);
    G8_STAGE_B(0, 0, 0); G8_STAGE_A(0, 0, 0); G8_STAGE_B(0, 1, 0); G8_STAGE_A(0, 1, 0);
    if (wr == 1) G8_BAR;
    G8_WAIT_V(4); G8_BAR;
    G8_STAGE_B(1, 0, 1); G8_STAGE_A(1, 0, 1); G8_STAGE_B(1, 1, 1);
    G8_WAIT_V(6); G8_BAR;
    for (int t = 0; t < nt - 2; t += 2) {
        mid(t, acc, wr, fr, fq);
        G8_LDB(B0, 0, 0); G8_SCHED; G8_LDA(At, 0, 0); G8_STAGE_A(1, 1, t + 1);
        G8_WAIT_L(8); G8_BAR; G8_WAIT_L(0); G8_MMA(0, 0, At, B0); G8_BAR; G8_SCHED;
        G8_LDB(B1, 0, 1); G8_STAGE_B(0, 0, t + 2);
        G8_BAR; G8_WAIT_L(0); G8_MMA(0, 1, At, B1); G8_BAR;
        G8_LDA(At, 0, 1); G8_STAGE_A(0, 0, t + 2);
        G8_BAR; G8_WAIT_L(0); G8_MMA(1, 0, At, B0); G8_BAR; G8_SCHED;
        G8_STAGE_B(0, 1, t + 2);
        G8_WAIT_V(6); G8_BAR;
        float bgv[8];
        if constexpr (BG::ON) bg.read(smem, wid, lane, bgv);
        G8_MMA(1, 1, At, B1);
        if constexpr (BG::ON) bg.store(t >> 1, wid, lane, bgv);
        G8_BAR;
        G8_LDB(B0, 1, 0); G8_SCHED; G8_LDA(At, 1, 0); G8_STAGE_A(0, 1, t + 2);
        G8_WAIT_L(8); G8_BAR; G8_WAIT_L(0); G8_MMA(0, 0, At, B0); G8_BAR; G8_SCHED;
        G8_LDB(B1, 1, 1); G8_STAGE_B(1, 0, t + 3);
        if constexpr (BG::ON) { const int nx = (t >> 1) + 1; bg.issue(nx < ((nt - 2) >> 1) ? nx : ((nt - 2) >> 1) - 1, smem, wid, lane); }
        G8_BAR; G8_WAIT_L(0); G8_MMA(0, 1, At, B1); G8_BAR;
        G8_LDA(At, 1, 1); G8_STAGE_A(1, 0, t + 3);
        G8_BAR; G8_WAIT_L(0); G8_MMA(1, 0, At, B0); G8_BAR; G8_SCHED;
        G8_STAGE_B(1, 1, t + 3);
        if constexpr (BG::ON) { G8_WAIT_V(8); } else { G8_WAIT_V(6); }
        G8_BAR; G8_MMA(1, 1, At, B1); G8_BAR;
    }
    { G8_LDB(B0, 0, 0); G8_LDA(At, 0, 0); G8_STAGE_A(1, 1, nt - 1);
      G8_BAR; G8_WAIT_L(0); G8_MMA(0, 0, At, B0); G8_BAR;
      G8_LDB(B1, 0, 1); G8_BAR; G8_WAIT_L(0); G8_MMA(0, 1, At, B1); G8_BAR;
      G8_LDA(At, 0, 1); G8_WAIT_V(4); G8_BAR; G8_WAIT_L(0);
      G8_MMA(1, 0, At, B0); G8_MMA(1, 1, At, B1); G8_BAR; }
    { G8_LDB(B0, 1, 0); G8_LDA(At, 1, 0); G8_WAIT_V(2); G8_BAR; G8_WAIT_L(0); G8_MMA(0, 0, At, B0); G8_BAR;
      G8_LDB(B1, 1, 1); G8_WAIT_V(0); G8_BAR; G8_WAIT_L(0); G8_MMA(0, 1, At, B1); G8_BAR;
      G8_LDA(At, 1, 1); G8_BAR; G8_WAIT_L(0); G8_MMA(1, 0, At, B0); G8_MMA(1, 1, At, B1); G8_BAR; }
    if (wr == 0) G8_BAR;
    epi(acc, wr, wc, fr, fq);
}
struct NoMid8 { template <class ACC> __device__ __forceinline__ void operator()(int, ACC&, int, int, int) const {} };
struct NoBg { static constexpr bool ON = false; };
struct BgConv {
    static constexpr bool ON = true;
    const float* src0; long src_step;
    bf16_t* dst0; long dst_step;
    int chunk0;
    __device__ __forceinline__ void issue(int i, unsigned char* smem, int wave, int lane) const {
        const int c = __builtin_amdgcn_readfirstlane(chunk0 + 256 * i), m = c >> 10, kt = (c >> 5) & 31, n64 = c & 31;
        const GAS float* s = uniform_ptr(src0 + (long)(m >> 4) * src_step + (size_t)(m & 15) * 2048 * 2048 + (size_t)(kt * 64) * 2048 + n64 * 64);
        const int wv = __builtin_amdgcn_readfirstlane(wave);
        const unsigned voff = (unsigned)((lane >> 4) * 2048 + (((lane & 15) ^ wv) & 15) * 4);
        const GAS float* s0 = s + (size_t)(wv * 8) * 2048;
        const GAS float* s1 = s + (size_t)(wv * 8 + 4) * 2048;
        __builtin_amdgcn_global_load_lds((const GAS unsigned*)(s0 + voff), (LAS unsigned*)(smem + SM_CV + wv * 2048), 16, 0, 0);
        __builtin_amdgcn_global_load_lds((const GAS unsigned*)(s1 + voff), (LAS unsigned*)(smem + SM_CV + wv * 2048 + 1024), 16, 0, 0);
    }
    __device__ __forceinline__ void read(unsigned char* smem, int wave, int lane, float (&v)[8]) const {
        asm volatile("" ::: "memory");
        const int kg = lane & 7, n = wave * 8 + (lane >> 3);
        const float* cv = (const float*)(smem + SM_CV + kg * 2048 + ((((n >> 2) ^ kg) & 15) * 4 + (n & 3)) * 4);
#pragma unroll
        for (int j = 0; j < 8; ++j) v[j] = cv[j * 64];
    }
    __device__ __forceinline__ void store(int i, int wave, int lane, const float (&v)[8]) const {
        const int c = __builtin_amdgcn_readfirstlane(chunk0 + 256 * i), m = c >> 10, kt = (c >> 5) & 31, n64 = c & 31;
        const int wv = __builtin_amdgcn_readfirstlane(wave);
        GAS bf16_t* d = (GAS bf16_t*)uniform_ptr(dst0 + (long)(m >> 4) * dst_step + (size_t)(m & 15) * 2048 * 2048 + (size_t)(n64 * 64 + wv * 8) * 2048 + kt * 64);
        u32x4 w; w[0] = pk2(v[0], v[1]); w[1] = pk2(v[2], v[3]); w[2] = pk2(v[4], v[5]); w[3] = pk2(v[6], v[7]);
        *(GAS u32x4*)(d + (unsigned)((lane >> 3) * 2048 + (lane & 7) * 8)) = w;
    }
};
struct BHalves { const bf16_t* h0; const bf16_t* h1; int ld;
    __device__ __forceinline__ const bf16_t* half_base(int h) const { return h ? h1 : h0; }
    __device__ __forceinline__ unsigned row_off(int r) const { return (unsigned)r * (unsigned)ld; } };

#define BG_GU0 (32768 - 45 * 256)
#define BG_DN1 (60 * 256)
struct ConvItem { const float* s; bf16_t* d; int N, ldd; };
#define CV_SMALL 6656
#define CV_DN0 (CV_SMALL)
#define CV_GU0 (CV_DN0 + 2 * (16384 - BG_DN1))
#define CV_END (CV_GU0 + 2 * BG_GU0)
__device__ __forceinline__ ConvItem conv_decode(const MKParams& p, int it, int lane) {
    const int kg = lane & 7, n4 = (lane >> 3) << 2;
    const float* src; bf16_t* dst; int N, ldd, r;
    if (it < 4096) { src = p.w_in; dst = p.w_in_t; N = DIN_; ldd = XN_LD; r = it; }
    else if (it < 6144) { src = p.w_out; dst = p.w_out_t; N = D_; ldd = D_; r = it - 4096; }
    else if (it < 6656) { src = p.w_glu; dst = p.w_glu_t; N = DS_; ldd = DS_; r = it - 6144; }
    else {
        int which, e, rc, sub;
        if (it < CV_GU0) { const int j = it - CV_DN0, d = BG_DN1 + (j >> 1); sub = j & 1; which = 2; e = d >> 10; rc = d & 1023; }
        else { const int j = it - CV_GU0, s = j >> 1; sub = j & 1; which = s >> 14; e = (s >> 10) & 15; rc = s & 1023; }
        r = (rc >> 5) * 64 + (rc & 31) * 2 + sub; N = 2048; ldd = 2048;
        const size_t eo = (size_t)e * D_ * FF_;
        src = (which == 0 ? p.w_gate : (which == 1 ? p.w_up : p.w_down)) + eo;
        dst = (which == 0 ? p.w_gate_t : (which == 1 ? p.w_up_t : p.w_down_t)) + eo;
    }
    const int nn32 = N >> 5, kt = r / nn32, nt = r % nn32;
    ConvItem c;
    c.s = src + (size_t)(kt * 64 + kg * 8) * N + nt * 32 + n4;
    c.d = dst + (size_t)(nt * 32 + n4) * ldd + kt * 64 + kg * 8;
    c.N = N; c.ldd = ldd;
    return c;
}
__device__ __forceinline__ void conv_load(const ConvItem& c, f32x4 (&r)[8]) {
#pragma unroll
    for (int j = 0; j < 8; ++j) r[j] = *(const f32x4*)(c.s + (size_t)j * c.N);
}
__device__ __forceinline__ void conv_store(const ConvItem& c, const f32x4 (&r)[8]) {
#pragma unroll
    for (int i = 0; i < 4; ++i) {
        uint4 w; w.x = pk2(r[0][i], r[1][i]); w.y = pk2(r[2][i], r[3][i]); w.z = pk2(r[4][i], r[5][i]); w.w = pk2(r[6][i], r[7][i]);
        *(uint4*)(c.d + (size_t)i * c.ldd) = w;
    }
}
__device__ __forceinline__ void conv_range(const MKParams& p, int lo, int hi, int gw, int NGW, int lane) {
    int it = lo + gw;
    f32x4 r0[8], r1[8], r2[8], r3[8];
    ConvItem c0, c1, c2, c3;
    c0 = c1 = c2 = c3 = conv_decode(p, lo, lane);
    bool h0 = it < hi, h1 = it + NGW < hi, h2 = it + 2 * NGW < hi, h3 = it + 3 * NGW < hi;
    if (h0) { c0 = conv_decode(p, it, lane); conv_load(c0, r0); }
    if (h1) { c1 = conv_decode(p, it + NGW, lane); conv_load(c1, r1); }
    if (h2) { c2 = conv_decode(p, it + 2 * NGW, lane); conv_load(c2, r2); }
    if (h3) { c3 = conv_decode(p, it + 3 * NGW, lane); conv_load(c3, r3); }
    while (h0) {
        it += 4 * NGW;
        conv_store(c0, r0); h0 = it < hi;               if (h0) { c0 = conv_decode(p, it, lane); conv_load(c0, r0); }
        if (!h1) break;
        conv_store(c1, r1); h1 = it + NGW < hi;         if (h1) { c1 = conv_decode(p, it + NGW, lane); conv_load(c1, r1); }
        if (!h2) break;
        conv_store(c2, r2); h2 = it + 2 * NGW < hi;     if (h2) { c2 = conv_decode(p, it + 2 * NGW, lane); conv_load(c2, r2); }
        if (!h3) break;
        conv_store(c3, r3); h3 = it + 3 * NGW < hi;     if (h3) { c3 = conv_decode(p, it + 3 * NGW, lane); conv_load(c3, r3); }
    }
}
#define CV_P0_END (CV_GU0 + 13500)
#define CV_P3_END (CV_P0_END + 6800)
#define CV_P4_END (CV_P3_END + 14200)

template <bool TR>
struct EpiInProj8 {
    const MKParams& p; int m0, n0;
    __device__ __forceinline__ void operator()(f32x4 (&acc)[2][2][4][2], int wr, int wc, int fr, int fq) const {
#pragma unroll
        for (int ai = 0; ai < 2; ++ai)
#pragma unroll
            for (int m = 0; m < 4; ++m) {
                if (TR) {
                    const int token = m0 + ai * 128 + wr * 64 + m * 16 + fr;
                    const float rs = p.rstd_x[token];
#pragma unroll
                    for (int bj = 0; bj < 2; ++bj)
#pragma unroll
                        for (int n = 0; n < 2; ++n) {
                            const int col = n0 + bj * 128 + wc * 32 + n * 16 + fq * 4;
                            const f32x4 a = acc[ai][bj][m][n];
                            uint2 w;
                            if (n0 < 1024) {
                                w.x = pk2(a[0] * rs, a[1] * rs); w.y = pk2(a[2] * rs, a[3] * rs);
                                *(uint2*)(p.ua + ((size_t)(col >> 4) * 256 + (token >> 5)) * 768 + (token & 31) * 16 + (col & 15)) = w;
                            } else if (n0 < 2048) {
                                const float r8 = rs * 0.125f;
                                w.x = pk2(a[0] * r8, a[1] * r8); w.y = pk2(a[2] * r8, a[3] * r8);
                                *(uint2*)(p.qb + (size_t)token * 1024 + (col - 1024)) = w;
                            } else {
                                w.x = pk2(a[0] * rs, a[1] * rs); w.y = pk2(a[2] * rs, a[3] * rs);
                                *(uint2*)(p.kb + (size_t)token * 1024 + (col - 2048)) = w;
                            }
                        }
                } else {
                    const int token = m0 + ai * 128 + wr * 64 + m * 16 + fq * 4;
                    const float4 rs = *(const float4*)(p.rstd_x + token);
#pragma unroll
                    for (int bj = 0; bj < 2; ++bj)
#pragma unroll
                        for (int n = 0; n < 2; ++n) {
                            const int f = n0 - 3072 + bj * 128 + wc * 32 + n * 16 + fr;
                            const f32x4 a = acc[ai][bj][m][n];
                            uint2 w; w.x = pk2(a[0] * rs.x, a[1] * rs.y); w.y = pk2(a[2] * rs.z, a[3] * rs.w);
                            *(uint2*)(p.vT + (size_t)f * L_ + token) = w;
                        }
                }
            }
    }
};
struct MidOut8 {
    const float* rows;
    __device__ __forceinline__ void operator()(int t, f32x4 (&acc)[2][2][4][2], int wr, int fr, int fq) const {
        if (t == 16) {
#pragma unroll
            for (int ai = 0; ai < 2; ++ai)
#pragma unroll
                for (int m = 0; m < 4; ++m) {
                    const float ratio = rows[ai * 128 + wr * 64 + m * 16 + fr];
#pragma unroll
                    for (int bj = 0; bj < 2; ++bj)
#pragma unroll
                        for (int n = 0; n < 2; ++n) acc[ai][bj][m][n] *= ratio;
                }
        }
    }
};
struct EpiOut8 {
    const MKParams& p; const float* rows; int m0, n0, pn;
    __device__ __forceinline__ void operator()(f32x4 (&acc)[2][2][4][2], int wr, int wc, int fr, int fq) const {
#pragma unroll
        for (int ai = 0; ai < 2; ++ai)
#pragma unroll
            for (int m = 0; m < 4; ++m) {
                const int rt = ai * 128 + wr * 64 + m * 16 + fr, token = m0 + rt;
                const float rn = rows[256 + rt];
                float ss = 0.f;
#pragma unroll
                for (int bj = 0; bj < 2; ++bj)
#pragma unroll
                    for (int n = 0; n < 2; ++n) {
                        const int col = n0 + bj * 128 + wc * 32 + n * 16 + fq * 4;
                        const float4 xv = *(const float4*)(p.x + (size_t)token * D_ + col);
                        const float4 g = *(const float4*)(p.g_ffn + col);
                        const f32x4 a = acc[ai][bj][m][n];
                        const float v0 = xv.x + a[0] * rn, v1 = xv.y + a[1] * rn, v2 = xv.z + a[2] * rn, v3 = xv.w + a[3] * rn;
                        ss += v0 * v0 + v1 * v1 + v2 * v2 + v3 * v3;
                        uint2 w; w.x = pk2(v0 * g.x, v1 * g.y); w.y = pk2(v2 * g.z, v3 * g.w);
                        *(uint2*)(p.x1g + (size_t)token * D_ + col) = w;
                    }
                ss += __shfl_xor(ss, 16); ss += __shfl_xor(ss, 32);
                if (fq == 0) p.ssq_x1[token * 32 + pn * 4 + wc] = ss;
            }
    }
};
struct EpiMoe1_8 {
    const MKParams& p; int e, mt, nt;
    __device__ __forceinline__ void operator()(f32x4 (&acc)[2][2][4][2], int wr, int wc, int fr, int fq) const {
#pragma unroll
        for (int ai = 0; ai < 2; ++ai)
#pragma unroll
            for (int m = 0; m < 4; ++m) {
                const int slot = mt * 256 + ai * 128 + wr * 64 + m * 16 + fr;
                const float rs = p.rstd_x1[p.idx[e * CAP_ + slot]];
#pragma unroll
                for (int n = 0; n < 2; ++n) {
                    const f32x4 g = acc[ai][0][m][n] * rs, u = acc[ai][1][m][n] * rs;
                    float a[4];
#pragma unroll
                    for (int i = 0; i < 4; ++i) a[i] = g[i] / (1.f + __expf(-g[i])) * u[i];
                    uint2 w; w.x = pk2(a[0], a[1]); w.y = pk2(a[2], a[3]);
                    *(uint2*)(p.act + (size_t)(e * CAP_ + slot) * FF_ + nt * 128 + wc * 32 + n * 16 + fq * 4) = w;
                }
            }
    }
};
struct EpiMoe2_8 {
    const MKParams& p; int e, mt, nt;
    __device__ __forceinline__ void operator()(f32x4 (&acc)[2][2][4][2], int wr, int wc, int fr, int fq) const {
#pragma unroll
        for (int ai = 0; ai < 2; ++ai)
#pragma unroll
            for (int m = 0; m < 4; ++m) {
                const int slot = mt * 256 + ai * 128 + wr * 64 + m * 16 + fr;
                const float gt = p.gate[e * CAP_ + slot];
#pragma unroll
                for (int bj = 0; bj < 2; ++bj)
#pragma unroll
                    for (int n = 0; n < 2; ++n) {
                        const f32x4 a = acc[ai][bj][m][n] * gt;
                        uint2 w; w.x = pk2(a[0], a[1]); w.y = pk2(a[2], a[3]);
                        *(uint2*)(p.ye + (size_t)(e * CAP_ + slot) * D_ + nt * 256 + bj * 128 + wc * 32 + n * 16 + fq * 4) = w;
                    }
            }
    }
};

__device__ __forceinline__ void phase_prep(const MKParams& p, int gw, int NGW, int lane) {
    for (int row = gw; row < L_; row += NGW) {
        const float4* xr = (const float4*)(p.x + (size_t)row * D_);
        const float4* gr = (const float4*)p.g_mix;
        float s = 0.f;
        uint2* o = (uint2*)(p.xn + (size_t)row * XN_LD);
#pragma unroll
        for (int j = 0; j < 8; ++j) {
            const float4 v = xr[lane + 64 * j]; const float4 g = gr[lane + 64 * j];
            s += v.x * v.x + v.y * v.y + v.z * v.z + v.w * v.w;
            uint2 w; w.x = pk2(v.x * g.x, v.y * g.y); w.y = pk2(v.z * g.z, v.w * g.w);
            o[lane + 64 * j] = w;
        }
        s = wave_sum(s);
        if (lane == 0) p.rstd_x[row] = 1.0f / sqrtf(s * (1.0f / D_) + 1e-6f);
    }
    for (int i = gw * 64 + lane; i < NE_ * D_; i += NGW * 64) {
        const int e = i >> 11, n = i & (D_ - 1);
        const float w = p.w_router[n * NE_ + e];
        const unsigned hi = pk2(w, 0.f) & 0xffffu;
        const float rem = w - __uint_as_float(hi << 16);
        p.wrT[i] = (bf16_t)hi; p.wrT[NE_ * D_ + i] = (bf16_t)(pk2(rem, 0.f) & 0xffffu);
    }
}

__device__ __forceinline__ void phase_inproj(const MKParams& p, unsigned char* smem, int b) {
    for (int it = b; it < 512; it += gridDim.x) {
        const int xcd = it & 7, q = it >> 3;
        const int pn = (q & 1) * 8 + xcd;
        const int pm = q >> 1;
        const int m0 = pm * 256, n0 = pn * 256;
        ARows al{p.xn + (size_t)m0 * XN_LD, XN_LD};
        BHalves bl{p.w_in_t + (size_t)n0 * XN_LD, p.w_in_t + (size_t)(n0 + 128) * XN_LD, XN_LD};
        BgConv bg{p.w_gate, (long)(p.w_up - p.w_gate), p.w_gate_t, (long)(p.w_up_t - p.w_gate_t), BG_GU0 + (it >> 8) * 15 * 256 + (it & 255)};
        if (n0 < 3072) gemm8_tile<true>(smem, al, bl, D_ / 64, NoMid8{}, EpiInProj8<true>{p, m0, n0}, bg);
        else           gemm8_tile<false>(smem, al, bl, D_ / 64, NoMid8{}, EpiInProj8<false>{p, m0, n0}, bg);
    }
}

#define UA_LD 768
#define WSYNC() asm volatile("s_waitcnt lgkmcnt(0)" ::: "memory")
__device__ __forceinline__ void tw_sync(volatile LAS unsigned* cnt, unsigned& epoch, int lane) {
    WSYNC();
    if (lane == 0) __hip_atomic_fetch_add((LAS unsigned*)cnt, 1u, __ATOMIC_RELEASE, __HIP_MEMORY_SCOPE_WORKGROUP);
    ++epoch;
    while (__hip_atomic_load((LAS unsigned*)cnt, __ATOMIC_ACQUIRE, __HIP_MEMORY_SCOPE_WORKGROUP) < 4u * epoch) __builtin_amdgcn_s_sleep(1);
    asm volatile("" ::: "memory");
}
__device__ __forceinline__ void ssm_tables(const MKParams& p, unsigned char* smem, int g, int part, int tw, int lane, volatile LAS unsigned* cnt, unsigned& epoch) {
    float2* apow = (float2*)(smem + SM_GEMM);
    float2* bbar = apow + 2 * 33 * 64;
    float2* cc = bbar + 2 * 64 * 16;
    float* taps = (float*)(cc + 2 * 16 * 64);
    if (tw < 2) {
        const int d = tw;
        const int pp = lane;
        const float lr = (d ? p.a_re_b : p.a_re_f)[g * 64 + pp], li = (d ? p.a_im_b : p.a_im_f)[g * 64 + pp];
        const float dt = expf((d ? p.ldt_b : p.ldt_f)[g]);
        const float x = lr * dt, y = li * dt;
        const float ex = expf(x), cy = cosf(y), sy = sinf(y), sh = sinf(0.5f * y);
        const float ar = ex * cy, ai = ex * sy;
        float sr = 1.f, si = 0.f;
        for (int t = 0; t <= 32; ++t) {
            apow[(d * 33 + t) * 64 + pp] = make_float2(sr, si);
            const float nr = sr * ar - si * ai, ni = sr * ai + si * ar; sr = nr; si = ni;
        }
        if (part == 0) *(float2*)(p.A32 + ((size_t)(g * 2 + d) * 64 + pp) * 2) = apow[(d * 33 + 32) * 64 + pp];
        const float nr = expm1f(x) * cy - 2.f * sh * sh, ni = ex * sy;
        const float den = lr * lr + li * li;
        const float fr_ = (nr * lr + ni * li) / den, fi_ = (ni * lr - nr * li) / den;
        const float* brp = (d ? p.b_re_b : p.b_re_f) + (g * 64 + pp) * 16;
        const float* bip = (d ? p.b_im_b : p.b_im_f) + (g * 64 + pp) * 16;
#pragma unroll
        for (int q4 = 0; q4 < 4; ++q4) {
            const float4 br = *(const float4*)(brp + q4 * 4), bi = *(const float4*)(bip + q4 * 4);
            float2* o = bbar + (d * 64 + pp) * 16 + q4 * 4;
            o[0] = make_float2(fr_ * br.x - fi_ * bi.x, fr_ * bi.x + fi_ * br.x);
            o[1] = make_float2(fr_ * br.y - fi_ * bi.y, fr_ * bi.y + fi_ * br.y);
            o[2] = make_float2(fr_ * br.z - fi_ * bi.z, fr_ * bi.z + fi_ * br.z);
            o[3] = make_float2(fr_ * br.w - fi_ * bi.w, fr_ * bi.w + fi_ * br.w);
        }
        const float* crp = (d ? p.c_re_b : p.c_re_f) + (g * 16) * 64 + pp;
        const float* cip = (d ? p.c_im_b : p.c_im_f) + (g * 16) * 64 + pp;
#pragma unroll
        for (int co = 0; co < 16; ++co) cc[(d * 16 + co) * 64 + pp] = make_float2(crp[co * 64], cip[co * 64]);
    }
    tw_sync(cnt, epoch, lane);
    {
        const int li_ = lane & 15, lk = lane >> 4;
#pragma unroll 1
        for (int co = tw * 4; co < tw * 4 + 4; ++co) {
#pragma unroll 1
            for (int d = 0; d < 2; ++d) {
                f32x4 acc0 = (f32x4){0.f, 0.f, 0.f, 0.f}, acc1 = acc0;
#pragma unroll 4
                for (int s = 0; s < 32; ++s) {
                    const int q = 2 * s + (lk >> 1), ri = lk & 1;
                    const float2 c = cc[(d * 16 + co) * 64 + q], bb = bbar[(d * 64 + q) * 16 + li_];
                    const float gb = ri ? -(c.x * bb.y + c.y * bb.x) : (c.x * bb.x - c.y * bb.y);
                    const float2 a0 = apow[(d * 33 + li_) * 64 + q], a1 = apow[(d * 33 + 16 + li_) * 64 + q];
                    acc0 = __builtin_amdgcn_mfma_f32_16x16x4f32(ri ? a0.y : a0.x, gb, acc0, 0, 0, 0);
                    acc1 = __builtin_amdgcn_mfma_f32_16x16x4f32(ri ? a1.y : a1.x, gb, acc1, 0, 0, 0);
                }
#pragma unroll
                for (int r = 0; r < 4; ++r) {
                    const int t0 = 4 * lk + r, t1 = 16 + 4 * lk + r;
                    float* p0 = taps + ((d ? 31 - t0 : 31 + t0) * 16 + co) * 16 + li_;
                    float* p1 = taps + ((d ? 31 - t1 : 31 + t1) * 16 + co) * 16 + li_;
                    if (d == 1 && t0 == 0) *p0 += acc0[r]; else *p0 = acc0[r];
                    *p1 = acc1[r];
                }
            }
        }
    }
    tw_sync(cnt, epoch, lane);
#pragma unroll 1
    for (int it = lane; it < 32 * 96; it += 64) {
        const int n = part * 128 + tw * 32 + it / 96, k = (it % 96) * 8;
        const int l = n >> 4, co = n & 15;
        float v[8];
        if (k < 512) {
            const int j = k >> 4, ci0 = ((k >> 3) & 1) * 8;
            const float* tp = taps + ((l - j + 31) * 16 + co) * 16 + ci0;
#pragma unroll
            for (int q = 0; q < 8; ++q) v[q] = tp[q];
        } else {
            const int k2 = k - 512, d = k2 >> 7, pp0 = (k2 >> 1) & 63;
            const int t = d ? (32 - l) : (l + 1);
#pragma unroll
            for (int q = 0; q < 4; ++q) {
                const float2 a = apow[(d * 33 + t) * 64 + pp0 + q], c = cc[(d * 16 + co) * 64 + pp0 + q];
                v[2 * q] = c.x * a.x - c.y * a.y; v[2 * q + 1] = -(c.x * a.y + c.y * a.x);
            }
        }
        uint4 w; w.x = pk2(v[0], v[1]); w.y = pk2(v[2], v[3]); w.z = pk2(v[4], v[5]); w.w = pk2(v[6], v[7]);
        *(uint4*)(p.WyT + ((size_t)g * 512 + n) * UA_LD + k) = w;
    }
#pragma unroll 1
    for (int it = lane; it < 16 * 64; it += 64) {
        const int n2 = part * 64 + tw * 16 + (it >> 6), kc = it & 63;
        const int d = n2 >> 7, pp = (n2 >> 1) & 63, ri = n2 & 1, j = kc >> 1, half = kc & 1;
        const int t = d ? j : 31 - j;
        const float2 a = apow[(d * 33 + t) * 64 + pp];
        const float2* bp = bbar + (d * 64 + pp) * 16 + half * 8;
        float v[8];
#pragma unroll
        for (int q = 0; q < 8; ++q) { const float2 b = bp[q]; v[q] = ri ? (a.x * b.y + a.y * b.x) : (a.x * b.x - a.y * b.y); }
        uint4 w; w.x = pk2(v[0], v[1]); w.y = pk2(v[2], v[3]); w.z = pk2(v[4], v[5]); w.w = pk2(v[6], v[7]);
        *(uint4*)(p.PBt + ((size_t)g * 256 + n2) * 512 + kc * 8) = w;
    }
    tw_sync(cnt, epoch, lane);
}

#define SE_PITCH 132
struct EpiSsmE {
    const MKParams& p; unsigned char* smem; int g;
    __device__ __forceinline__ void operator()(f32x4 (&acc)[2][2][4][2], int wr, int wc, int fr, int fq) const {
        float* E = (float*)(smem + SM_GEMM);
        const int tid = opaque_tid();
#pragma unroll
        for (int d = 0; d < 2; ++d) {
            __syncthreads();
#pragma unroll
            for (int ai = 0; ai < 2; ++ai)
#pragma unroll
                for (int m = 0; m < 4; ++m)
#pragma unroll
                    for (int n = 0; n < 2; ++n)
                        *(f32x4*)(E + (ai * 128 + wr * 64 + m * 16 + fr) * SE_PITCH + wc * 32 + n * 16 + fq * 4) = acc[ai][d][m][n];
            __syncthreads();
            if (tid < 64) {
                const int pp = tid;
                const float2 A = *(const float2*)(p.A32 + ((size_t)(g * 2 + d) * 64 + pp) * 2);
                bf16_t* sdst = p.ua + (size_t)g * 256 * UA_LD + 512 + d * 128 + pp * 2;
                float sr = 0.f, si = 0.f;
#pragma unroll 8
                for (int s = 0; s < 256; ++s) {
                    const int c = d ? (255 - s) : s;
                    const float2 e = *(const float2*)(E + c * SE_PITCH + pp * 2);
                    *(unsigned*)(sdst + (size_t)c * UA_LD) = pk2(sr, si);
                    const float nr = A.x * sr - A.y * si + e.x, ni = A.x * si + A.y * sr + e.y;
                    sr = nr; si = ni;
                }
            }
        }
    }
};
__device__ __forceinline__ void ssm_e_item(const MKParams& p, unsigned char* smem, int g) {
    ARows al{p.ua + (size_t)g * 256 * UA_LD, UA_LD};
    BHalves bl{p.PBt + (size_t)g * 256 * 512, p.PBt + ((size_t)g * 256 + 128) * 512, 512};
    gemm8_tile<true>(smem, al, bl, 8, NoMid8{}, EpiSsmE{p, smem, g}, NoBg{});
}

__device__ __forceinline__ float gelu_tanh_f(float x) {
    const float k0 = 0.7978845608028654f, k1 = 0.044715f;
    const float z = k0 * (x + k1 * x * x * x);
    const float e = __expf(2.f * z);
    return 0.5f * x * (2.f - 2.f / (1.f + e));
}
struct EpiSsmY {
    const MKParams& p; int g, nh;
    __device__ __forceinline__ void operator()(f32x4 (&acc)[2][2][4][2], int wr, int wc, int fr, int fq) const {
        const float4 dsk = *(const float4*)(p.ssm_d + g * 16 + fq * 4);
#pragma unroll
        for (int ai = 0; ai < 2; ++ai)
#pragma unroll
            for (int m = 0; m < 4; ++m) {
                const int c = ai * 128 + wr * 64 + m * 16 + fr;
                const bf16_t* urow = p.ua + ((size_t)g * 256 + c) * UA_LD + fq * 4;
#pragma unroll
                for (int bj = 0; bj < 2; ++bj)
#pragma unroll
                    for (int n = 0; n < 2; ++n) {
                        const int l = nh * 16 + bj * 8 + wc * 2 + n;
                        const uint2 uu = *(const uint2*)(urow + l * 16);
                        const f32x4 a = acc[ai][bj][m][n];
                        const float y0 = gelu_tanh_f(a[0] + dsk.x * bflo(uu.x)), y1 = gelu_tanh_f(a[1] + dsk.y * bfhi(uu.x));
                        const float y2 = gelu_tanh_f(a[2] + dsk.z * bflo(uu.y)), y3 = gelu_tanh_f(a[3] + dsk.w * bfhi(uu.y));
                        uint2 w; w.x = pk2(y0, y1); w.y = pk2(y2, y3);
                        *(uint2*)(p.ypre + (size_t)(c * 32 + l) * DS_ + g * 16 + fq * 4) = w;
                    }
            }
    }
};
__device__ __forceinline__ void ssm_y_item(const MKParams& p, unsigned char* smem, int g, int nh) {
    ARows al{p.ua + (size_t)g * 256 * UA_LD, UA_LD};
    BHalves bl{p.WyT + ((size_t)g * 512 + nh * 256) * UA_LD, p.WyT + ((size_t)g * 512 + nh * 256 + 128) * UA_LD, UA_LD};
    gemm8_tile<true>(smem, al, bl, 12, NoMid8{}, EpiSsmY{p, g, nh}, NoBg{});
}

#define NA_RING (SM_GEMM)
#define NA_RPB  (SM_GEMM + 7 * 16384 + 1024)
#define NA_D 5
__device__ __forceinline__ int na_clip(int v) { return v < 0 ? 0 : (v > 120 ? 120 : v); }
__device__ __forceinline__ void na_run(const MKParams& p, unsigned char* smem, int it0, int it1, int it2, int nitems) {
    int tid_ = threadIdx.x; asm volatile("" : "+v"(tid_));
    const int tid = tid_, lane = tid & 63, fr = lane & 15, fq = lane >> 4;
    const int wave = __builtin_amdgcn_readfirstlane(tid >> 6);
    const int r00 = (it0 >> 4) * 4, r01 = (it1 >> 4) * 4, r02 = (it2 >> 4) * 4;
    const int ns0 = na_clip(r00 - 1) + 7 - na_clip(r00 - 4) + 1;
    const int ns1 = nitems > 1 ? na_clip(r01 - 1) + 7 - na_clip(r01 - 4) + 1 : 0;
    const int ns2 = nitems > 2 ? na_clip(r02 - 1) + 7 - na_clip(r02 - 4) + 1 : 0;
    const int T = ns0 + ns1 + ns2;
    const int keyK = (((wave & 3) << 1) | ((lane >> 4) & 1));
    const int keyV = (4 * wave + (lane >> 4)) & 7;
    const unsigned kofs = (unsigned)((8 * wave + (lane >> 3)) * 1024 + (((lane & 7) ^ keyK) << 3));
    const unsigned vofs = (unsigned)((8 * wave + (lane >> 3)) * L_ + (((lane & 7) ^ keyV) << 3));
    const GAS bf16_t* const kbase = uniform_ptr(p.kb);
    const GAS bf16_t* const vbase = uniform_ptr(p.vT);
    const int kfrag = (8 * (fr >> 2) + (fr & 3)) * 128;
    const int keyKr = ((fr >> 2) << 1) | ((fr >> 1) & 1);
    const int kc0 = ((fq ^ keyKr) & 7) << 4, kc1 = (((fq | 4) ^ keyKr) & 7) << 4;
    const int keyVr = (fr >> 1) & 7;
    const int vfrag = 8192 + fr * 128;
    const int vc0 = ((fq ^ keyVr) & 7) << 4, vc1 = (((fq | 4) ^ keyVr) & 7) << 4;
#define NA_LOC(g, I, S) do { if ((g) < ns0) { I = 0; S = (g); } else if ((g) < ns0 + ns1) { I = 1; S = (g) - ns0; } else { I = 2; S = (g) - ns0 - ns1; } } while (0)
#define NA_ISSUE(g) do { int _i, _s; NA_LOC(g, _i, _s); const int _it = _i == 0 ? it0 : (_i == 1 ? it1 : it2); const int _r0 = (_it >> 4) * 4, _h = _it & 15; \
        const int _kr = na_clip(_r0 - 4) + _s; const int _buf = ((g) % 7) * 16384; \
        __builtin_amdgcn_global_load_lds((const GAS unsigned*)(kbase + (size_t)(_kr * 64) * 1024 + _h * 64 + kofs), (LAS unsigned*)(smem + NA_RING + _buf + wave * 1024), 16, 0, 0); \
        __builtin_amdgcn_global_load_lds((const GAS unsigned*)(vbase + (size_t)(_h * 64) * L_ + _kr * 64 + vofs), (LAS unsigned*)(smem + NA_RING + _buf + 8192 + wave * 1024), 16, 0, 0); } while (0)
    __syncthreads();
#pragma unroll
    for (int g = 0; g < NA_D; ++g) if (g < T) NA_ISSUE(g);
    bf16x8 qf[2][2];
    f32x4 o[2][4];
    float mrow[2], lrow[2];
    int kbq[2], dxq[2];
#pragma unroll
    for (int qb = 0; qb < 2; ++qb) {
        mrow[qb] = -1e30f; lrow[qb] = 0.f; kbq[qb] = 0; dxq[qb] = 0;
#pragma unroll
        for (int ks = 0; ks < 2; ++ks) qf[qb][ks] = (bf16x8){0, 0, 0, 0, 0, 0, 0, 0};
#pragma unroll
        for (int mt = 0; mt < 4; ++mt) o[qb][mt] = (f32x4){0.f, 0.f, 0.f, 0.f};
    }
#pragma unroll 1
    for (int g = 0; g < T; ++g) {
        if (g + NA_D < T) NA_ISSUE(g + NA_D);
        {
            const int after = T - 1 - g;
            if (after >= 5) asm volatile("s_waitcnt vmcnt(10)" ::: "memory");
            else if (after == 4) asm volatile("s_waitcnt vmcnt(8)" ::: "memory");
            else if (after == 3) asm volatile("s_waitcnt vmcnt(6)" ::: "memory");
            else if (after == 2) asm volatile("s_waitcnt vmcnt(4)" ::: "memory");
            else if (after == 1) asm volatile("s_waitcnt vmcnt(2)" ::: "memory");
            else asm volatile("s_waitcnt vmcnt(0)" ::: "memory");
        }
        __builtin_amdgcn_s_barrier();
        asm volatile("" ::: "memory");
        int ii, s; NA_LOC(g, ii, s);
        const int it = ii == 0 ? it0 : (ii == 1 ? it1 : it2);
        const int r0 = (it >> 4) * 4, h = it & 15;
        const int kr = na_clip(r0 - 4) + s;
        const int r = r0 + (wave >> 1), qh = wave & 1;
        const int rs = na_clip(r - 4);
        if (s == 0) {
#pragma unroll
            for (int qb = 0; qb < 2; ++qb) {
#pragma unroll
                for (int ks = 0; ks < 2; ++ks) qf[qb][ks] = *(const bf16x8*)(p.qb + (size_t)(r * 64 + (2 * qh + qb) * 16 + fr) * 1024 + h * 64 + ks * 32 + fq * 8);
                const int c = (2 * qh + qb) * 16 + fr;
                int cs = c - 8; cs = cs < 0 ? 0 : (cs > 48 ? 48 : cs);
                kbq[qb] = 8 * fq - cs; dxq[qb] = (8 * fq - c + 15) * 4;
                mrow[qb] = -1e30f; lrow[qb] = 0.f;
#pragma unroll
                for (int mt = 0; mt < 4; ++mt) o[qb][mt] = (f32x4){0.f, 0.f, 0.f, 0.f};
            }
        }
        if (kr >= rs && kr <= rs + 7) {
            const unsigned char* st = smem + NA_RING + (g % 7) * 16384;
            const unsigned char* brow = smem + NA_RPB + ((h * 15 + (kr - r + 7)) * 31) * 4;
            f32x4 sc[2][2][2];
#pragma unroll
            for (int P = 0; P < 2; ++P)
#pragma unroll
                for (int sx = 0; sx < 2; ++sx) {
                    const bf16x8 k0 = *(const bf16x8*)(st + kfrag + (32 * P + 4 * sx) * 128 + kc0);
                    const bf16x8 k1 = *(const bf16x8*)(st + kfrag + (32 * P + 4 * sx) * 128 + kc1);
#pragma unroll
                    for (int qb = 0; qb < 2; ++qb) {
                        f32x4 a = (f32x4){0.f, 0.f, 0.f, 0.f};
                        a = __builtin_amdgcn_mfma_f32_16x16x32_bf16(k0, qf[qb][0], a, 0, 0, 0);
                        a = __builtin_amdgcn_mfma_f32_16x16x32_bf16(k1, qf[qb][1], a, 0, 0, 0);
                        sc[P][sx][qb] = a;
                    }
                }
            unsigned pp[2][2][4];
#pragma unroll
            for (int qb = 0; qb < 2; ++qb) {
                const unsigned char* bq = brow + dxq[qb];
                float bv[16];
#pragma unroll
                for (int c16 = 0; c16 < 16; ++c16) bv[c16] = *(const float*)(bq + (32 * (c16 >> 3) + 4 * ((c16 >> 2) & 1) + (c16 & 3)) * 4);
                asm volatile("" : "+v"(bv[0]), "+v"(bv[1]), "+v"(bv[2]), "+v"(bv[3]), "+v"(bv[4]), "+v"(bv[5]), "+v"(bv[6]), "+v"(bv[7]),
                                  "+v"(bv[8]), "+v"(bv[9]), "+v"(bv[10]), "+v"(bv[11]), "+v"(bv[12]), "+v"(bv[13]), "+v"(bv[14]), "+v"(bv[15]));
                float ls = 0.f;
#pragma unroll
                for (int P = 0; P < 2; ++P)
#pragma unroll
                    for (int sx = 0; sx < 2; ++sx) {
                        float e[4];
#pragma unroll
                        for (int rg = 0; rg < 4; ++rg) {
                            const int cst = 32 * P + 4 * sx + rg;
                            const bool valid = (unsigned)(cst + kbq[qb]) < 16u;
                            const float ex = __expf(fminf(sc[P][sx][qb][rg] + bv[P * 8 + sx * 4 + rg], 60.f));
                            e[rg] = valid ? ex : 0.f;
                            ls += e[rg];
                        }
                        pp[qb][P][sx * 2 + 0] = pk2(e[0], e[1]);
                        pp[qb][P][sx * 2 + 1] = pk2(e[2], e[3]);
                    }
                lrow[qb] += ls;
            }
#pragma unroll
            for (int P = 0; P < 2; ++P)
#pragma unroll
                for (int mt = 0; mt < 4; ++mt) {
                    const bf16x8 vf = *(const bf16x8*)(st + vfrag + mt * 2048 + (P ? vc1 : vc0));
#pragma unroll
                    for (int qb = 0; qb < 2; ++qb) {
                        uint4 w; w.x = pp[qb][P][0]; w.y = pp[qb][P][1]; w.z = pp[qb][P][2]; w.w = pp[qb][P][3];
                        o[qb][mt] = __builtin_amdgcn_mfma_f32_16x16x32_bf16(vf, __builtin_bit_cast(bf16x8, w), o[qb][mt], 0, 0, 0);
                    }
                }
            if (kr == rs + 7) {
#pragma unroll
                for (int qb = 0; qb < 2; ++qb) {
                    float l = lrow[qb];
                    l += __shfl_xor(l, 16); l += __shfl_xor(l, 32);
                    const float inv = 1.f / l;
                    const int token = r * 64 + (2 * qh + qb) * 16 + fr;
                    float ss = 0.f;
#pragma unroll
                    for (int mt = 0; mt < 4; ++mt) {
                        const float4 g4 = *(const float4*)(p.g_na + h * 64 + mt * 16 + 4 * fq);
                        const f32x4 v = o[qb][mt] * inv;
                        ss += v[0] * v[0] + v[1] * v[1] + v[2] * v[2] + v[3] * v[3];
                        uint2 w; w.x = pk2(v[0] * g4.x, v[1] * g4.y); w.y = pk2(v[2] * g4.z, v[3] * g4.w);
                        *(uint2*)(p.ymix + (size_t)token * D_ + DS_ + h * 64 + mt * 16 + 4 * fq) = w;
                    }
                    ss += __shfl_xor(ss, 16); ss += __shfl_xor(ss, 32);
                    if (fq == 0) p.ssq_na[token * 16 + h] = ss;
                }
            }
        }
    }
}
__device__ __forceinline__ void phase2(const MKParams& p, unsigned char* smem, int b, int G) {
    for (int it = b; it < 64; it += G) ssm_e_item(p, smem, it);
    __syncthreads();
    const int tq = opaque_tid();
    { float* dst = (float*)(smem + NA_RPB); for (int i = tq; i < 16 * 15 * 31; i += NT_) dst[i] = p.rpb[i]; }
    if (G == 256) {
        if (b < 64) na_run(p, smem, b, 0, 0, 1);
        else { const int k = b - 64; na_run(p, smem, 64 + k, 256 + k, 448 + (k & 63), k < 64 ? 3 : 2); }
    } else {
        for (int it = b; it < 512; it += G) na_run(p, smem, it, 0, 0, 1);
    }
}

struct EpiGlu8 {
    const MKParams& p; int m0, n0, pn;
    __device__ __forceinline__ void operator()(f32x4 (&acc)[2][2][4][2], int wr, int wc, int fr, int fq) const {
#pragma unroll
        for (int ai = 0; ai < 2; ++ai)
#pragma unroll
            for (int m = 0; m < 4; ++m) {
                const int token = m0 + ai * 128 + wr * 64 + m * 16 + fr;
                float ss = 0.f;
#pragma unroll
                for (int bj = 0; bj < 2; ++bj)
#pragma unroll
                    for (int n = 0; n < 2; ++n) {
                        const int col = n0 + bj * 128 + wc * 32 + n * 16 + fq * 4;
                        const float4 b = *(const float4*)(p.b_glu + col);
                        const float4 g = *(const float4*)(p.g_ssm + col);
                        const uint2 yy = *(const uint2*)(p.ypre + (size_t)token * DS_ + col);
                        const f32x4 a = acc[ai][bj][m][n];
                        const float y0 = bflo(yy.x) / (1.f + __expf(-(a[0] + b.x))), y1 = bfhi(yy.x) / (1.f + __expf(-(a[1] + b.y)));
                        const float y2 = bflo(yy.y) / (1.f + __expf(-(a[2] + b.z))), y3 = bfhi(yy.y) / (1.f + __expf(-(a[3] + b.w)));
                        ss += y0 * y0 + y1 * y1 + y2 * y2 + y3 * y3;
                        uint2 w; w.x = pk2(y0 * g.x, y1 * g.y); w.y = pk2(y2 * g.z, y3 * g.w);
                        *(uint2*)(p.ymix + (size_t)token * D_ + col) = w;
                    }
                ss += __shfl_xor(ss, 16); ss += __shfl_xor(ss, 32);
                if (fq == 0) p.ssq_ssm[token * 16 + pn * 4 + wc] = ss;
            }
    }
};
__device__ __forceinline__ void glu_item(const MKParams& p, unsigned char* smem, int it) {
    const int pn = it & 3, pm = it >> 2;
    const int m0 = pm * 256, n0 = pn * 256;
    ARows al{p.ypre + (size_t)m0 * DS_, DS_};
    BHalves bl{p.w_glu_t + (size_t)n0 * DS_, p.w_glu_t + (size_t)(n0 + 128) * DS_, DS_};
    gemm8_tile<true>(smem, al, bl, DS_ / 64, NoMid8{}, EpiGlu8{p, m0, n0, pn}, NoBg{});
}

__device__ __forceinline__ float rstd16(const float* part) {
    const float4 a = ((const float4*)part)[0], b = ((const float4*)part)[1], c = ((const float4*)part)[2], d = ((const float4*)part)[3];
    const float s = ((a.x + a.y) + (a.z + a.w)) + ((b.x + b.y) + (b.z + b.w)) + ((c.x + c.y) + (c.z + c.w)) + ((d.x + d.y) + (d.z + d.w));
    return 1.0f / sqrtf(s * (1.0f / DS_) + 1e-6f);
}
struct MidOut {
    const float* rows;
    __device__ __forceinline__ void operator()(int kt, f32x4 (&acc)[8][4], int wr, int fr, int fq) const {
        if (kt == 16) {
#pragma unroll
            for (int m = 0; m < 8; ++m) {
                const float ratio = rows[wr * 128 + m * 16 + fr];
#pragma unroll
                for (int nn = 0; nn < 4; ++nn) acc[m][nn] *= ratio;
            }
        }
    }
};
struct EpiOut {
    const MKParams& p; const float* rows; int m0, n0, pn;
    __device__ __forceinline__ void operator()(f32x4 (&acc)[8][4], int wr, int wc, int fr, int fq) const {
#pragma unroll
        for (int m = 0; m < 8; ++m) {
            const int token = m0 + wr * 128 + m * 16 + fr;
            const float rn = rows[256 + wr * 128 + m * 16 + fr];
            float ss = 0.f;
#pragma unroll
            for (int nn = 0; nn < 4; ++nn) {
                const int col = n0 + wc * 64 + nn * 16 + fq * 4;
                const float4 xv = *(const float4*)(p.x + (size_t)token * D_ + col);
                const float4 g = *(const float4*)(p.g_ffn + col);
                const f32x4 a = acc[m][nn];
                const float v0 = xv.x + a[0] * rn, v1 = xv.y + a[1] * rn, v2 = xv.z + a[2] * rn, v3 = xv.w + a[3] * rn;
                ss += v0 * v0 + v1 * v1 + v2 * v2 + v3 * v3;
                uint2 w; w.x = pk2(v0 * g.x, v1 * g.y); w.y = pk2(v2 * g.z, v3 * g.w);
                *(uint2*)(p.x1g + (size_t)token * D_ + col) = w;
            }
            ss += __shfl_xor(ss, 16); ss += __shfl_xor(ss, 32);
            if (fq == 0) p.ssq_x1[token * 32 + pn * 4 + wc] = ss;
        }
    }
};
__device__ __forceinline__ void outproj_item(const MKParams& p, unsigned char* smem, int it) {
    const int pn = it & 7, pm = it >> 3;
    const int m0 = pm * 256, n0 = pn * 256;
    float* rows = (float*)(smem + SM_ROWS);
    __syncthreads();
    const int tq = opaque_tid();
    if (tq < 256) {
        const int token = m0 + tq;
        const float rs = rstd16(p.ssq_ssm + token * 16), rn = rstd16(p.ssq_na + token * 16);
        rows[tq] = rs / rn; rows[256 + tq] = rn;
    }
    ARows al{p.ymix + (size_t)m0 * D_, D_};
    BHalves bl{p.w_out_t + (size_t)n0 * D_, p.w_out_t + (size_t)(n0 + 128) * D_, D_};
    BgConv bg{p.w_gate, (long)(p.w_up - p.w_gate), p.w_gate_t, (long)(p.w_up_t - p.w_gate_t), BG_GU0 + 30 * 256 + it};
    gemm8_tile<true>(smem, al, bl, D_ / 64, MidOut8{rows}, EpiOut8{p, rows, m0, n0, pn}, bg);
}

#define RT_PART (SM_GEMM)
__device__ __forceinline__ void router_item(const MKParams& p, unsigned char* smem, int item) {
    const int tid = opaque_tid(), lane = tid & 63, wave = tid >> 6, fr = lane & 15, fq = lane >> 4;
    const int tile = item * 2 + (wave >> 2), kq = wave & 3;
    const int token = tile * 16 + fr;
    const bf16_t* xr = p.x1g + (size_t)token * D_ + kq * 512 + fq * 8;
    const bf16_t* wh = p.wrT + (size_t)fr * D_ + kq * 512 + fq * 8;
    const bf16_t* wl = wh + 16 * D_;
    f32x4 ah = (f32x4){0.f, 0.f, 0.f, 0.f}, alo = (f32x4){0.f, 0.f, 0.f, 0.f};
#pragma unroll 8
    for (int k = 0; k < 512; k += 32) {
        const bf16x8 xb = *(const bf16x8*)(xr + k);
        ah = __builtin_amdgcn_mfma_f32_16x16x32_bf16(*(const bf16x8*)(wh + k), xb, ah, 0, 0, 0);
        alo = __builtin_amdgcn_mfma_f32_16x16x32_bf16(*(const bf16x8*)(wl + k), xb, alo, 0, 0, 0);
    }
    f32x4* part = (f32x4*)(smem + RT_PART);
    __syncthreads();
    part[wave * 64 + lane] = ah + alo;
    __syncthreads();
    if (kq == 0) {
        const f32x4 t = part[wave * 64 + lane] + part[(wave + 1) * 64 + lane] + part[(wave + 2) * 64 + lane] + part[(wave + 3) * 64 + lane];
        const float4 s0 = *(const float4*)(p.ssq_x1 + token * 32 + fq * 8), s1 = *(const float4*)(p.ssq_x1 + token * 32 + fq * 8 + 4);
        float ss = ((s0.x + s0.y) + (s0.z + s0.w)) + ((s1.x + s1.y) + (s1.z + s1.w));
        ss += __shfl_xor(ss, 16); ss += __shfl_xor(ss, 32);
        const float rs = 1.0f / sqrtf(ss * (1.0f / D_) + 1e-6f);
        float l[4];
#pragma unroll
        for (int i = 0; i < 4; ++i) l[i] = t[i] * rs;
        float mx = fmaxf(fmaxf(l[0], l[1]), fmaxf(l[2], l[3]));
        mx = fmaxf(mx, __shfl_xor(mx, 16)); mx = fmaxf(mx, __shfl_xor(mx, 32));
        float e[4], sum = 0.f;
#pragma unroll
        for (int i = 0; i < 4; ++i) { e[i] = expf(l[i] - mx); sum += e[i]; }
        sum += __shfl_xor(sum, 16); sum += __shfl_xor(sum, 32);
        const float inv = 1.f / sum;
#pragma unroll
        for (int i = 0; i < 4; ++i) {
            const float a = e[i] * inv;
            p.aff_t[(size_t)(4 * fq + i) * L_ + token] = a;
            atomicAdd(p.ahist + (4 * fq + i) * 4096 + (__float_as_uint(a) >> 19), 1u);
        }
        if (fq == 0) p.rstd_x1[token] = rs;
    }
}

#define TK_MISC (SM_GEMM)
#define TK_SUF  (SM_GEMM + 64)
#define TK_LIST (SM_GEMM + 1024)
__device__ __forceinline__ void topk_item(const MKParams& p, unsigned char* smem, int e) {
    const int tid = opaque_tid(), lane = tid & 63, wave = tid >> 6;
    unsigned* misc = (unsigned*)(smem + TK_MISC);
    unsigned* wsum = (unsigned*)(smem + TK_SUF);
    uint2* list = (uint2*)(smem + TK_LIST);
    const float* a = p.aff_t + (size_t)e * L_;
    unsigned key[16];
#pragma unroll
    for (int i = 0; i < 16; ++i) key[i] = __float_as_uint(a[tid + NT_ * i]);
    const uint4 h0 = *(const uint4*)(p.ahist + e * 4096 + tid * 8), h1 = *(const uint4*)(p.ahist + e * 4096 + tid * 8 + 4);
    const unsigned hb[8] = {h0.x, h0.y, h0.z, h0.w, h1.x, h1.y, h1.z, h1.w};
    unsigned own = 0;
#pragma unroll
    for (int i = 0; i < 8; ++i) own += hb[i];
    unsigned suf = own;
#pragma unroll
    for (int o = 1; o < 64; o <<= 1) { const unsigned t = __shfl_down(suf, o); if (lane + o < 64) suf += t; }
    __syncthreads();
    if (lane == 0) wsum[wave] = suf;
    if (tid == 0) { misc[2] = 0u; misc[3] = 0u; }
    __syncthreads();
    unsigned above = suf - own;
#pragma unroll
    for (int w = 0; w < 8; ++w) if (w > wave) above += wsum[w];
    if (above < (unsigned)CAP_ && (unsigned)CAP_ <= above + own) {
        unsigned cnt = above;
#pragma unroll
        for (int i = 7; i >= 0; --i) {
            if (cnt < (unsigned)CAP_ && (unsigned)CAP_ <= cnt + hb[i]) { misc[0] = (unsigned)(tid * 8 + i); misc[1] = (unsigned)CAP_ - cnt; }
            cnt += hb[i];
        }
    }
    __syncthreads();
    const unsigned T = misc[0], need = misc[1];
#pragma unroll
    for (int i = 0; i < 16; ++i)
        if ((key[i] >> 19) == T) { const unsigned s = atomicAdd(&misc[3], 1u); list[s] = make_uint2(key[i], (unsigned)(tid + NT_ * i)); }
    __syncthreads();
    const unsigned nc = misc[3];
#pragma unroll
    for (int i = 0; i < 16; ++i) {
        const int token = tid + NT_ * i;
        const unsigned bin = key[i] >> 19;
        if (bin != T) {
            int slot = -1;
            if (bin > T) {
                slot = (int)atomicAdd(&misc[2], 1u);
                p.idx[e * CAP_ + slot] = token;
                p.gate[e * CAP_ + slot] = __uint_as_float(key[i]);
            }
            p.slot_of[token * NE_ + e] = slot;
        }
    }
    for (unsigned c0 = tid; c0 < nc; c0 += NT_) {
        const uint2 me = list[c0];
        unsigned rank = 0;
        unsigned j = 0;
        for (; j + 4 <= nc; j += 4) {
            const uint2 a0 = list[j], a1 = list[j + 1], a2 = list[j + 2], a3 = list[j + 3];
            rank += (a0.x > me.x || (a0.x == me.x && a0.y < me.y)) ? 1u : 0u;
            rank += (a1.x > me.x || (a1.x == me.x && a1.y < me.y)) ? 1u : 0u;
            rank += (a2.x > me.x || (a2.x == me.x && a2.y < me.y)) ? 1u : 0u;
            rank += (a3.x > me.x || (a3.x == me.x && a3.y < me.y)) ? 1u : 0u;
        }
        for (; j < nc; ++j) { const uint2 a0 = list[j]; rank += (a0.x > me.x || (a0.x == me.x && a0.y < me.y)) ? 1u : 0u; }
        int slot = -1;
        if (rank < need) {
            slot = (int)atomicAdd(&misc[2], 1u);
            p.idx[e * CAP_ + slot] = (int)me.y;
            p.gate[e * CAP_ + slot] = __uint_as_float(me.x);
        }
        p.slot_of[me.y * NE_ + e] = slot;
    }
    __syncthreads();
}

struct AGather { const bf16_t* base; const int* rows; __device__ __forceinline__ const bf16_t* ubase() const { return base; } __device__ __forceinline__ unsigned row_off(int r) const { return (unsigned)rows[r] * (unsigned)D_; } };
struct BMoe1 {
    const float* wg; long up_minus_gate; int col0;
    __device__ __forceinline__ const float* ubase(int wave) const { return wg + (long)(wave & 1) * up_minus_gate; }
    __device__ __forceinline__ unsigned col_off(int n4) const {
        const int wc = n4 >> 6, nn = (n4 >> 4) & 3, i = n4 & 15;
        return (unsigned)(col0 + wc * 32 + (nn & 1) * 16 + i);
    }
};
struct EpiMoe1 {
    const MKParams& p; int e, mt, nt;
    __device__ __forceinline__ void operator()(f32x4 (&acc)[8][4], int wr, int wc, int fr, int fq) const {
#pragma unroll
        for (int m = 0; m < 8; ++m) {
            const int slot = mt * 256 + wr * 128 + m * 16 + fr;
            const float rs = p.rstd_x1[p.idx[e * CAP_ + slot]];
#pragma unroll
            for (int nn = 0; nn < 2; ++nn) {
                const f32x4 g = acc[m][nn] * rs, u = acc[m][nn + 2] * rs;
                float a[4];
#pragma unroll
                for (int i = 0; i < 4; ++i) a[i] = g[i] / (1.f + __expf(-g[i])) * u[i];
                uint2 w; w.x = pk2(a[0], a[1]); w.y = pk2(a[2], a[3]);
                *(uint2*)(p.act + (size_t)(e * CAP_ + slot) * FF_ + nt * 128 + wc * 32 + nn * 16 + fq * 4) = w;
            }
        }
    }
};
__device__ __forceinline__ void moe1_item(const MKParams& p, unsigned char* smem, int it) {
    const int rnd = it >> 8, b = it & 255, xcd = b & 7, s = b >> 3;
    const int mt = s & 3, wt = rnd * 64 + xcd * 8 + (s >> 2);
    const int e = wt >> 4, nt = wt & 15;
    AGather al{p.x1g, p.idx + e * CAP_ + mt * 256};
    BHalves bl{p.w_gate_t + ((size_t)e * FF_ + nt * 128) * D_, p.w_up_t + ((size_t)e * FF_ + nt * 128) * D_, D_};
    BgConv bg{p.w_down, 0L, p.w_down_t, 0L, rnd * 15 * 256 + b};
    gemm8_tile<true>(smem, al, bl, D_ / 64, NoMid8{}, EpiMoe1_8{p, e, mt, nt}, bg);
}

struct EpiMoe2 {
    const MKParams& p; int e, mt, nt;
    __device__ __forceinline__ void operator()(f32x4 (&acc)[8][4], int wr, int wc, int fr, int fq) const {
#pragma unroll
        for (int m = 0; m < 8; ++m) {
            const int slot = mt * 256 + wr * 128 + m * 16 + fr;
            const float gt = p.gate[e * CAP_ + slot];
#pragma unroll
            for (int nn = 0; nn < 4; ++nn) {
                const f32x4 a = acc[m][nn] * gt;
                uint2 w; w.x = pk2(a[0], a[1]); w.y = pk2(a[2], a[3]);
                *(uint2*)(p.ye + (size_t)(e * CAP_ + slot) * D_ + nt * 256 + wc * 64 + nn * 16 + fq * 4) = w;
            }
        }
    }
};
__device__ __forceinline__ void moe2_item(const MKParams& p, unsigned char* smem, int it) {
    const int rnd = it >> 8, b = it & 255, xcd = b & 7, s = b >> 3;
    const int mt = s & 3, wt = rnd * 64 + xcd * 8 + (s >> 2);
    const int e = wt >> 3, nt = wt & 7;
    ARows al{p.act + (size_t)(e * CAP_ + mt * 256) * FF_, FF_};
    BHalves bl{p.w_down_t + ((size_t)e * D_ + nt * 256) * FF_, p.w_down_t + ((size_t)e * D_ + nt * 256 + 128) * FF_, FF_};
    gemm8_tile<true>(smem, al, bl, FF_ / 64, NoMid8{}, EpiMoe2_8{p, e, mt, nt}, NoBg{});
}

__device__ __forceinline__ void final_token(const MKParams& p, int token, int lane) {
    float v[4][8];
#pragma unroll
    for (int j = 0; j < 4; ++j) {
        const int n = j * 512 + lane * 8;
        const uint4 w = *(const uint4*)(p.x1g + (size_t)token * D_ + n);
        const float4 g0 = *(const float4*)(p.g_ffn + n), g1 = *(const float4*)(p.g_ffn + n + 4);
        v[j][0] = bflo(w.x) / g0.x; v[j][1] = bfhi(w.x) / g0.y; v[j][2] = bflo(w.y) / g0.z; v[j][3] = bfhi(w.y) / g0.w;
        v[j][4] = bflo(w.z) / g1.x; v[j][5] = bfhi(w.z) / g1.y; v[j][6] = bflo(w.w) / g1.z; v[j][7] = bfhi(w.w) / g1.w;
    }
#pragma unroll 1
    for (int e = 0; e < NE_; ++e) {
        const int slot = p.slot_of[token * NE_ + e];
        if (slot >= 0) {
            const bf16_t* yr = p.ye + (size_t)(e * CAP_ + slot) * D_;
#pragma unroll
            for (int j = 0; j < 4; ++j) {
                const uint4 w = *(const uint4*)(yr + j * 512 + lane * 8);
                v[j][0] += bflo(w.x); v[j][1] += bfhi(w.x); v[j][2] += bflo(w.y); v[j][3] += bfhi(w.y);
                v[j][4] += bflo(w.z); v[j][5] += bfhi(w.z); v[j][6] += bflo(w.w); v[j][7] += bfhi(w.w);
            }
        }
    }
    float ss = 0.f;
#pragma unroll
    for (int j = 0; j < 4; ++j)
#pragma unroll
        for (int i = 0; i < 8; ++i) ss += v[j][i] * v[j][i];
    ss = wave_sum(ss);
    const float rs = 1.0f / sqrtf(ss * (1.0f / D_) + 1e-6f);
#pragma unroll
    for (int j = 0; j < 4; ++j) {
        const int n = j * 512 + lane * 8;
        const float4 g0 = *(const float4*)(p.g_final + n), g1 = *(const float4*)(p.g_final + n + 4);
        float4 o0, o1;
        o0.x = v[j][0] * rs * g0.x; o0.y = v[j][1] * rs * g0.y; o0.z = v[j][2] * rs * g0.z; o0.w = v[j][3] * rs * g0.w;
        o1.x = v[j][4] * rs * g1.x; o1.y = v[j][5] * rs * g1.y; o1.z = v[j][6] * rs * g1.z; o1.w = v[j][7] * rs * g1.w;
        *(float4*)(p.out + (size_t)token * D_ + n) = o0;
        *(float4*)(p.out + (size_t)token * D_ + n + 4) = o1;
    }
}


#ifndef REP0
#define REP0 1
#endif
#ifndef REP1
#define REP1 1
#endif
#ifndef REP2
#define REP2 1
#endif
#ifndef REP3
#define REP3 1
#endif
#ifndef REP4
#define REP4 1
#endif
#ifndef REP5
#define REP5 1
#endif
#ifndef REP6
#define REP6 1
#endif
#ifndef REP7
#define REP7 1
#endif
#ifndef REP8
#define REP8 1
#endif
#ifndef REP9
#define REP9 1
#endif
#ifndef REP10
#define REP10 1
#endif
#ifndef REP12
#define REP12 1
#endif
#ifndef REP13
#define REP13 0
#endif
__global__ __launch_bounds__(NT_, 2) void k_mega(MKParams p) {
    extern __shared__ __attribute__((aligned(16))) unsigned char smem[];
    volatile LAS unsigned* st = (volatile LAS unsigned*)smem;
    if (threadIdx.x < 4) st[threadIdx.x] = 0u;
    if (threadIdx.x == 4) *(volatile LAS unsigned*)(smem + 64) = 0u;
    __syncthreads();
    xcd_barrier_post(p.bar, st);
    if (p.never) cg::this_grid().sync();
    const int G = gridDim.x, b0 = blockIdx.x;
    {
        const int tq = opaque_tid(), lane = tq & 63, wave = __builtin_amdgcn_readfirstlane(tq >> 6);
        if (wave < 4) {
            unsigned epoch = 0;
            volatile LAS unsigned* cnt = (volatile LAS unsigned*)(smem + 64);
            for (int rep = 0; rep < p.rep[10]; ++rep)
                for (int it = b0; it < 256; it += G) ssm_tables(p, smem, it >> 2, it & 3, wave, lane, cnt, epoch);
        } else {
            const int gw = b0 * 4 + (wave - 4), NGW = G * 4;
            for (int rep = 0; rep < p.rep[0]; ++rep) conv_range(p, 0, CV_P0_END, gw, NGW, lane);
            phase_prep(p, gw, NGW, lane);
            for (int i = gw * 64 + lane; i < NE_ * 4096; i += NGW * 64) p.ahist[i] = 0u;
        }
    }
    xcd_barrier(p.bar, st);
    if (threadIdx.x == 0) {
        bool even = (G % 8) == 0;
        for (int j = 0; j < 8; ++j) even = even && (xb_ld(&p.bar[XB_XCNT(j)]) == (unsigned)(G / 8));
        st[2] = even ? (st[2] + 8u * st[3]) : (unsigned)blockIdx.x;
    }
    __syncthreads();
    const int b = (int)st[2];
    for (int rep = 0; rep < p.rep[1]; ++rep) {
    phase_inproj(p, smem, b);
    xcd_barrier(p.bar, st);
    }
    for (int rep = 0; rep < p.rep[2]; ++rep) {
    phase2(p, smem, b, G);
    xcd_barrier(p.bar, st);
    }
    for (int rep = 0; rep < p.rep[3]; ++rep) {
    for (int it = b; it < 128; it += G) { const int q = it >> 3; ssm_y_item(p, smem, (it & 7) + 8 * (q >> 1), q & 1); }
    if (b >= 128) { const int tq = opaque_tid(); conv_range(p, CV_P0_END, CV_P3_END, (b - 128) * 8 + (tq >> 6), 128 * 8, tq & 63); }
    xcd_barrier(p.bar, st);
    }
    for (int rep = 0; rep < p.rep[4]; ++rep) {
    for (int it = b; it < 128; it += G) glu_item(p, smem, it);
    if (b >= 128) { const int tq = opaque_tid(); conv_range(p, CV_P3_END, CV_P4_END, (b - 128) * 8 + (tq >> 6), 128 * 8, tq & 63); }
    xcd_barrier(p.bar, st);
    }
    for (int rep = 0; rep < p.rep[5]; ++rep) {
    for (int it = b; it < 256; it += G) outproj_item(p, smem, it);
    xcd_barrier(p.bar, st);
    }
    for (int rep = 0; rep < p.rep[6]; ++rep) {
    for (int it = b; it < L_ / 32; it += G) router_item(p, smem, it);
    xcd_barrier(p.bar, st);
    }
    for (int rep = 0; rep < p.rep[7]; ++rep) {
    for (int it = b; it < NE_; it += G) topk_item(p, smem, it);
    if (b >= 16) { const int tq = opaque_tid(); conv_range(p, CV_P4_END, CV_END, (b - 16) * 8 + (tq >> 6), 240 * 8, tq & 63); }
    xcd_barrier(p.bar, st);
    }
    for (int rep = 0; rep < p.rep[8]; ++rep) {
    for (int it = b; it < 1024; it += G) moe1_item(p, smem, it);
    xcd_barrier(p.bar, st);
    }
    for (int rep = 0; rep < p.rep[9]; ++rep) {
    for (int it = b; it < 512; it += G) moe2_item(p, smem, it);
    xcd_barrier(p.bar, st);
    }
    for (int i = 0; i < p.rep[13]; ++i) xcd_barrier(p.bar, st);
    for (int rep = 0; rep < p.rep[12]; ++rep)
    { int tq = threadIdx.x; asm volatile("" : "+v"(tq));
      for (int t = b * 8 + (tq >> 6); t < L_; t += G * 8) final_token(p, t, tq & 63); }
}

extern "C" void kernel_launch(void* const* d_in, const int* in_sizes, int n_in, void* d_out, int out_size, void* d_ws, size_t ws_size,
                              hipStream_t stream) {
    (void)in_sizes; (void)n_in; (void)out_size; (void)ws_size;
    static int grid = 0;
    if (!grid) {
        int dev = 0, cus = 0, per_cu = 0;
        (void)hipGetDevice(&dev);
        (void)hipDeviceGetAttribute(&cus, hipDeviceAttributeMultiprocessorCount, dev);
        (void)hipFuncSetAttribute((const void*)k_mega, hipFuncAttributeMaxDynamicSharedMemorySize, MK_LDS);
        (void)hipOccupancyMaxActiveBlocksPerMultiprocessor(&per_cu, (const void*)k_mega, NT_, MK_LDS);
        if (per_cu < 1) per_cu = 1;
        grid = cus;
    }
    MKParams mp{};
    const float* const* in = (const float* const*)d_in;
    mp.x = in[0]; mp.g_mix = in[1]; mp.w_in = in[2];
    mp.a_re_f = in[3]; mp.a_im_f = in[4]; mp.ldt_f = in[5]; mp.b_re_f = in[6]; mp.b_im_f = in[7]; mp.c_re_f = in[8]; mp.c_im_f = in[9];
    mp.a_re_b = in[10]; mp.a_im_b = in[11]; mp.ldt_b = in[12]; mp.b_re_b = in[13]; mp.b_im_b = in[14]; mp.c_re_b = in[15]; mp.c_im_b = in[16];
    mp.ssm_d = in[17]; mp.w_glu = in[18]; mp.b_glu = in[19]; mp.rpb = in[20]; mp.g_ssm = in[21]; mp.g_na = in[22]; mp.w_out = in[23];
    mp.g_ffn = in[24]; mp.w_router = in[25]; mp.w_gate = in[26]; mp.w_up = in[27]; mp.w_down = in[28]; mp.g_final = in[29];
    mp.out = (float*)d_out;
    unsigned char* ws = (unsigned char*)d_ws;
    size_t off = 0;
    auto take = [&](size_t bytes) { unsigned char* q = ws + off; off += (bytes + 255) & ~(size_t)255; return q; };
    mp.bar = (unsigned*)take(XCD_BAR_WORDS * 4);
    mp.xn = (bf16_t*)take((size_t)L_ * XN_LD * 2);
    mp.rstd_x = (float*)take(L_ * 4);
    mp.ua = (bf16_t*)take((size_t)64 * 256 * 768 * 2);
    mp.qb = (bf16_t*)take((size_t)L_ * DS_ * 2);
    mp.kb = (bf16_t*)take((size_t)L_ * DS_ * 2);
    mp.vT = (bf16_t*)take((size_t)L_ * DS_ * 2);
    mp.PBt = (bf16_t*)take((size_t)64 * 256 * 512 * 2);
    mp.WyT = (bf16_t*)take((size_t)64 * 512 * 768 * 2);
    mp.A32 = (float*)take(64 * 2 * 64 * 2 * 4);
    mp.ypre = (bf16_t*)take((size_t)L_ * DS_ * 2);
    mp.ymix = (bf16_t*)take((size_t)L_ * D_ * 2);
    mp.ssq_na = (float*)take((size_t)L_ * 16 * 4);
    mp.ssq_ssm = (float*)take((size_t)L_ * 16 * 4);
    mp.x1g = (bf16_t*)take((size_t)L_ * D_ * 2);
    mp.ssq_x1 = (float*)take((size_t)L_ * 32 * 4);
    mp.wrT = (bf16_t*)take((size_t)2 * NE_ * D_ * 2);
    mp.aff_t = (float*)take((size_t)NE_ * L_ * 4);
    mp.rstd_x1 = (float*)take(L_ * 4);
    mp.idx = (int*)take(NE_ * CAP_ * 4);
    mp.gate = (float*)take(NE_ * CAP_ * 4);
    mp.slot_of = (int*)take((size_t)L_ * NE_ * 4);
    mp.ahist = (unsigned*)take((size_t)NE_ * 4096 * 4);
    mp.act = (bf16_t*)take((size_t)NE_ * CAP_ * FF_ * 2);
    mp.ye = (bf16_t*)take((size_t)NE_ * CAP_ * D_ * 2);
    mp.w_in_t = (bf16_t*)take((size_t)DIN_ * XN_LD * 2);
    mp.w_out_t = (bf16_t*)take((size_t)D_ * D_ * 2);
    mp.w_glu_t = (bf16_t*)take((size_t)DS_ * DS_ * 2);
    mp.w_gate_t = (bf16_t*)take((size_t)NE_ * D_ * FF_ * 2);
    mp.w_up_t = (bf16_t*)take((size_t)NE_ * D_ * FF_ * 2);
    mp.w_down_t = (bf16_t*)take((size_t)NE_ * D_ * FF_ * 2);
    { const int reps[14] = {REP0, REP1, REP2, REP3, REP4, REP5, REP6, REP7, REP8, REP9, REP10, 1, REP12, REP13}; for (int i = 0; i < 14; ++i) mp.rep[i] = reps[i]; }
    mp.bg = 1;
    mp.never = 0; mp.pad = 0;
    (void)hipMemsetAsync(mp.bar, 0, XCD_BAR_WORDS * sizeof(unsigned), stream);
    void* args[] = {&mp};
    (void)hipLaunchCooperativeKernel((const void*)k_mega, dim3(grid), dim3(NT_), args, MK_LDS, stream);
}
```
